# Optimizing an MI355X kernel written in HIP

```python
import jax, jax.numpy as jnp
from jax import lax
import numpy as np

D_MODEL = 1024
BATCH = 2
SEQ = 16384
DEPTH = 4

GRID_W = 64
CTX_LEN = 256
HEAD_DIM = 64
N_Q_HEADS = D_MODEL // HEAD_DIM
N_KV_HEADS = N_Q_HEADS // 4
GQA_GROUP = N_Q_HEADS // N_KV_HEADS
QKV_WIDTH = (N_Q_HEADS + 2 * N_KV_HEADS) * HEAD_DIM
ROPE_AXIS_DIM = HEAD_DIM // 2
ROPE_THETA = 10000.0
Q_BLOCK = 128
WINDOW = 128
N_EXPERTS = 16
EC_CAPACITY = 2
D_EXPERT = 2 * D_MODEL
N_MOD = 6
N_GLOBAL_LAYERS = (DEPTH + 1) // 2
N_WINDOW_LAYERS = DEPTH // 2
NORM_EPS = 1e-6
NEG_INF = -1e30

kernel_name = "hybrid_interleaved_gqa_window_ec_moe_dit"


def rms_norm(x, g):
    xf = x.astype(jnp.float32)
    y = xf * lax.rsqrt(jnp.mean(xf * xf, axis=-1, keepdims=True) + NORM_EPS)
    return (y * g.astype(jnp.float32)).astype(x.dtype)


def modulate(h, shift, scale):
    return h * (1 + scale) + shift


def axial_rope_tables(n_tokens):
    rows = n_tokens // GRID_W
    row = jnp.repeat(jnp.arange(rows, dtype=jnp.float32), GRID_W)
    col = jnp.tile(jnp.arange(GRID_W, dtype=jnp.float32), rows)
    inv_freq = 1.0 / (ROPE_THETA ** (jnp.arange(0, ROPE_AXIS_DIM, 2, dtype=jnp.float32) / ROPE_AXIS_DIM))
    ang = jnp.stack([row[:, None] * inv_freq, col[:, None] * inv_freq], axis=1)
    return jnp.cos(ang), jnp.sin(ang)


def apply_axial_rope(x, cos, sin):
    half = ROPE_AXIS_DIM // 2
    L = x.shape[1]
    xs = x.reshape(x.shape[:-1] + (2, 2, half))
    x1, x2 = xs[..., 0, :], xs[..., 1, :]
    bshape = (1, L) + (1,) * (x.ndim - 3) + (2, half)
    cs = cos.reshape(bshape).astype(x.dtype)
    sn = sin.reshape(bshape).astype(x.dtype)
    out = jnp.stack([x1 * cs - x2 * sn, x2 * cs + x1 * sn], axis=-2)
    return out.reshape(x.shape)


def project_qkv(h, w_qkv):
    B, L, _ = h.shape
    qkv = h @ w_qkv
    nq = N_Q_HEADS * HEAD_DIM
    nk = N_KV_HEADS * HEAD_DIM
    q = qkv[..., :nq].reshape(B, L, N_KV_HEADS, GQA_GROUP, HEAD_DIM)
    k = qkv[..., nq:nq + nk].reshape(B, L, N_KV_HEADS, HEAD_DIM)
    v = qkv[..., nq + nk:].reshape(B, L, N_KV_HEADS, HEAD_DIM)
    return q, k, v


def attend(q, k, v, mask=None, sink=None):
    s = jnp.einsum('bqhgd,bkhd->bhgqk', q, k).astype(jnp.float32) * (HEAD_DIM ** -0.5)
    if mask is not None:
        s = jnp.where(mask, s, NEG_INF)
    if sink is not None:
        sk = jnp.broadcast_to(sink.astype(jnp.float32)[None, :, :, None, None], s.shape[:-1] + (1,))
        p = jax.nn.softmax(jnp.concatenate([s, sk], axis=-1), axis=-1)[..., :-1]
    else:
        p = jax.nn.softmax(s, axis=-1)
    return jnp.einsum('bhgqk,bkhd->bqhgd', p.astype(v.dtype), v)


def merge_heads(o, w_o):
    B, L = o.shape[:2]
    return o.reshape(B, L, D_MODEL) @ w_o


def global_attention_mixer(hx, hc, w_qkv, w_o, q_g, k_g, cos, sin, with_ctx):
    q_l, k_l, v_l = project_qkv(hx, w_qkv)
    q_c, k_c, v_c = project_qkv(hc, w_qkv)
    q_l = apply_axial_rope(rms_norm(q_l, q_g), cos, sin)
    k_l = apply_axial_rope(rms_norm(k_l, k_g), cos, sin)
    q_c = rms_norm(q_c, q_g)
    k_c = rms_norm(k_c, k_g)
    keys = jnp.concatenate([k_c, k_l], axis=1)
    vals = jnp.concatenate([v_c, v_l], axis=1)
    B, L = hx.shape[:2]
    nb = L // Q_BLOCK
    qb = q_l.reshape(B, nb, Q_BLOCK, N_KV_HEADS, GQA_GROUP, HEAD_DIM).swapaxes(0, 1)
    ob = lax.map(lambda qblk: attend(qblk, keys, vals), qb)
    o_l = merge_heads(ob.swapaxes(0, 1).reshape(B, L, N_KV_HEADS, GQA_GROUP, HEAD_DIM), w_o)
    o_c = merge_heads(attend(q_c, k_c, v_c), w_o) if with_ctx else None
    return o_l, o_c


def window_attention_mixer(hx, hc, w_qkv, w_o, sink_h, cos, sin, with_ctx):
    q_l, k_l, v_l = project_qkv(hx, w_qkv)
    q_c, k_c, v_c = project_qkv(hc, w_qkv)
    q_l = apply_axial_rope(q_l, cos, sin)
    k_l = apply_axial_rope(k_l, cos, sin)
    sink = sink_h.reshape(N_KV_HEADS, GQA_GROUP)
    B, L = hx.shape[:2]
    Lc = hc.shape[1]
    nb = L // Q_BLOCK
    span = Q_BLOCK + 2 * WINDOW
    pad = ((0, 0), (WINDOW, WINDOW), (0, 0), (0, 0))
    k_pad = jnp.pad(k_l, pad)
    v_pad = jnp.pad(v_l, pad)
    a = jnp.arange(Q_BLOCK)
    b = jnp.arange(span)
    band = (b[None, :] >= a[:, None]) & (b[None, :] <= a[:, None] + 2 * WINDOW)
    ctx_ok = jnp.ones((Q_BLOCK, Lc), dtype=bool)
    qb = q_l.reshape(B, nb, Q_BLOCK, N_KV_HEADS, GQA_GROUP, HEAD_DIM).swapaxes(0, 1)

    def block(args):
        qblk, n = args
        start = n * Q_BLOCK
        ks = lax.dynamic_slice_in_dim(k_pad, start, span, axis=1)
        vs = lax.dynamic_slice_in_dim(v_pad, start, span, axis=1)
        j = start - WINDOW + b
        inb = (j >= 0) & (j < L)
        mask = jnp.concatenate([ctx_ok, band & inb[None, :]], axis=1)
        keys = jnp.concatenate([k_c, ks], axis=1)
        vals = jnp.concatenate([v_c, vs], axis=1)
        return attend(qblk, keys, vals, mask, sink)

    ob = lax.map(block, (qb, jnp.arange(nb)))
    o_l = merge_heads(ob.swapaxes(0, 1).reshape(B, L, N_KV_HEADS, GQA_GROUP, HEAD_DIM), w_o)
    o_c = merge_heads(attend(q_c, k_c, v_c, None, sink), w_o) if with_ctx else None
    return o_l, o_c


def expert_choice_ffn(h, w_router, w_gate, w_up, w_down):
    B, L, D = h.shape
    cap = max(1, EC_CAPACITY * L // N_EXPERTS)
    aff = jax.nn.softmax(jnp.einsum('bld,de->ble', h, w_router).astype(jnp.float32), axis=-1)
    gates, idx = lax.top_k(aff.transpose(0, 2, 1), cap)
    x_sel = jax.vmap(lambda hb, ib: hb[ib])(h, idx)
    g = jnp.einsum('becd,edf->becf', x_sel, w_gate)
    u = jnp.einsum('becd,edf->becf', x_sel, w_up)
    y = jnp.einsum('becf,efd->becd', jax.nn.silu(g) * u, w_down)
    y = y * gates[..., None].astype(y.dtype)
    return jax.vmap(lambda yb, ib: jnp.zeros((L, D), yb.dtype).at[ib.reshape(-1)].add(yb.reshape(-1, D)))(y, idx)


def setup_inputs(seed: int = 0) -> dict:
    key = jax.random.key(seed)
    ks = jax.random.split(key, 20)
    f32 = jnp.float32
    nrm = lambda k, shape, s: jax.random.normal(k, shape, f32) * s
    return {
        "x": nrm(ks[0], (BATCH, SEQ, D_MODEL), 1.0),
        "c": nrm(ks[1], (BATCH, D_MODEL), 1.0),
        "ctx": nrm(ks[2], (BATCH, CTX_LEN, D_MODEL), 1.0),
        "c_ctx": nrm(ks[3], (D_MODEL,), 1.0),
        "w_mod": nrm(ks[4], (DEPTH, D_MODEL, N_MOD * D_MODEL), 0.5 * D_MODEL ** -0.5),
        "b_mod": nrm(ks[5], (DEPTH, N_MOD * D_MODEL), 0.01),
        "norm_mix_g": 1.0 + nrm(ks[6], (DEPTH, D_MODEL), 0.02),
        "norm_ffn_g": 1.0 + nrm(ks[7], (DEPTH, D_MODEL), 0.02),
        "w_qkv": nrm(ks[8], (DEPTH, D_MODEL, QKV_WIDTH), D_MODEL ** -0.5),
        "w_o": nrm(ks[9], (DEPTH, D_MODEL, D_MODEL), D_MODEL ** -0.5),
        "q_norm_g": 1.0 + nrm(ks[10], (N_GLOBAL_LAYERS, HEAD_DIM), 0.02),
        "k_norm_g": 1.0 + nrm(ks[11], (N_GLOBAL_LAYERS, HEAD_DIM), 0.02),
        "attn_sink": nrm(ks[12], (N_WINDOW_LAYERS, N_Q_HEADS), 0.5),
        "w_router": nrm(ks[13], (DEPTH, D_MODEL, N_EXPERTS), D_MODEL ** -0.5),
        "w_gate": nrm(ks[14], (DEPTH, N_EXPERTS, D_MODEL, D_EXPERT), D_MODEL ** -0.5),
        "w_up": nrm(ks[15], (DEPTH, N_EXPERTS, D_MODEL, D_EXPERT), D_MODEL ** -0.5),
        "w_down": nrm(ks[16], (DEPTH, N_EXPERTS, D_EXPERT, D_MODEL), D_EXPERT ** -0.5),
        "final_norm_g": 1.0 + nrm(ks[17], (D_MODEL,), 0.02),
    }


def reference(x, c, ctx, c_ctx, w_mod, b_mod, norm_mix_g, norm_ffn_g, w_qkv, w_o, q_norm_g, k_norm_g,
              attn_sink, w_router, w_gate, w_up, w_down, final_norm_g):
    L = x.shape[1]
    cos, sin = axial_rope_tables(L)
    silu_c = jax.nn.silu(c)
    silu_cc = jax.nn.silu(c_ctx)
    for i in range(DEPTH):
        last = i == DEPTH - 1
        mod_x = silu_c @ w_mod[i] + b_mod[i]
        sh1, sc1, g1, sh2, sc2, g2 = [m[:, None, :] for m in jnp.split(mod_x, N_MOD, axis=-1)]
        mod_c = silu_cc @ w_mod[i] + b_mod[i]
        csh1, csc1, cg1, csh2, csc2, cg2 = jnp.split(mod_c, N_MOD, axis=-1)

        hx = modulate(rms_norm(x, norm_mix_g[i]), sh1, sc1)
        hc = modulate(rms_norm(ctx, norm_mix_g[i]), csh1, csc1)
        if i % 2 == 0:
            j = i // 2
            o_x, o_c = global_attention_mixer(hx, hc, w_qkv[i], w_o[i], q_norm_g[j], k_norm_g[j],
                                              cos, sin, not last)
        else:
            j = i // 2
            o_x, o_c = window_attention_mixer(hx, hc, w_qkv[i], w_o[i], attn_sink[j], cos, sin, not last)
        x = x + g1 * o_x
        if not last:
            ctx = ctx + cg1 * o_c

        hx = modulate(rms_norm(x, norm_ffn_g[i]), sh2, sc2)
        x = x + g2 * expert_choice_ffn(hx, w_router[i], w_gate[i], w_up[i], w_down[i])
        if not last:
            hc = modulate(rms_norm(ctx, norm_ffn_g[i]), csh2, csc2)
            ctx = ctx + cg2 * expert_choice_ffn(hc, w_router[i], w_gate[i], w_up[i], w_down[i])
    return rms_norm(x, final_norm_g)
```

```cpp
#include <hip/hip_runtime.h>
#include <hip/hip_bf16.h>
#include <cmath>
#include <cstdio>
#include <cstdint>

#define LAS __attribute__((address_space(3)))
typedef unsigned short bf16_t;
typedef float f32x4 __attribute__((ext_vector_type(4)));
typedef unsigned u32x4 __attribute__((ext_vector_type(4)));
typedef unsigned u32x2 __attribute__((ext_vector_type(2)));

namespace cfg {
constexpr int D = 1024, NB = 2, SEQ = 16384, DEPTH = 4, CTXL = 256, HD = 64, NQH = 16, NKVH = 4, QKVW = 1536;
constexpr int NE = 16, DE = 2048, CAP_L = 2048, CAP_C = 32;
constexpr int RB = CTXL + SEQ;
constexpr int R = NB * RB;
constexpr int NSLOT_L = NB * NE * CAP_L;
constexpr int NSLOT = NSLOT_L + NE * 256;
constexpr float EPS = 1e-6f;
constexpr float C2 = 0.125f * 1.4426950408889634f;
constexpr float LOG2E = 1.4426950408889634f;
constexpr int NT = 512;
}
using namespace cfg;

constexpr size_t MiB = 1u << 20;
constexpr size_t WS_CTL   = 0;
constexpr size_t WS_MOD   = 1 * MiB;
constexpr size_t WS_ROPE  = WS_MOD + 512 * 1024;
constexpr size_t WS_WQKV  = 2 * MiB;
constexpr size_t WS_WO    = WS_WQKV + 12 * MiB;
constexpr size_t WS_WGU   = WS_WO + 8 * MiB;
constexpr size_t WS_WD    = WS_WGU + 512 * MiB;
constexpr size_t WS_XR    = WS_WD + 256 * MiB;
constexpr size_t WS_H     = WS_XR + 130 * MiB;
constexpr size_t WS_Q     = WS_H + 65 * MiB;
constexpr size_t WS_K     = WS_Q + 65 * MiB;
constexpr size_t WS_V     = WS_K + 17 * MiB;
constexpr size_t WS_O     = WS_V + 17 * MiB;
constexpr size_t WS_AFF   = WS_O + 65 * MiB;
constexpr size_t WS_SELI  = WS_AFF + 3 * MiB;
constexpr size_t WS_SELG  = WS_SELI + 512 * 1024;
constexpr size_t WS_INVT  = WS_SELG + 512 * 1024;
constexpr size_t WS_XSEL  = WS_INVT + 3 * MiB;
constexpr size_t WS_ACT   = WS_XSEL + 136 * MiB;
constexpr size_t WS_Y     = WS_ACT + 272 * MiB;
constexpr size_t WS_END   = WS_Y + 272 * MiB;

struct Params {
    const float *x, *c, *ctx, *c_ctx, *w_mod, *b_mod, *norm_mix_g, *norm_ffn_g, *w_qkv, *w_o, *q_norm_g, *k_norm_g, *attn_sink, *w_router, *w_gate, *w_up, *w_down, *final_norm_g;
    float* out; unsigned char* ws;
};

__device__ __forceinline__ unsigned f2bf(float f) { unsigned u = __builtin_bit_cast(unsigned, f); return (u + 0x7fffu + ((u >> 16) & 1u)) >> 16; }
__device__ __forceinline__ unsigned pk2(float lo, float hi) { return f2bf(lo) | (f2bf(hi) << 16); }
__device__ __forceinline__ float bf2f(unsigned short h) { return __builtin_bit_cast(float, (unsigned)h << 16); }
__device__ __forceinline__ float wave_sum(float v) {
#pragma unroll
    for (int o = 1; o < 64; o <<= 1) v += __shfl_xor(v, o);
    return v;
}
__device__ __forceinline__ int otid() { int t = threadIdx.x; asm volatile("" : "+v"(t)); return t; }
__device__ __forceinline__ unsigned char* ows(const Params& P) {
    __attribute__((address_space(1))) unsigned char* g = (__attribute__((address_space(1))) unsigned char*)P.ws; asm volatile("" : "+s"(g)); return (unsigned char*)g; }
__device__ __forceinline__ float silu_f(float v) { return v / (1.f + expf(-v)); }
__device__ __forceinline__ int mod_vec_of_row(int r) { const int b = r / RB, j = r - b * RB; return j < CTXL ? 2 : b; }

__device__ __forceinline__ size_t wtile_off(int n, int k, int K) {
    const int r = n & 127, c = k & 63; const int st = (r >> 4) * 2 + (c >> 5), ob = (r & 15) * 64 + (c & 31) * 2;
    return ((size_t)(n >> 7) * (K >> 6) + (k >> 6)) * 8192 + (size_t)((st * 1024 + (ob ^ (((ob >> 9) & 1) << 5))) >> 1);
}
template <bool KPERM = false, class RowMap>
__device__ __forceinline__ void transpose_item(const float* W, int K, int N, bf16_t* WT, const RowMap& rowmap, int item, int lane, float scale = 1.f) {
    const int nblk = N / 64, kb = item / nblk, nb = item % nblk, k0 = 64 * kb, n = 64 * nb + lane;
    const float* src = W + (size_t)k0 * N + n; const int row = rowmap(n);
#pragma unroll
    for (int half = 0; half < 2; ++half) {
        float v[32];
#pragma unroll
        for (int j = 0; j < 32; ++j) v[j] = src[(size_t)(32 * half + j) * N] * scale;
#pragma unroll
        for (int kc = 0; kc < 4; ++kc) { const int ka = k0 + 32 * half + 8 * kc;
            u32x4 o; o.x = pk2(v[8 * kc], v[8 * kc + 1]); o.y = pk2(v[8 * kc + 2], v[8 * kc + 3]); o.z = pk2(v[8 * kc + 4], v[8 * kc + 5]); o.w = pk2(v[8 * kc + 6], v[8 * kc + 7]);
            if (KPERM) { const int kb_ = ka + 4;
                const int pa = (ka & ~31) + 8 * ((ka >> 2) & 3) + 4 * ((ka >> 4) & 1), pb = (kb_ & ~31) + 8 * ((kb_ >> 2) & 3) + 4 * ((kb_ >> 4) & 1);
                *(u32x2*)(WT + wtile_off(row, pa, K)) = (u32x2){o.x, o.y}; *(u32x2*)(WT + wtile_off(row, pb, K)) = (u32x2){o.z, o.w}; }
            else *(u32x4*)(WT + wtile_off(row, ka, K)) = o; }
    }
}

__device__ __forceinline__ void phase_weights(const Params& P, LAS unsigned char* lds) {
    unsigned char* const ws = ows(P);
    const int tid = otid(), lane = tid & 63, wave = tid >> 6;
    const int gw = blockIdx.x * 8 + wave, NGW = gridDim.x * 8;
    constexpr int I_QKV = 16 * 24, I_O = 16 * 16, I_G = 16 * 32, I_D = 32 * 16;
    constexpr int PER_LAYER = I_QKV + I_O + NE * (2 * I_G + I_D);
    for (int it = gw; it < DEPTH * PER_LAYER; it += NGW) {
        const int l = it / PER_LAYER; int r = it % PER_LAYER;
        if (r < I_QKV) { bf16_t* dst = (bf16_t*)(ws + WS_WQKV) + (size_t)l * QKVW * D;
            transpose_item(P.w_qkv + (size_t)l * D * QKVW, D, QKVW, dst, [](int n) { const int hh = n >> 6; return 256 * (hh >> 2) + 128 * ((n >> 5) & 1) + 32 * (hh & 3) + (n & 31); }, r, lane); continue; }
        r -= I_QKV;
        if (r < I_O) { bf16_t* dst = (bf16_t*)(ws + WS_WO) + (size_t)l * D * D;
            transpose_item<true>(P.w_o + (size_t)l * D * D, D, D, dst, [](int n) { const int c = n & 31; return (n & ~31) + 16 * ((c >> 2) & 1) + 4 * (c >> 3) + (c & 3); }, r, lane); continue; }
        r -= I_O;
        const int e = r / (2 * I_G + I_D); r = r % (2 * I_G + I_D);
        const size_t le = (size_t)l * NE + e;
        if (r < I_G) { bf16_t* dst = (bf16_t*)(ws + WS_WGU) + le * (size_t)(2 * DE) * D;
            transpose_item(P.w_gate + le * (size_t)D * DE, D, DE, dst, [](int f) { return 256 * (f >> 7) + 128 * ((f >> 2) & 1) + 32 * ((f >> 5) & 3) + 4 * ((f >> 3) & 3) + (f & 3); }, r, lane, -1.4426950408889634f); continue; }
        r -= I_G;
        if (r < I_G) { bf16_t* dst = (bf16_t*)(ws + WS_WGU) + le * (size_t)(2 * DE) * D;
            transpose_item(P.w_up + le * (size_t)D * DE, D, DE, dst, [](int f) { return 256 * (f >> 7) + 128 * ((f >> 2) & 1) + 32 * ((f >> 5) & 3) + 16 + 4 * ((f >> 3) & 3) + (f & 3); }, r, lane, -0.6931471805599453f); continue; }
        r -= I_G;
        { bf16_t* dst = (bf16_t*)(ws + WS_WD) + le * (size_t)D * DE;
            transpose_item(P.w_down + le * (size_t)DE * D, DE, D, dst, [](int n) { const int c = n & 31; return (n & ~31) + 16 * ((c >> 2) & 1) + 4 * (c >> 3) + (c & 3); }, r, lane); }
    }
}

__device__ __forceinline__ void phase_mod(const Params& P, LAS unsigned char* lds) {
    unsigned char* const ws = ows(P);
    const int tid = otid(), lane = tid & 63, wave = tid >> 6;
    LAS float* sc = (LAS float*)lds;
    LAS float* red = sc + 3 * 1024;
    for (int i = tid; i < 3 * D; i += NT) { const int v = i / D, k = i % D; const float cv = v < 2 ? P.c[v * D + k] : P.c_ctx[k]; sc[i] = silu_f(cv); }
    __syncthreads();
    float* MOD = (float*)(ws + WS_MOD);
    for (int it = blockIdx.x; it < DEPTH * 96; it += gridDim.x) {
        const int l = it / 96, col = (it % 96) * 64 + lane;
        const float* W = P.w_mod + (size_t)l * D * 6144 + col;
        float a0 = 0.f, a1 = 0.f, a2 = 0.f;
#pragma unroll 4
        for (int k = wave; k < D; k += 8) { const float w = W[(size_t)k * 6144]; a0 += sc[k] * w; a1 += sc[D + k] * w; a2 += sc[2 * D + k] * w; }
        red[(wave * 3 + 0) * 64 + lane] = a0; red[(wave * 3 + 1) * 64 + lane] = a1; red[(wave * 3 + 2) * 64 + lane] = a2;
        __syncthreads();
        if (wave < 3) { float s = 0.f;
#pragma unroll
            for (int w = 0; w < 8; ++w) s += red[(w * 3 + wave) * 64 + lane];
            MOD[((size_t)l * 3 + wave) * 6144 + col] = s + P.b_mod[(size_t)l * 6144 + col]; }
        __syncthreads();
    }
}

__device__ __forceinline__ void phase_rope_init(const Params& P) {
    unsigned char* const ws = ows(P);
    float* T = (float*)(ws + WS_ROPE);
    for (int i = blockIdx.x * NT + otid(); i < 256 * 16; i += gridDim.x * NT) {
        const int p = i >> 4, f = i & 15;
        const float inv = (float)(1.0 / pow(10000.0, (double)f / 16.0));
        const float ang = (float)p * inv;
        T[2 * i] = (float)cos((double)ang); T[2 * i + 1] = (float)sin((double)ang);
    }
}


__device__ __forceinline__ void phase_norm1_l0(const Params& P) {
    unsigned char* const ws = ows(P);
    const int tid = otid(), lane = tid & 63, wave = tid >> 6;
    const int gw = blockIdx.x * 8 + wave, NGW = gridDim.x * 8;
    bf16_t* H = (bf16_t*)(ws + WS_H); const float* MOD = (const float*)(ws + WS_MOD); const float* gain = P.norm_mix_g;
    for (int r = gw; r < R; r += NGW) {
        const int b = r / RB, j = r - b * RB; const int mv = j < CTXL ? 2 : b;
        const float* sh = MOD + (size_t)mv * 6144; const float* sc = sh + 1024;
        const f32x4* xr = (const f32x4*)(j < CTXL ? P.ctx + ((size_t)b * CTXL + j) * D : P.x + ((size_t)b * SEQ + (j - CTXL)) * D) + lane;
        f32x4 v[4]; float ss = 0.f;
#pragma unroll
        for (int q = 0; q < 4; ++q) { v[q] = xr[64 * q]; ss += (v[q].x * v[q].x + v[q].y * v[q].y) + (v[q].z * v[q].z + v[q].w * v[q].w); }
        const float rstd = 1.0f / sqrtf(wave_sum(ss) * (1.f / D) + EPS);
        unsigned long long* o8 = (unsigned long long*)(H + (size_t)r * D) + lane;
#pragma unroll
        for (int q = 0; q < 4; ++q) { const int c0 = 4 * lane + 256 * q;
            const f32x4 g4 = *(const f32x4*)(gain + c0), sc4 = *(const f32x4*)(sc + c0), sh4 = *(const f32x4*)(sh + c0);
            const f32x4 h = v[q] * rstd * g4 * (sc4 + 1.f) + sh4;
            o8[64 * q] = (unsigned long long)pk2(h.x, h.y) | ((unsigned long long)pk2(h.z, h.w) << 32); }
    }
}


namespace pg8 {
#define PG8_LAS __attribute__((address_space(3)))
typedef unsigned short bf16_t;
typedef short bf16x8 __attribute__((ext_vector_type(8)));
typedef float f32x4 __attribute__((ext_vector_type(4)));
typedef unsigned u32x4 __attribute__((ext_vector_type(4)));
constexpr int BM = 256, BK = 64, HALF = 128, HTB = HALF * BK * 2  , STAGE_BYTES = 8 * HTB, NXCD = 8, WGM = 8;

__host__ __device__ __forceinline__ int lds_byte(int r, int c) { const int st = (r >> 4) * 2 + (c >> 5), rr = r & 15, cc = c & 31, ob = rr * 64 + cc * 2; return st * 1024 + (ob ^ (((ob >> 9) & 1) << 5)); }
__host__ __device__ __forceinline__ void stage_rc(int b, int& R, int& C) { const int st = b / 1024, sb = b % 1024, swz = sb ^ (((sb >> 9) & 1) << 5); R = (st >> 1) * 16 + swz / 64; C = (st & 1) * 32 + (swz % 64) / 2; }
__host__ __device__ __forceinline__ int perm32(int rho) { const int n = rho >> 4, i = rho & 15; return 8 * (i >> 2) + 4 * n + (i & 3); }

struct Unit { int pm, pn; int par = 0; int kt0 = 0, nkt = 0, kq = -1; };
struct Gemm { const bf16_t* A; const bf16_t* Bt; int M, N, K; const int* gidx; };


__device__ __forceinline__ unsigned cvt_pk_bf16(float lo, float hi) { unsigned r; asm volatile("v_cvt_pk_bf16_f32 %0, %1, %2" : "=v"(r) : "v"(lo), "v"(hi)); return r; }
typedef unsigned u32x2 __attribute__((ext_vector_type(2)));

struct EpiQKV {
    static constexpr bool PERM = false, AFTER_DRAIN = false, PRE = false;
    unsigned char* ws; const float* rope; const float* qg; const float* kg; int do_norm; const PG8_LAS float* ropel;
    __device__ __forceinline__ void operator()(const f32x4 (&acc)[2][2][4][2], const Unit& u, int wr_, int wc_, int fr_, int fq_) const {
        int wr = wr_, wc = wc_, fr = fr_, fq = fq_; asm volatile("" : "+s"(wr), "+s"(wc), "+v"(fr), "+v"(fq));
        const int type = u.pn < 4 ? 0 : (u.pn == 4 ? 1 : 2);
        const int pb = u.pm / 65, pj = u.pm - pb * 65;
        const bool lat = pj != 0, nrm = do_norm && type < 2;
        const size_t dbyte = type == 0 ? ::WS_Q + (size_t)(u.pn * 4 + wc) * 128 : (type == 1 ? ::WS_K : ::WS_V) + (size_t)wc * 128;
        bf16_t* dst = (bf16_t*)(ws + dbyte);
        const int ldd = type == 0 ? 1024 : 256;
        f32x4 gv[2][2];
#pragma unroll
        for (int bj = 0; bj < 2; ++bj)
#pragma unroll
            for (int n = 0; n < 2; ++n) { const f32x4 a = *(const f32x4*)(qg + 32 * bj + 16 * n + 4 * fq), b = *(const f32x4*)(kg + 32 * bj + 16 * n + 4 * fq);
                gv[bj][n] = nrm ? (type == 0 ? a : b) : (f32x4){1.f, 1.f, 1.f, 1.f}; }
        const float osc = type == 0 ? cfg::C2 : 1.f;
        const bool dorope = lat && type < 2;
#pragma unroll
        for (int ai = 0; ai < 2; ++ai) {
            f32x4 rr0 = (f32x4){1.f, 0.f, 1.f, 0.f}, rr1 = rr0;
            if (dorope) { const int prow = (pj - 1) * 4 + 2 * ai + wr; const f32x4* cs = (const f32x4*)(rope + (size_t)(prow * 16 + 4 * fq) * 2); rr0 = cs[0]; rr1 = cs[1]; }
#pragma unroll
            for (int mp = 0; mp < 2; ++mp) {
            f32x4 rc0[2], rc1[2];
#pragma unroll
            for (int mm = 0; mm < 2; ++mm) { rc0[mm] = (f32x4){1.f, 0.f, 1.f, 0.f}; rc1[mm] = rc0[mm]; }
            if (dorope) {
#pragma unroll
                for (int mm = 0; mm < 2; ++mm) { const PG8_LAS f32x4* cc = (const PG8_LAS f32x4*)(ropel + ((16 * (2 * mp + mm) + fr) * 16 + 4 * fq) * 2); rc0[mm] = cc[0]; rc1[mm] = cc[1]; }
            }
#pragma unroll
            for (int mm = 0; mm < 2; ++mm) {
                const int m = 2 * mp + mm;
                const int rt = ai * HALF + wr * 64 + m * 16 + fr;
                f32x4 v[2][2];
#pragma unroll
                for (int bj = 0; bj < 2; ++bj)
#pragma unroll
                    for (int n = 0; n < 2; ++n) v[bj][n] = acc[ai][bj][m][n];
                if (nrm) {
                    float ss = 0.f;
#pragma unroll
                    for (int bj = 0; bj < 2; ++bj)
#pragma unroll
                        for (int n = 0; n < 2; ++n) { const f32x4 x = v[bj][n]; ss += (x[0] * x[0] + x[1] * x[1]) + (x[2] * x[2] + x[3] * x[3]); }
                    ss += __shfl_xor(ss, 16); ss += __shfl_xor(ss, 32);
                    const float rstd = 1.0f / sqrtf(ss * (1.f / 64.f) + cfg::EPS);
#pragma unroll
                    for (int bj = 0; bj < 2; ++bj)
#pragma unroll
                        for (int n = 0; n < 2; ++n) v[bj][n] = v[bj][n] * rstd * gv[bj][n];
                }
                if (dorope) {
#pragma unroll
                    for (int bj = 0; bj < 2; ++bj) {
                        const f32x4 A = bj == 0 ? rr0 : rc0[mm], B = bj == 0 ? rr1 : rc1[mm];
                        const f32x4 c = (f32x4){A[0], A[2], B[0], B[2]}, s = (f32x4){A[1], A[3], B[1], B[3]};
                        const f32x4 x1 = v[bj][0], x2 = v[bj][1];
                        v[bj][0] = x1 * c - x2 * s; v[bj][1] = x2 * c + x1 * s;
                    }
                }
                const size_t tile_ = (size_t)((pb * 4 + wc) * 260 + pj * 4 + (rt >> 6));
                bf16_t* rowp = type == 1 ? (bf16_t*)(ws + ::WS_K) + (tile_ * 8 + fq) * 512 + (rt & 63) * 8
                             : type == 2 ? (bf16_t*)(ws + ::WS_V) + tile_ * 4096 + (rt & 63) * 32 + 8 * fq
                                         : dst + ((size_t)u.pm * BM + rt) * ldd + 8 * fq;
                const int sbj = type == 0 ? 32 : 2048;
#pragma unroll
                for (int bj = 0; bj < 2; ++bj) { const f32x4 o0 = v[bj][0] * osc, o1 = v[bj][1] * osc; u32x4 w; w.x = cvt_pk_bf16(o0[0], o0[1]); w.y = cvt_pk_bf16(o0[2], o0[3]); w.z = cvt_pk_bf16(o1[0], o1[1]); w.w = cvt_pk_bf16(o1[2], o1[3]);
                    *(u32x4*)(rowp + sbj * bj) = w; }
            }
            asm volatile("" ::: "memory");
            }
        }
    }
};
struct EpiResid {
    static constexpr bool PERM = false, AFTER_DRAIN = false, PRE = false;
    bf16_t* XR; const float* modl; const float* in_x; const float* in_ctx; int first;
    float* part = nullptr;
    __device__ __forceinline__ void operator()(const f32x4 (&acc)[2][2][4][2], const Unit& u, int wr_, int wc_, int fr_, int fq_) const {
        int wr = wr_, wc = wc_, fr = fr_, fq = fq_; asm volatile("" : "+s"(wr), "+s"(wc), "+v"(fr), "+v"(fq));
        const int pb = u.pm / 65, pj = u.pm - pb * 65; const int mv = pj == 0 ? 2 : pb;
        const int col0 = u.pn * BM + wc * 32 + 8 * fq;
        const float* g1 = modl + (size_t)mv * 6144 + 2048 + col0;
        const float* rin = pj == 0 ? in_ctx + (size_t)pb * 256 * 1024 : in_x + ((size_t)pb * 16384 + (size_t)(pj - 1) * 256) * 1024;
        f32x4 gv[2][2];
#pragma unroll
        for (int bj = 0; bj < 2; ++bj)
#pragma unroll
            for (int n = 0; n < 2; ++n) gv[bj][n] = *(const f32x4*)(g1 + bj * HALF + n * 4);
        if (u.kq > 0) {
            float* pb0 = part + ((size_t)(u.kq - 1) * 512 + (size_t)pb * 256) * 1024 + col0;
#pragma unroll
            for (int ai = 0; ai < 2; ++ai)
#pragma unroll
                for (int m = 0; m < 4; ++m) { float* rowp = pb0 + (size_t)(ai * HALF + wr * 64 + m * 16 + fr) * 1024;
#pragma unroll
                    for (int bj = 0; bj < 2; ++bj)
#pragma unroll
                        for (int n = 0; n < 2; ++n) *(f32x4*)(rowp + bj * HALF + n * 4) = gv[bj][n] * acc[ai][bj][m][n]; }
            return; }
#pragma unroll
        for (int ai = 0; ai < 2; ++ai)
#pragma unroll
            for (int mp = 0; mp < 2; ++mp) {
                f32x4 xv[2][2][2];
#pragma unroll
                for (int mm = 0; mm < 2; ++mm) { const size_t ro = (size_t)(ai * HALF + wr * 64 + (2 * mp + mm) * 16 + fr) * 1024 + col0;
                    if (first) { const float* rowp = rin + ro;
#pragma unroll
                        for (int bj = 0; bj < 2; ++bj)
#pragma unroll
                            for (int n = 0; n < 2; ++n) xv[mm][bj][n] = *(const f32x4*)(rowp + bj * HALF + n * 4); }
                    else { const bf16_t* rowp = XR + (size_t)u.pm * BM * 1024 + ro;
#pragma unroll
                        for (int bj = 0; bj < 2; ++bj) { const u32x4 w = *(const u32x4*)(rowp + bj * HALF);
                            xv[mm][bj][0] = (f32x4){__builtin_bit_cast(float, w.x << 16), __builtin_bit_cast(float, w.x & 0xffff0000u), __builtin_bit_cast(float, w.y << 16), __builtin_bit_cast(float, w.y & 0xffff0000u)};
                            xv[mm][bj][1] = (f32x4){__builtin_bit_cast(float, w.z << 16), __builtin_bit_cast(float, w.z & 0xffff0000u), __builtin_bit_cast(float, w.w << 16), __builtin_bit_cast(float, w.w & 0xffff0000u)}; } } }
#pragma unroll
                for (int mm = 0; mm < 2; ++mm) { bf16_t* rowp = XR + ((size_t)u.pm * BM + ai * HALF + wr * 64 + (2 * mp + mm) * 16 + fr) * 1024 + col0;
#pragma unroll
                    for (int bj = 0; bj < 2; ++bj) { const f32x4 o0 = xv[mm][bj][0] + gv[bj][0] * acc[ai][bj][2 * mp + mm][0], o1 = xv[mm][bj][1] + gv[bj][1] * acc[ai][bj][2 * mp + mm][1];
                        u32x4 w; w.x = cvt_pk_bf16(o0[0], o0[1]); w.y = cvt_pk_bf16(o0[2], o0[3]); w.z = cvt_pk_bf16(o1[0], o1[1]); w.w = cvt_pk_bf16(o1[2], o1[3]);
                        *(u32x4*)(rowp + bj * HALF) = w; } }
                asm volatile("" ::: "memory");
            }
    }
};
struct EpiSwiGLU {
    static constexpr bool PERM = false, AFTER_DRAIN = false, PRE = false;
    bf16_t* ACT; int ntn;
    __device__ __forceinline__ void operator()(const f32x4 (&acc)[2][2][4][2], const Unit& u, int wr_, int wc_, int fr_, int fq_) const {
        int wr = wr_, wc = wc_, fr = fr_, fq = fq_; asm volatile("" : "+s"(wr), "+s"(wc), "+v"(fr), "+v"(fq));
        const int pnl = u.pn % ntn; const int f0 = 128 * pnl + 32 * wc + 8 * fq;
#pragma unroll
        for (int ai = 0; ai < 2; ++ai)
#pragma unroll
            for (int m = 0; m < 4; ++m) { bf16_t* rowp = ACT + ((size_t)u.pm * BM + ai * HALF + wr * 64 + m * 16 + fr) * 2048 + f0;
                u32x4 w;
#pragma unroll
                for (int bj = 0; bj < 2; ++bj) { const f32x4 g = acc[ai][bj][m][0], up = acc[ai][bj][m][1]; f32x4 a;
#pragma unroll
                    for (int q = 0; q < 4; ++q) a[q] = (g[q] * up[q]) * __builtin_amdgcn_rcpf(1.f + __builtin_amdgcn_exp2f(g[q]));
                    if (bj == 0) { w.x = cvt_pk_bf16(a[0], a[1]); w.y = cvt_pk_bf16(a[2], a[3]); } else { w.z = cvt_pk_bf16(a[0], a[1]); w.w = cvt_pk_bf16(a[2], a[3]); } }
                *(u32x4*)rowp = w; }
    }
};
constexpr int YP_ROW0 = NSLOT;
struct EpiDown {
    static constexpr bool PERM = false, AFTER_DRAIN = false, PRE = true;
    bf16_t* Y; const float* selg; int ntn; PG8_LAS float* gl;
    __device__ __forceinline__ void pre(const Unit& u, int wid, int lane) const { if (wid < 4) __builtin_amdgcn_global_load_lds((const unsigned*)(selg + (size_t)u.pm * BM + wid * 64 + lane), (PG8_LAS unsigned*)(gl + u.par * 256 + wid * 64), 4, 0, 0); }
    __device__ __forceinline__ void operator()(const f32x4 (&acc)[2][2][4][2], const Unit& u, int wr_, int wc_, int fr_, int fq_) const {
        int wr = wr_, wc = wc_, fr = fr_, fq = fq_; asm volatile("" : "+s"(wr), "+s"(wc), "+v"(fr), "+v"(fq));
        const int pnl = u.pn % ntn; const int col0 = pnl * BM + wc * 32 + 8 * fq;
        const size_t rowb = u.kq < 0 ? (size_t)u.pm * BM : (size_t)(YP_ROW0 + 4096 * u.kq) + (size_t)(u.pm - 256) * BM;
        float gts[2][4];
#pragma unroll
        for (int ai = 0; ai < 2; ++ai)
#pragma unroll
            for (int m = 0; m < 4; ++m) gts[ai][m] = gl[u.par * 256 + ai * HALF + wr * 64 + m * 16 + fr];
#pragma unroll
        for (int ai = 0; ai < 2; ++ai)
#pragma unroll
            for (int m = 0; m < 4; ++m) { const size_t row = rowb + ai * HALF + wr * 64 + m * 16 + fr; const float gt = gts[ai][m]; bf16_t* rowp = Y + row * 1024 + col0;
#pragma unroll
                for (int bj = 0; bj < 2; ++bj) { const f32x4 o0 = acc[ai][bj][m][0] * gt, o1 = acc[ai][bj][m][1] * gt; u32x4 w; w.x = cvt_pk_bf16(o0[0], o0[1]); w.y = cvt_pk_bf16(o0[2], o0[3]); w.z = cvt_pk_bf16(o1[0], o1[1]); w.w = cvt_pk_bf16(o1[2], o1[3]);
                    *(u32x4*)(rowp + bj * HALF) = w; } }
    }
};
struct MoeOrder {
    int nMe, nN, nwg, G, c;
    __device__ void init(int nMe_, int nN_, int G_, int c_) { nMe = nMe_; nN = nN_; nwg = 16 * nMe * nN; G = G_; c = c_; }
    __device__ bool next(int i, Unit& u) const {
        const int L = i * G + c; if (L >= nwg) return false;
        int wgid = L; { const int q = nwg / NXCD, r = nwg % NXCD, xcd = wgid % NXCD, off = wgid / NXCD; wgid = (xcd < r ? xcd * (q + 1) : r * (q + 1) + (xcd - r) * q) + off; }
        const int per = nMe * nN, e = wgid / per, idx = wgid - e * per;
        const int nig = WGM * nN, gid = idx / nig, fm = gid * WGM, gsz = (nMe - fm) < WGM ? (nMe - fm) : WGM;
        const int pml = fm + ((idx % nig) % gsz), pnl = (idx % nig) / gsz;
        u.pm = pml < 8 ? e * 8 + pml : (pml < 16 ? (16 + e) * 8 + (pml - 8) : 256 + e);
        u.pn = e * nN + pnl; return true;
    }
    __device__ __forceinline__ void a_ready(const Unit&) const {}
    __device__ __forceinline__ void done(const Unit&) const {}
};
struct MoeSplitOrder {
    MoeOrder lat; int G, c;
    __device__ void init(int G_, int c_) { lat.init(16, 4, G_, c_); G = G_; c = c_; }
    __device__ bool next(int i, Unit& u) const {
        Unit v; v.pm = 0; v.pn = 0; const bool isl = lat.next(i, v);
        const int Lq = i * G + c - lat.nwg; if (!isl && Lq >= 256) return false;
        const int xcd = Lq & (NXCD - 1), off = Lq >> 3, e = 2 * xcd + (off >> 4), kq = off & 3;
        u.pm = isl ? v.pm : 256 + e; u.pn = isl ? v.pn : e * 4 + ((off >> 2) & 3); u.kq = isl ? -1 : kq; u.kt0 = isl ? 0 : 8 * kq; u.nkt = isl ? 32 : 8; return true;
    }
    __device__ __forceinline__ void a_ready(const Unit&) const {}
    __device__ __forceinline__ void done(const Unit&) const {}
};
struct MoeCtxLastOrder {
    MoeOrder lat; int G, c;
    __device__ void init(int G_, int c_) { lat.init(16, 16, G_, c_); G = G_; c = c_; }
    __device__ bool next(int i, Unit& u) const {
        Unit v; v.pm = 0; v.pn = 0; const bool isl = lat.next(i, v);
        const int Lq = i * G + c - lat.nwg; if (!isl && Lq >= 256) return false;
        const int xcd = Lq & (NXCD - 1), off = Lq >> 3, e = 2 * xcd + (off >> 4);
        u.pm = isl ? v.pm : 256 + e; u.pn = isl ? v.pn : e * 16 + (off & 15); return true;
    }
    __device__ __forceinline__ void a_ready(const Unit&) const {}
    __device__ __forceinline__ void done(const Unit&) const {}
};
struct DenseOrder {
    int nM, nN, nwg, G, c, skipctx;
    __device__ void init(int M, int N, int G_, int c_, int skipctx_ = 0) { nM = M / BM; nN = N / BM; nwg = nM * nN; G = G_; c = c_; skipctx = skipctx_; }
    __device__ bool next(int i, Unit& u) const {
        const int L = i * G + c; if (L >= nwg) return false;
        int wgid = L; { const int q = nwg / NXCD, r = nwg % NXCD, xcd = wgid % NXCD, off = wgid / NXCD; wgid = (xcd < r ? xcd * (q + 1) : r * (q + 1) + (xcd - r) * q) + off; }
        const int nig = WGM * nN, gid = wgid / nig, fm = gid * WGM, gsz = (nM - fm) < WGM ? (nM - fm) : WGM;
        u.pm = fm + ((wgid % nig) % gsz); u.pn = (wgid % nig) / gsz; if (skipctx) u.pm += 1 + (u.pm >= 64 ? 1 : 0); return true;
    }
    __device__ __forceinline__ void a_ready(const Unit&) const {}
    __device__ __forceinline__ void done(const Unit&) const {}
};
struct DenseSplitOrder {
    DenseOrder lat; int G, c;
    __device__ void init(int G_, int c_) { lat.init(NB * SEQ, D, G_, c_, 1); G = G_; c = c_; }
    __device__ bool next(int i, Unit& u) const {
        Unit v; v.pm = 0; v.pn = 0; const bool isl = lat.next(i, v);
        const int Lq = i * G + c - lat.nwg; if (!isl && Lq >= 32) return false;
        const int xcd = Lq & (NXCD - 1), kq = (Lq >> 3) & 3;
        u.pm = isl ? v.pm : ((xcd >> 2) ? 65 : 0); u.pn = isl ? v.pn : (xcd & 3); u.kq = isl ? -1 : kq; u.kt0 = isl ? 0 : 4 * kq; u.nkt = isl ? 16 : 4; return true;
    }
    __device__ __forceinline__ void a_ready(const Unit&) const {}
    __device__ __forceinline__ void done(const Unit&) const {}
};

template <class Epi, class Sched, bool ALIGN_EPI = false, bool SP2 = false, bool GATHER = false, bool BTILED = true, bool SPLITK = false, bool THIN = false>
__device__ __forceinline__ void gemm_phase(PG8_LAS unsigned char* lds, const Gemm g, const Sched& S, const Epi& E) {
    const int tid = otid(), wid = __builtin_amdgcn_readfirstlane(tid >> 6), lane = tid & 63, wr = wid >> 2, wc = wid & 3, fr = lane & 15, fq = lane >> 4;
    const int K = g.K, nt = K / BK;
    static_assert(!GATHER || SP2, "GATHER is wired into the SP2 loop only");
    unsigned voffA[2], voffB[2], goC[2][2], goN[2][2]; int gR[2]; unsigned gC[2];
#pragma unroll
    for (int i = 0; i < 2; ++i) { int R, C; stage_rc(tid * 16 + i * 8192, R, C); const int Rb = Epi::PERM ? ((R & ~31) + perm32(R & 31)) : R;
        voffA[i] = (unsigned)(R * K + C) * 2u; voffB[i] = BTILED ? (unsigned)(tid * 16 + i * 8192) : (unsigned)(Rb * K + C) * 2u; gR[i] = R; gC[i] = (unsigned)C * 2u; }
    static_assert(!BTILED || !Epi::PERM, "BTILED: the weight copy is already in LDS image order (no perm32)");
    PG8_LAS int* gix = (PG8_LAS int*)(lds + STAGE_BYTES + 64);
    const size_t kstep = (size_t)(BK * 2);
    const size_t kstepB = BTILED ? (size_t)HTB : kstep;
    const size_t hstep = (size_t)HALF * K * 2;
    const size_t tstep = 2 * hstep;
    const unsigned ldsw = (unsigned)wid * 1024u;
    const int aoff = lds_byte(wr * 64 + fr, fq * 8), boff = lds_byte(wc * 32 + fr, fq * 8);
#define PG8_SA(b, h) (((b) * 2 + (h)) * HTB)
#define PG8_SB(b, h) ((4 + (b) * 2 + (h)) * HTB)
#define PG8_STAGE(bufoff, gbase, voff) do { _Pragma("unroll") for (int _i = 0; _i < 2; ++_i) \
        __builtin_amdgcn_global_load_lds((const unsigned*)((const char*)(gbase) + (voff)[_i]), (PG8_LAS unsigned*)(lds + (bufoff) + ldsw + _i * 8192), 16, 0, 0); } while (0)
#define PG8_STAGE_A(bufoff, ptr, kb, h, NX) do { if constexpr (GATHER) { const char* _gb = (const char*)g.A + (kb); const unsigned _v0 = (NX) ? goN[h][0] : goC[h][0], _v1 = (NX) ? goN[h][1] : goC[h][1]; \
        __builtin_amdgcn_global_load_lds((const unsigned*)(_gb + _v0), (PG8_LAS unsigned*)(lds + (bufoff) + ldsw), 16, 0, 0); __builtin_amdgcn_global_load_lds((const unsigned*)(_gb + _v1), (PG8_LAS unsigned*)(lds + (bufoff) + ldsw + 8192), 16, 0, 0); } \
    else { PG8_STAGE(bufoff, ptr, voffA); } } while (0)
#define PG8_LDA(dst, b, h) do { _Pragma("unroll") for (int m = 0; m < 4; ++m) _Pragma("unroll") for (int k = 0; k < 2; ++k) dst[m][k] = *(const PG8_LAS bf16x8*)(lds + PG8_SA(b, h) + aoff + m * 2048 + k * 1024); } while (0)
#define PG8_LDB(dst, b, h) do { _Pragma("unroll") for (int n = 0; n < 2; ++n) _Pragma("unroll") for (int k = 0; k < 2; ++k) dst[n][k] = *(const PG8_LAS bf16x8*)(lds + PG8_SB(b, h) + boff + n * 2048 + k * 1024); } while (0)
#define PG8_MMA(ai, bj, At, Bt) do { __builtin_amdgcn_s_setprio(1); _Pragma("unroll") for (int m = 0; m < 4; ++m) _Pragma("unroll") for (int n = 0; n < 2; ++n) _Pragma("unroll") for (int k = 0; k < 2; ++k) \
        acc[ai][bj][m][n] = __builtin_amdgcn_mfma_f32_16x16x32_bf16(Bt[n][k], At[m][k], acc[ai][bj][m][n], 0, 0, 0); __builtin_amdgcn_s_setprio(0); } while (0)
#define PG8_WAIT_V(n) asm volatile("s_waitcnt vmcnt(" #n ")" ::: "memory")
#define PG8_WAIT_L(n) asm volatile("s_waitcnt lgkmcnt(" #n ")" ::: "memory")
#define PG8_BAR __builtin_amdgcn_s_barrier()
#define PG8_SCHED __builtin_amdgcn_sched_barrier(0)
    Unit cur, nxt; int ui = 0;
    if (!S.next(0, cur)) return;
    cur.par = 0;
    f32x4 acc[2][2][4][2];
#pragma unroll
    for (int a = 0; a < 2; ++a)
#pragma unroll
        for (int b = 0; b < 2; ++b)
#pragma unroll
            for (int m = 0; m < 4; ++m)
#pragma unroll
                for (int n = 0; n < 2; ++n) acc[a][b][m][n] = (f32x4){0.f, 0.f, 0.f, 0.f};
    bf16x8 At[4][2], B0[2][2], B1[2][2];
    const char* cA = (const char*)g.A + (size_t)cur.pm * tstep; const char* cB = (const char*)g.Bt + (size_t)cur.pn * tstep;
    if constexpr (SPLITK) { cA += (size_t)cur.kt0 * kstep; cB += (size_t)cur.kt0 * kstepB; }
    if constexpr (GATHER) {
#pragma unroll
        for (int h = 0; h < 2; ++h)
#pragma unroll
            for (int i = 0; i < 2; ++i) { goC[h][i] = (unsigned)g.gidx[(size_t)cur.pm * BM + h * HALF + gR[i]] * (unsigned)(K * 2) + gC[i]; goN[h][i] = goC[h][i]; } }
    S.a_ready(cur);
    if constexpr (SP2) {
        PG8_STAGE(PG8_SB(0, 0), cB, voffB); PG8_STAGE(PG8_SB(0, 1), cB + hstep, voffB); PG8_STAGE_A(PG8_SA(0, 0), cA, 0, 0, false); PG8_STAGE_A(PG8_SA(0, 1), cA + hstep, 0, 1, false);
        if (wr == 1) PG8_BAR;
        PG8_WAIT_V(2); PG8_BAR;
        PG8_STAGE(PG8_SB(1, 0), cB + kstepB, voffB); PG8_STAGE_A(PG8_SA(1, 0), cA + kstep, kstep, 0, false); PG8_STAGE(PG8_SB(1, 1), cB + hstep + kstepB, voffB);
        PG8_WAIT_V(6); PG8_BAR;
    } else {
        PG8_STAGE(PG8_SB(0, 0), cB, voffB); PG8_STAGE(PG8_SA(0, 0), cA, voffA); PG8_STAGE(PG8_SB(0, 1), cB + hstep, voffB); PG8_STAGE(PG8_SA(0, 1), cA + hstep, voffA);
        if (wr == 1) PG8_BAR;
        PG8_WAIT_V(4); PG8_BAR;
        PG8_STAGE(PG8_SB(1, 0), cB + kstepB, voffB); PG8_STAGE(PG8_SA(1, 0), cA + kstep, voffA); PG8_STAGE(PG8_SB(1, 1), cB + hstep + kstepB, voffB);
        PG8_WAIT_V(6); PG8_BAR;
    }
    for (;;) {
        const bool has_next = S.next(ui + 1, nxt);
        nxt.par = (ui + 1) & 1;
        const char* nA = has_next ? (const char*)g.A + (size_t)nxt.pm * tstep + (SPLITK ? (size_t)nxt.kt0 * kstep : (size_t)0) : cA; const char* nB = has_next ? (const char*)g.Bt + (size_t)nxt.pn * tstep + (SPLITK ? (size_t)nxt.kt0 * kstepB : (size_t)0) : cB;
        const int ntc = SPLITK ? cur.nkt : nt;
        const bool thin = THIN && cur.pm >= 256;
        const bool thin1 = thin && wr == 1;
        if constexpr (Epi::PRE) E.pre(cur, wid, lane);
        if constexpr (GATHER) { if (has_next && wid < 4) __builtin_amdgcn_global_load_lds((const unsigned*)(g.gidx + (size_t)nxt.pm * BM + wid * 64 + lane), (PG8_LAS unsigned*)(gix + ((ui + 1) & 1) * 256 + wid * 64), 4, 0, 0); }
        for (int t = 0; t < ntc; t += 2) {
            const bool last = (t == ntc - 2);
            const char* a1 = cA + (size_t)(t + 1) * kstep;
            const char* a2 = last ? nA : cA + (size_t)(t + 2) * kstep; const char* b2 = last ? nB : cB + (size_t)(t + 2) * kstepB;
            const char* a3 = a2 + kstep; const char* b3 = b2 + kstepB;
            if (last && has_next) S.a_ready(nxt);
            const size_t kb2 = last ? (size_t)0 : (size_t)(t + 2) * kstep;
            if constexpr (GATHER) { if (last && has_next) {
#pragma unroll
                for (int h = 0; h < 2; ++h)
#pragma unroll
                    for (int i = 0; i < 2; ++i) goN[h][i] = (unsigned)gix[((ui + 1) & 1) * 256 + h * HALF + gR[i]] * (unsigned)(K * 2) + gC[i]; } }
            if constexpr (SP2) {
            PG8_LDB(B0, 0, 0); PG8_LDB(B1, 0, 1); PG8_SCHED; PG8_LDA(At, 0, 0); PG8_STAGE_A(PG8_SA(1, 1), a1 + hstep, (size_t)(t + 1) * kstep, 1, false);
            PG8_WAIT_V(8); PG8_WAIT_L(0); PG8_BAR; if (!thin1) { PG8_MMA(0, 0, At, B0); PG8_MMA(0, 1, At, B1); } PG8_BAR; PG8_SCHED;
            PG8_LDA(At, 0, 1); PG8_STAGE(PG8_SB(0, 0), b2, voffB); PG8_STAGE(PG8_SB(0, 1), b2 + hstep, voffB); PG8_STAGE_A(PG8_SA(0, 0), a2, kb2, 0, last);
            PG8_WAIT_V(8); PG8_WAIT_L(0); PG8_BAR; if (!thin) { PG8_MMA(1, 0, At, B0); PG8_MMA(1, 1, At, B1); } PG8_BAR; PG8_SCHED;
            PG8_LDB(B0, 1, 0); PG8_LDB(B1, 1, 1); PG8_SCHED; PG8_LDA(At, 1, 0); PG8_STAGE_A(PG8_SA(0, 1), a2 + hstep, kb2, 1, last);
            PG8_WAIT_V(8); PG8_WAIT_L(0); PG8_BAR; if (!thin1) { PG8_MMA(0, 0, At, B0); PG8_MMA(0, 1, At, B1); } PG8_BAR; PG8_SCHED;
            PG8_LDA(At, 1, 1); PG8_STAGE(PG8_SB(1, 0), b3, voffB); PG8_STAGE(PG8_SB(1, 1), b3 + hstep, voffB); PG8_STAGE_A(PG8_SA(1, 0), a3, kb2 + kstep, 0, last);
            PG8_WAIT_V(8); PG8_WAIT_L(0); PG8_BAR; if (!thin) { PG8_MMA(1, 0, At, B0); PG8_MMA(1, 1, At, B1); } PG8_BAR; PG8_SCHED;
            } else {
            PG8_LDB(B0, 0, 0); PG8_SCHED; PG8_LDA(At, 0, 0); PG8_STAGE(PG8_SA(1, 1), a1 + hstep, voffA);
            PG8_WAIT_L(8); PG8_BAR; PG8_WAIT_L(0); PG8_MMA(0, 0, At, B0); PG8_BAR; PG8_SCHED;
            PG8_LDB(B1, 0, 1); PG8_STAGE(PG8_SB(0, 0), b2, voffB);
            PG8_BAR; PG8_WAIT_L(0); PG8_MMA(0, 1, At, B1); PG8_BAR;
            PG8_LDA(At, 0, 1); PG8_STAGE(PG8_SA(0, 0), a2, voffA);
            PG8_BAR; PG8_WAIT_L(0); PG8_MMA(1, 0, At, B0); PG8_BAR; PG8_SCHED;
            PG8_STAGE(PG8_SB(0, 1), b2 + hstep, voffB);
            PG8_WAIT_V(6); PG8_BAR; PG8_MMA(1, 1, At, B1); PG8_BAR;
            PG8_LDB(B0, 1, 0); PG8_SCHED; PG8_LDA(At, 1, 0); PG8_STAGE(PG8_SA(0, 1), a2 + hstep, voffA);
            PG8_WAIT_L(8); PG8_BAR; PG8_WAIT_L(0); PG8_MMA(0, 0, At, B0); PG8_BAR; PG8_SCHED;
            PG8_LDB(B1, 1, 1); PG8_STAGE(PG8_SB(1, 0), b3, voffB);
            PG8_BAR; PG8_WAIT_L(0); PG8_MMA(0, 1, At, B1); PG8_BAR;
            PG8_LDA(At, 1, 1); PG8_STAGE(PG8_SA(1, 0), a3, voffA);
            PG8_BAR; PG8_WAIT_L(0); PG8_MMA(1, 0, At, B0); PG8_BAR; PG8_SCHED;
            PG8_STAGE(PG8_SB(1, 1), b3 + hstep, voffB);
            PG8_WAIT_V(6); PG8_BAR; PG8_MMA(1, 1, At, B1); PG8_BAR;
            }
        }
        if constexpr (ALIGN_EPI) { if (wr == 0) PG8_BAR; }
        if constexpr (!Epi::AFTER_DRAIN) { E(acc, cur, wr, wc, fr, fq); S.done(cur); }
        if (!has_next) break;
#pragma unroll
        for (int a = 0; a < 2; ++a)
#pragma unroll
            for (int b = 0; b < 2; ++b)
#pragma unroll
                for (int m = 0; m < 4; ++m)
#pragma unroll
                    for (int n = 0; n < 2; ++n) acc[a][b][m][n] = (f32x4){0.f, 0.f, 0.f, 0.f};
        cur = nxt; cA = nA; cB = nB; ++ui;
        if constexpr (GATHER) {
#pragma unroll
            for (int h = 0; h < 2; ++h)
#pragma unroll
                for (int i = 0; i < 2; ++i) goC[h][i] = goN[h][i]; }
        if constexpr (ALIGN_EPI) { if (wr == 1) PG8_BAR; }
    }
    PG8_WAIT_V(0);
    if constexpr (!ALIGN_EPI) { if (wr == 0) PG8_BAR; }
    PG8_BAR;
    if constexpr (Epi::AFTER_DRAIN) { E.fused(acc, cur, wr, wc, fr, fq, lds, wid, lane); S.done(cur); }
#undef PG8_SA
#undef PG8_SB
#undef PG8_STAGE
#undef PG8_STAGE_A
#undef PG8_LDA
#undef PG8_LDB
#undef PG8_MMA
#undef PG8_WAIT_V
#undef PG8_WAIT_L
#undef PG8_BAR
#undef PG8_SCHED
}
}


__device__ __forceinline__ void phase_qkv(const Params& P, int layer, LAS unsigned char* lds) {
    unsigned char* const ws = ows(P);
    pg8::Gemm g{(const bf16_t*)(ws + WS_H), (const bf16_t*)(ws + WS_WQKV) + (size_t)layer * QKVW * D, R, QKVW, D};
    pg8::DenseOrder S; S.init(R, QKVW, (int)gridDim.x, (int)blockIdx.x);
    LAS float* ropel = (LAS float*)(lds + pg8::STAGE_BYTES + 4608);
    { const int tid = otid(); ((LAS f32x4*)ropel)[tid] = ((const f32x4*)(ws + WS_ROPE))[tid]; __syncthreads(); }
    pg8::EpiQKV E{ws, (const float*)(ws + WS_ROPE), P.q_norm_g + (layer >> 1) * 64, P.k_norm_g + (layer >> 1) * 64, (layer & 1) == 0 ? 1 : 0, ropel};
    pg8::gemm_phase<pg8::EpiQKV, pg8::DenseOrder, true, true>(lds, g, S, E);
}
__device__ __forceinline__ void phase_oproj(const Params& P, int layer, LAS unsigned char* lds) {
    unsigned char* const ws = ows(P);
    pg8::Gemm g{(const bf16_t*)(ws + WS_O), (const bf16_t*)(ws + WS_WO) + (size_t)layer * D * D, R, D, D};
    pg8::EpiResid E{(bf16_t*)(ws + WS_XR), (const float*)(ws + WS_MOD) + (size_t)layer * 3 * 6144, P.x, P.ctx, layer == 0 ? 1 : 0, (float*)(ws + WS_XSEL)};
    if (layer == DEPTH - 1) { pg8::DenseOrder S; S.init(NB * SEQ, D, (int)gridDim.x, (int)blockIdx.x, 1); pg8::gemm_phase<pg8::EpiResid, pg8::DenseOrder, true, true>(lds, g, S, E); }
    else { pg8::DenseSplitOrder S; S.init((int)gridDim.x, (int)blockIdx.x); pg8::gemm_phase<pg8::EpiResid, pg8::DenseSplitOrder, true, true, false, true, true>(lds, g, S, E); }
}
__device__ __forceinline__ void phase_gateup(const Params& P, int layer, LAS unsigned char* lds) {
    unsigned char* const ws = ows(P);
    pg8::Gemm g{(const bf16_t*)(ws + WS_H), (const bf16_t*)(ws + WS_WGU) + (size_t)layer * NE * (2 * DE) * D, NSLOT, 2 * DE, D, (const int*)(ws + WS_SELI)};
    pg8::EpiSwiGLU E{(bf16_t*)(ws + WS_ACT), 16};
    if (layer == DEPTH - 1) { pg8::MoeOrder S; S.init(16, 16, (int)gridDim.x, (int)blockIdx.x); pg8::gemm_phase<pg8::EpiSwiGLU, pg8::MoeOrder, true, true, true>(lds, g, S, E); }
    else { pg8::MoeCtxLastOrder S; S.init((int)gridDim.x, (int)blockIdx.x); pg8::gemm_phase<pg8::EpiSwiGLU, pg8::MoeCtxLastOrder, true, true, true, true, false, true>(lds, g, S, E); }
}
__device__ __forceinline__ void phase_down(const Params& P, int layer, LAS unsigned char* lds) {
    unsigned char* const ws = ows(P);
    pg8::Gemm g{(const bf16_t*)(ws + WS_ACT), (const bf16_t*)(ws + WS_WD) + (size_t)layer * NE * D * DE, NSLOT, D, DE};
    pg8::EpiDown E{(bf16_t*)(ws + WS_Y), (const float*)(ws + WS_SELG), 4, (LAS float*)(lds + pg8::STAGE_BYTES + 2112)};
    if (layer == DEPTH - 1) { pg8::MoeOrder S; S.init(16, 4, (int)gridDim.x, (int)blockIdx.x); pg8::gemm_phase<pg8::EpiDown, pg8::MoeOrder, true, true>(lds, g, S, E); }
    else { pg8::MoeSplitOrder S; S.init((int)gridDim.x, (int)blockIdx.x); pg8::gemm_phase<pg8::EpiDown, pg8::MoeSplitOrder, true, true, false, true, true, true>(lds, g, S, E); }
}
namespace attn_body {
using bf16=__hip_bfloat16;
using bf16x8=__attribute__((ext_vector_type(8)))short;
using s16x4=__attribute__((ext_vector_type(4)))short;
using f32x16=__attribute__((ext_vector_type(16)))float;
using u32x4=__attribute__((ext_vector_type(4)))unsigned;
constexpr int D=64,DM=1024,KP=256;
constexpr int NW=8,QBLK=32,QB=QBLK*NW,KVBLK=64;
__device__ __forceinline__ int crow(int r,int hi){return (r&3)+8*(r>>2)+4*hi;}
#define SBAR() __builtin_amdgcn_sched_barrier(0)
__device__ __forceinline__ void wmask(f32x16&p0,f32x16&p1,int dk0,int hi){
  const float NEG=-INFINITY; const int kb=dk0+4*hi;
  #pragma unroll
  for(int r=0;r<16;++r){const int dk=kb+(r&3)+8*(r>>2); if(dk<-128||dk>128)p0[r]=NEG; if(dk+32<-128||dk+32>128)p1[r]=NEG;}
}

constexpr int NSLOT=3, SLOTB=8192;
constexpr int LDS_K=0, LDS_V=NSLOT*SLOTB, LDS_WS=2*NSLOT*SLOTB, LDS_OST=LDS_WS+NW*64*4, LDS_BYTES=LDS_OST+NW*4096;
constexpr float C2=0.125f*1.4426950408889634f;
__device__ __forceinline__ void glds16(const void*gsrc,unsigned lds_dst){unsigned keep;
  asm volatile("s_mov_b32 %0, m0\n\ts_mov_b32 m0, %2\n\ts_nop 0\n\tglobal_load_lds_dwordx4 %1, off\n\ts_mov_b32 m0, %0":"=&s"(keep):"v"(gsrc),"s"(lds_dst):"memory");}
__device__ __forceinline__ float max3f(float a,float b,float c){float r;asm("v_max3_f32 %0, %1, %2, %3":"=v"(r):"v"(a),"v"(b),"v"(c));return r;}
__device__ __forceinline__ float max2f(float a,float b){float r;asm("v_max_f32_e32 %0, %1, %2":"=v"(r):"v"(a),"v"(b));return r;}
__device__ __forceinline__ float fadd_s(float a,float b){float r;asm("v_add_f32_e32 %0, %1, %2":"=v"(r):"v"(a),"v"(b));return r;}
__device__ __forceinline__ float fsub_s(float a,float b){float r;asm("v_sub_f32_e32 %0, %1, %2":"=v"(r):"v"(a),"v"(b));return r;}
typedef float f32x2_t __attribute__((ext_vector_type(2))); typedef __bf16 bf16x2_t __attribute__((ext_vector_type(2)));
__device__ __forceinline__ unsigned cvtpk_s(float lo,float hi){f32x2_t v={lo,hi};bf16x2_t b=__builtin_convertvector(v,bf16x2_t);return __builtin_bit_cast(unsigned,b);}
#define WAIT_BAR(N) asm volatile("s_waitcnt vmcnt(" #N ") lgkmcnt(0)\n\ts_barrier":::"memory")

__device__ __forceinline__ void qkt(f32x16&p0,f32x16&p1,const char*Kslot,const bf16x8*qr,const f32x16&negm,int r32,int hi){
  const char*kb=Kslot+hi*1024+r32*16;
  #pragma unroll
  for(int d0=0;d0<4;++d0){
    const bf16x8 b0=*reinterpret_cast<const bf16x8*>(kb+d0*2048);
    const bf16x8 b1=*reinterpret_cast<const bf16x8*>(kb+d0*2048+512);
    if(d0==0){p0=__builtin_amdgcn_mfma_f32_32x32x16_bf16(b0,qr[0],negm,0,0,0);p1=__builtin_amdgcn_mfma_f32_32x32x16_bf16(b1,qr[0],negm,0,0,0);}
    else{p0=__builtin_amdgcn_mfma_f32_32x32x16_bf16(b0,qr[d0],p0,0,0,0);p1=__builtin_amdgcn_mfma_f32_32x32x16_bf16(b1,qr[d0],p1,0,0,0);}}
}
typedef __attribute__((address_space(3))) const char* lds_cptr;
typedef short v4i16_t __attribute__((ext_vector_type(4)));
__device__ __forceinline__ void kload8(bf16x8*kf,lds_cptr kp){
  kf[0]=*(const __attribute__((address_space(3))) bf16x8*)(kp);      kf[1]=*(const __attribute__((address_space(3))) bf16x8*)(kp+512);
  kf[2]=*(const __attribute__((address_space(3))) bf16x8*)(kp+2048); kf[3]=*(const __attribute__((address_space(3))) bf16x8*)(kp+2560);
  kf[4]=*(const __attribute__((address_space(3))) bf16x8*)(kp+4096); kf[5]=*(const __attribute__((address_space(3))) bf16x8*)(kp+4608);
  kf[6]=*(const __attribute__((address_space(3))) bf16x8*)(kp+6144); kf[7]=*(const __attribute__((address_space(3))) bf16x8*)(kp+6656);
}
__device__ __forceinline__ void kload2(bf16x8*kf,lds_cptr kp,int j){ kf[2*j]=*(const __attribute__((address_space(3))) bf16x8*)(kp+j*2048); kf[2*j+1]=*(const __attribute__((address_space(3))) bf16x8*)(kp+j*2048+512); }
__device__ __forceinline__ s16x4 vtr(lds_cptr p){ return __builtin_bit_cast(s16x4,__builtin_amdgcn_ds_read_tr16_b64_v4i16((__attribute__((address_space(3))) v4i16_t*)p)); }
__device__ __forceinline__ float rowmax(const f32x16&p0,const f32x16&p1){
  float a=max3f(p0[0],p0[1],p1[0]),b=max3f(p0[2],p0[3],p1[1]);a=max3f(a,p1[2],p1[3]);
  #pragma unroll
  for(int r=4;r<16;r+=4){a=max3f(a,p0[r],p0[r+1]);b=max3f(b,p0[r+2],p0[r+3]);a=max3f(a,p1[r],p1[r+1]);b=max3f(b,p1[r+2],p1[r+3]);}
  const float m=max2f(a,b);
  auto rr=__builtin_amdgcn_permlane32_swap(__float_as_uint(m),__float_as_uint(m),false,false);
  return max2f(__uint_as_float(rr[0]),__uint_as_float(rr[1]));
}
__device__ __forceinline__ void pv(f32x16*o,int vb,bf16x8 pa0,bf16x8 pa1,bf16x8 pa2,bf16x8 pa3){
  #pragma unroll
  for(int d0=0;d0<2;++d0){s16x4 lo[4],hi[4];
    #pragma unroll
    for(int ks=0;ks<4;++ks){
      asm volatile("ds_read_b64_tr_b16 %0,%1 offset:%c2":"=&v"(lo[ks]):"v"(vb),"i"(d0*4096+ks*1024):"memory");
      asm volatile("ds_read_b64_tr_b16 %0,%1 offset:%c2":"=&v"(hi[ks]):"v"(vb),"i"(d0*4096+ks*1024+512):"memory");}
    asm volatile("s_waitcnt lgkmcnt(0)":::"memory");SBAR();
    #define PK(k) (bf16x8){lo[k][0],lo[k][1],lo[k][2],lo[k][3],hi[k][0],hi[k][1],hi[k][2],hi[k][3]}
    o[d0]=__builtin_amdgcn_mfma_f32_32x32x16_bf16(pa0,PK(0),o[d0],0,0,0);
    o[d0]=__builtin_amdgcn_mfma_f32_32x32x16_bf16(pa1,PK(1),o[d0],0,0,0);
    o[d0]=__builtin_amdgcn_mfma_f32_32x32x16_bf16(pa2,PK(2),o[d0],0,0,0);
    o[d0]=__builtin_amdgcn_mfma_f32_32x32x16_bf16(pa3,PK(3),o[d0],0,0,0);
    #undef PK
  }
}

#ifndef ATTN_STORE16
#define ATTN_STORE16(p,v) (*(u32x4*)(p)=(v))
#endif
struct AttnUnit { int qrow0, kvrow0, h, nt, lo, t0, kt0; };
template<int THRL,bool WINDOW,bool FIXREF> __device__ __forceinline__ void attn_unit(const AttnUnit u,const bf16*Q,const bf16*__restrict__ K,const bf16*__restrict__ V,bf16*O,char*shm,float sinkl2,float mfix){
  const int tid=otid(),lane=tid&63,r32=lane&31,hi=lane>>5; const int wid=__builtin_amdgcn_readfirstlane(tid>>6);
  const bf16*Qw=Q+((long)u.qrow0+wid*QBLK)*DM+u.h*D;
  const bf16*Kh=K+(long)u.kt0*4096,*Vh=V+(long)u.kt0*4096;
  const unsigned lds0=(unsigned)(uintptr_t)shm;
  float*wsf=(float*)(shm+LDS_WS)+wid*64;
  const bf16*ksrc=Kh+wid*512+lane*8;
  const bf16*vsrc=Vh+(wid>>2)*2048+(16*(wid&3)+(lane>>2))*32+(lane&3)*8;
  const unsigned kdst=lds0+LDS_K+wid*1024, vdst=lds0+LDS_V+wid*1024;
  #define TROW(t) (KVBLK*(t)+((WINDOW&&(t)>=4)?u.lo:0))
  #define DMA_K(t,slot) glds16(ksrc+(long)(TROW(t)>>6)*4096,(unsigned)__builtin_amdgcn_readfirstlane(kdst+(slot)))
  #define DMA_V(t,slot) glds16(vsrc+(long)(TROW(t)>>6)*4096,(unsigned)__builtin_amdgcn_readfirstlane(vdst+(slot)))
  const int vb0=(int)(lds0+LDS_V)+((lane>>4)&1)*32+(lane&3)*8+(4*hi+((lane&15)>>2))*64;
  const char*Kbase=shm+LDS_K; bf16x8 kf[8];
  const lds_cptr shm3=(lds_cptr)shm; const lds_cptr kp0=shm3+LDS_K+hi*1024+r32*16; const lds_cptr vp0=shm3+LDS_V+((lane>>4)&1)*32+(lane&3)*8+(4*hi+((lane&15)>>2))*64;
  const int NT=u.nt;
  DMA_K(0,0);DMA_V(0,0);DMA_K(1,SLOTB);
  bf16x8 qr[4];
  #pragma unroll
  for(int d0=0;d0<4;++d0)qr[d0]=*reinterpret_cast<const bf16x8*>(&Qw[(long)r32*DM+d0*16+hi*8]);
  float mhat=FIXREF?mfix:0.f,l_reg=0.f;f32x16 o[2];o[0]=f32x16{};o[1]=f32x16{};f32x16 negm=f32x16{};
  if(FIXREF){_Pragma("unroll") for(int r=0;r<16;++r)negm[r]=-mfix;} asm volatile("":"+v"(negm));
  const int qrel=wid*QBLK+r32;
  #define CMASK(P0,P1,t) do{ if(WINDOW){ if((t)>=4){ const int kq_=u.lo+KVBLK*((t)-4)-u.t0-wid*QBLK;     \
      if(kq_<31-128||kq_+63>128) wmask(P0,P1,kq_-r32,hi); } } }while(0)
  bool resc=false;
  #define START(P0,P1) do{ resc=false; \
    if constexpr(!FIXREF){ const float rm=rowmax(P0,P1); const float dl=rm; mhat=fadd_s(mhat,dl); \
      _Pragma("unroll") for(int r=0;r<16;++r){P0[r]=fsub_s(P0[r],dl);P1[r]=fsub_s(P1[r],dl);} \
      _Pragma("unroll") for(int r=0;r<16;++r)negm[r]=-mhat; asm volatile("":"+v"(negm)); } \
    _Pragma("unroll") for(int r=0;r<16;++r)P0[r]=__builtin_amdgcn_exp2f(P0[r]); }while(0)
  #define RESC() do{ if(!FIXREF&&resc){ asm volatile("s_waitcnt lgkmcnt(0)":::"memory"); \
      _Pragma("unroll") for(int d_=0;d_<2;++d_) _Pragma("unroll") for(int r=0;r<16;++r)o[d_][r]*=wsf[crow(r,hi)]; } }while(0)
  f32x16 pA0,pA1,pB0,pB1;
  int sl_prev=0,sl_cur=0,sl_next=SLOTB;
  #define ROT() do{sl_prev=sl_cur;sl_cur=sl_next;sl_next=(sl_next==(NSLOT-1)*SLOTB)?0:sl_next+SLOTB;}while(0)
  DMA_K(2,2*SLOTB);
  WAIT_BAR(3);
  qkt(pA0,pA1,Kbase,qr,negm,r32,hi);asm volatile("s_nop 15\n\ts_nop 7":"+v"(pA0),"+v"(pA1));CMASK(pA0,pA1,0);
  START(pA0,pA1);
  _Pragma("unroll") for(int r=0;r<16;++r)pA1[r]=__builtin_amdgcn_exp2f(pA1[r]);
  WAIT_BAR(0);
  DMA_K(3,0);DMA_V(1,SLOTB);
  ROT();
  kload8(kf,kp0+sl_cur);
  WAIT_BAR(2);
  s16x4 vlo[8],vhi[8]; u32x4 pw0,pw1,pw2,pw3;
  #define PKW(P,B) cvtpk_s(P[B],P[B+1])
  #define PAF(k) __builtin_bit_cast(bf16x8,pw##k)
  #define VFR(i) (bf16x8){vlo[i][0],vlo[i][1],vlo[i][2],vlo[i][3],vhi[i][0],vhi[i][1],vhi[i][2],vhi[i][3]}
  #define PIN(x) asm volatile("":"+v"(x))
  #define MX3(a,b,c) __builtin_fmaxf(__builtin_fmaxf((a),(b)),(c))
  #define GAPA(MF,A0,A1,A2,A3,W0,W1,PW) do{ MF; sacc+=A0; sacc+=A1; sacc+=A2; sacc+=A3; PIN(sacc); W0; W1; PIN(PW); SBAR(); }while(0)
  #define EX(v) __builtin_amdgcn_exp2f(v)
  #define GAPB(MF,X,B) do{ MF; X[B]=EX(X[B]); X[B+1]=EX(X[B+1]); X[B+2]=EX(X[B+2]); X[B+3]=EX(X[B+3]); PIN(X); SBAR(); }while(0)
  #define VRD(i) do{ vlo[i]=vtr(vp_+(((i)>>2)*4096+((i)&3)*1024)); vhi[i]=vtr(vp_+(((i)>>2)*4096+((i)&3)*1024+512)); }while(0)
  #define KRD(G,j) do{ if(G){ kload2(kf,kp0+sl_next,j); SBAR(); } }while(0)
  #define STEP(C0,C1,P0,P1,t,GK,GV,GL) do{ SBAR(); \
    const lds_cptr vp_=vp0+sl_prev; \
    VRD(0); SBAR(); float sacc=(P0[0]+P0[1]); \
    GAPA(C0=__builtin_amdgcn_mfma_f32_32x32x16_bf16(kf[0],qr[0],negm,0,0,0), P0[2],P0[3],P0[4],P0[5],     pw0[0]=PKW(P0,0), pw0[1]=PKW(P0,2), pw0); \
    VRD(4); SBAR(); GAPA(C1=__builtin_amdgcn_mfma_f32_32x32x16_bf16(kf[1],qr[0],negm,0,0,0), P0[6],P0[7],P0[8],P0[9],     pw0[2]=PKW(P0,4), pw0[3]=PKW(P0,6), pw0); \
    VRD(1); SBAR(); GAPA(C0=__builtin_amdgcn_mfma_f32_32x32x16_bf16(kf[2],qr[1],C0,0,0,0),   P0[10],P0[11],P0[12],P0[13], pw1[0]=PKW(P0,8), pw1[1]=PKW(P0,10), pw1); \
    VRD(5); SBAR(); GAPA(C1=__builtin_amdgcn_mfma_f32_32x32x16_bf16(kf[3],qr[1],C1,0,0,0),   P0[14],P0[15],P1[0],P1[1],   pw1[2]=PKW(P0,12),pw1[3]=PKW(P0,14), pw1); \
    VRD(2); SBAR(); GAPA(C0=__builtin_amdgcn_mfma_f32_32x32x16_bf16(kf[4],qr[2],C0,0,0,0),   P1[2],P1[3],P1[4],P1[5],     pw2[0]=PKW(P1,0), pw2[1]=PKW(P1,2), pw2); \
    VRD(6); SBAR(); GAPA(C1=__builtin_amdgcn_mfma_f32_32x32x16_bf16(kf[5],qr[2],C1,0,0,0),   P1[6],P1[7],P1[8],P1[9],     pw2[2]=PKW(P1,4), pw2[3]=PKW(P1,6), pw2); \
    VRD(3); SBAR(); GAPA(C0=__builtin_amdgcn_mfma_f32_32x32x16_bf16(kf[6],qr[3],C0,0,0,0),   P1[10],P1[11],P1[12],P1[13], pw3[0]=PKW(P1,8), pw3[1]=PKW(P1,10), pw3); \
    VRD(7); SBAR(); GAPA(C1=__builtin_amdgcn_mfma_f32_32x32x16_bf16(kf[7],qr[3],C1,0,0,0),   P1[14],P1[15],0.f,0.f,       pw3[2]=PKW(P1,12),pw3[3]=PKW(P1,14), pw3); \
    l_reg+=sacc; \
    if(GK){DMA_K((t)+3,sl_cur);} if(GV){DMA_V((t)+1,sl_next);} \
    CMASK(C0,C1,t); \
    if constexpr(!FIXREF){ float a=MX3(C0[0],C0[1],C1[0]),b=MX3(C0[2],C0[3],C1[1]); a=MX3(a,C1[2],C1[3]); \
      _Pragma("unroll") for(int r=4;r<16;r+=4){a=MX3(a,C0[r],C0[r+1]);b=MX3(b,C0[r+2],C0[r+3]);a=MX3(a,C1[r],C1[r+1]);b=MX3(b,C1[r+2],C1[r+3]);} \
      float rm=__builtin_fmaxf(a,b); { auto rr=__builtin_amdgcn_permlane32_swap(__float_as_uint(rm),__float_as_uint(rm),false,false); rm=__builtin_fmaxf(__uint_as_float(rr[0]),__uint_as_float(rr[1])); } \
      resc=false; \
      if(__builtin_expect(__any(rm>(float)THRL),0)){ const float dl=__builtin_fmaxf(rm,0.f); mhat+=dl; \
        _Pragma("unroll") for(int r=0;r<16;++r){C0[r]-=dl;C1[r]-=dl;} \
        _Pragma("unroll") for(int r=0;r<16;++r)negm[r]=-mhat; asm volatile("":"+v"(negm)); \
        const float f=__builtin_amdgcn_exp2f(-dl); l_reg*=f; if(hi==0)wsf[r32]=f; resc=true; } } \
    SBAR(); \
    GAPB(o[0]=__builtin_amdgcn_mfma_f32_32x32x16_bf16(PAF(0),VFR(0),o[0],0,0,0), C0,0); \
    GAPB(o[1]=__builtin_amdgcn_mfma_f32_32x32x16_bf16(PAF(0),VFR(4),o[1],0,0,0), C0,4); \
    KRD(GL,0); GAPB(o[0]=__builtin_amdgcn_mfma_f32_32x32x16_bf16(PAF(1),VFR(1),o[0],0,0,0), C0,8); \
    KRD(GL,1); GAPB(o[1]=__builtin_amdgcn_mfma_f32_32x32x16_bf16(PAF(1),VFR(5),o[1],0,0,0), C0,12); \
    KRD(GL,2); GAPB(o[0]=__builtin_amdgcn_mfma_f32_32x32x16_bf16(PAF(2),VFR(2),o[0],0,0,0), C1,0); \
    KRD(GL,3); GAPB(o[1]=__builtin_amdgcn_mfma_f32_32x32x16_bf16(PAF(2),VFR(6),o[1],0,0,0), C1,4); \
    GAPB(o[0]=__builtin_amdgcn_mfma_f32_32x32x16_bf16(PAF(3),VFR(3),o[0],0,0,0), C1,8); \
    GAPB(o[1]=__builtin_amdgcn_mfma_f32_32x32x16_bf16(PAF(3),VFR(7),o[1],0,0,0), C1,12); \
    }while(0)
  int t=1;
  for(;t+5<NT;t+=2){
    STEP(pB0,pB1,pA0,pA1,t,true,true,true);     WAIT_BAR(2); RESC(); ROT();
    STEP(pA0,pA1,pB0,pB1,t+1,true,true,true);   WAIT_BAR(2); RESC(); ROT();
  }
  #define ENDW(tt) do{ if((tt)+3<NT){WAIT_BAR(2);} else if((tt)+2<NT){WAIT_BAR(1);} else {WAIT_BAR(0);} }while(0)
  for(;t+1<NT;t+=2){
    STEP(pB0,pB1,pA0,pA1,t,(t+3<NT),(t+1<NT),(t+1<NT));       ENDW(t);   RESC(); ROT();
    STEP(pA0,pA1,pB0,pB1,t+1,(t+4<NT),(t+2<NT),(t+2<NT));     ENDW(t+1); RESC(); ROT();
  }
  STEP(pB0,pB1,pA0,pA1,NT-1,false,false,false); RESC();
  { float sacc=pB0[0]+pB0[1]; _Pragma("unroll") for(int r=2;r<16;++r)sacc+=pB0[r]; _Pragma("unroll") for(int r=0;r<16;++r)sacc+=pB1[r]; l_reg+=sacc;
    pw0=(u32x4){PKW(pB0,0),PKW(pB0,2),PKW(pB0,4),PKW(pB0,6)};pw1=(u32x4){PKW(pB0,8),PKW(pB0,10),PKW(pB0,12),PKW(pB0,14)};pw2=(u32x4){PKW(pB1,0),PKW(pB1,2),PKW(pB1,4),PKW(pB1,6)};pw3=(u32x4){PKW(pB1,8),PKW(pB1,10),PKW(pB1,12),PKW(pB1,14)};
    SBAR(); pv(o,vb0+sl_cur,PAF(0),PAF(1),PAF(2),PAF(3)); }
  #undef PKW
  #undef PAF
  #undef VFR
  #undef PIN
  #undef MX3
  #undef GAPA
  #undef GAPB
  #undef EX
  #undef VRD
  #undef KRD
  #undef STEP
  #undef ENDW
  {auto rr=__builtin_amdgcn_permlane32_swap(__float_as_uint(l_reg),__float_as_uint(l_reg),false,false);l_reg=__uint_as_float(rr[0])+__uint_as_float(rr[1]);}
  if(WINDOW)l_reg+=__builtin_amdgcn_exp2f(sinkl2-mhat);
  if(hi==0)wsf[32+r32]=l_reg;asm volatile("s_waitcnt lgkmcnt(0)":::"memory");
  float rli[16];
  #pragma unroll
  for(int r=0;r<16;++r)rli[r]=__builtin_amdgcn_rcpf(wsf[32+crow(r,hi)]);
  bf16*Ow=O+((long)u.qrow0+wid*QBLK)*DM+u.h*D;
  { bf16*stg=(bf16*)(shm+LDS_OST)+wid*2048;
    #pragma unroll
    for(int r=0;r<16;++r){const int orow=crow(r,hi);
      #pragma unroll
      for(int d0=0;d0<2;++d0)stg[orow*64+d0*32+r32]=__float2bfloat16(o[d0][r]*rli[r]);}
    asm volatile("s_waitcnt lgkmcnt(0)":::"memory");
    #pragma unroll
    for(int i=0;i<4;++i){const int row=i*8+(lane>>3),ch=lane&7; const u32x4 v=*(const u32x4*)(stg+row*64+ch*8); ATTN_STORE16(Ow+(long)row*DM+ch*8,v);} }
  asm volatile("s_waitcnt lgkmcnt(0)\n\ts_barrier":::"memory");
  #undef DMA_K
  #undef TROW
  #undef DMA_V
  #undef CMASK
  #undef START
  #undef RESC
  #undef ROT
}
constexpr int ATTN_LDS_BYTES=LDS_BYTES;
#undef SBAR
#undef WAIT_BAR
}

template <bool WINDOW>
__device__ __forceinline__ void phase_attn(const Params& P, int layer, char* lds) {
    unsigned char* const ws = ows(P);
    const attn_body::bf16* Q = (const attn_body::bf16*)(ws + WS_Q); const attn_body::bf16* Kb = (const attn_body::bf16*)(ws + WS_K); const attn_body::bf16* Vb = (const attn_body::bf16*)(ws + WS_V);
    attn_body::bf16* O = (attn_body::bf16*)(ws + WS_O);
    const float* sinkp = P.attn_sink + (layer >> 1) * NQH;
    float mfix = 0.f; bool fix = false;
    if (!WINDOW) { const int lane = otid() & 63; float gq = fabsf(P.q_norm_g[(layer >> 1) * 64 + lane]), gk = fabsf(P.k_norm_g[(layer >> 1) * 64 + lane]);
#pragma unroll
        for (int o = 1; o < 64; o <<= 1) { gq = fmaxf(gq, __shfl_xor(gq, o)); gk = fmaxf(gk, __shfl_xor(gk, o)); }
        mfix = __builtin_amdgcn_readfirstlane(8.f * LOG2E * 1.01f * gq * gk + 0.05f); fix = mfix < 40.f; }
    for (int v = blockIdx.x; v < 256; v += gridDim.x) {
        const int xcd = v & 7, cu = v >> 3; const int b = xcd >> 2, kvh = xcd & 3;
        for (int i = 0; i < 9; ++i) {
            attn_body::AttnUnit u; u.kvrow0 = b * RB; u.lo = 0; u.t0 = 0; u.kt0 = (b * 4 + kvh) * 260;
            if (i < 8) { const int n = i * 32 + cu; u.h = kvh * 4 + (n >> 6); const int qb = n & 63; u.t0 = qb * 256; u.qrow0 = b * RB + CTXL + u.t0;
                if (WINDOW) { int lo = u.t0 - 128; if (lo < 0) lo = 0; int hi = u.t0 + 384; if (hi > SEQ) hi = SEQ; u.lo = lo; u.nt = 4 + (hi - lo) / 64; } else u.nt = RB / 64; }
            else { if (cu >= 4 || layer == DEPTH - 1) break; u.h = kvh * 4 + cu; u.qrow0 = b * RB; u.nt = 4; }
            const float sk = WINDOW ? sinkp[u.h] * LOG2E : 0.f;
            if (WINDOW) attn_body::attn_unit<8, true, false>(u, Q, Kb, Vb, O, lds, sk, 0.f);
            else if (fix) attn_body::attn_unit<8, false, true>(u, Q, Kb, Vb, O, lds, 0.f, mfix);
            else attn_body::attn_unit<8, false, false>(u, Q, Kb, Vb, O, lds, 0.f, 0.f);
        }
    }
}

__device__ __forceinline__ int block_excl_scan(int v, LAS int* sm, int& total) {
    const int tid = otid(), lane = tid & 63, wave = tid >> 6;
    int inc = v;
#pragma unroll
    for (int o = 1; o < 64; o <<= 1) { const int t = __shfl_up(inc, o); if (lane >= o) inc += t; }
    __syncthreads();
    if (lane == 63) sm[wave] = inc;
    __syncthreads();
    int base = 0, tot = 0;
#pragma unroll
    for (int w = 0; w < 8; ++w) { const int s = sm[w]; if (w < wave) base += s; tot += s; }
    total = tot;
    return base + inc - v;
}
__device__ __forceinline__ void phase_select(const Params& P, LAS unsigned char* lds, bool last) {
    unsigned char* const ws = ows(P);
    const int tid = otid();
    LAS int* hist = (LAS int*)lds;
    LAS int* tot = hist + 32 * 257;
    LAS int* sm = tot + 256;
    LAS unsigned* bc = (LAS unsigned*)(sm + 16);
    const float* AFFL = (const float*)(ws + WS_AFF); const float* AFFC = AFFL + (size_t)NB * NE * SEQ;
    int* SELI = (int*)(ws + WS_SELI); float* SELG = (float*)(ws + WS_SELG); int* INVT = (int*)(ws + WS_INVT);
    for (int pid = blockIdx.x; pid < (last ? 32 : 64); pid += gridDim.x) {
        const bool isctx = pid >= 32; const int be = pid & 31, b = be >> 4, e = be & 15;
        const int n = isctx ? CTXL : SEQ, kcap = isctx ? CAP_C : CAP_L;
        const float* aff = isctx ? AFFC + (size_t)be * CTXL : AFFL + (size_t)be * SEQ;
        const int cnt = isctx ? (tid < CTXL ? 1 : 0) : 32; const int i0 = isctx ? tid : tid * 32;
        unsigned key[32];
        if (isctx) { key[0] = cnt ? __builtin_bit_cast(unsigned, aff[i0]) : 0u;
#pragma unroll
            for (int i = 1; i < 32; ++i) key[i] = 0u; }
        else {
#pragma unroll
            for (int i = 0; i < 32; i += 4) { const u32x4 t = *(const u32x4*)(aff + i0 + i); key[i] = t.x; key[i + 1] = t.y; key[i + 2] = t.z; key[i + 3] = t.w; } }
        unsigned prefix = 0u, mask = 0u; int krem = kcap;
        for (int pass = 0; pass < 4; ++pass) {
            const int shift = 24 - 8 * pass;
            __syncthreads();
            for (int i = tid; i < 32 * 257; i += NT) hist[i] = 0;
            __syncthreads();
            LAS int* myh = hist + (tid & 31) * 257;
#pragma unroll
            for (int i = 0; i < 32; ++i) if (i < cnt && (key[i] & mask) == prefix) __hip_atomic_fetch_add(&myh[(key[i] >> shift) & 255u], 1, __ATOMIC_RELAXED, __HIP_MEMORY_SCOPE_WORKGROUP);
            __syncthreads();
            if (tid < 256) { int s = 0;
#pragma unroll 8
                for (int c = 0; c < 32; ++c) s += hist[c * 257 + tid];
                tot[tid] = s; }
            __syncthreads();
            if (tid < 64) {
                int c[4]; int s = 0;
#pragma unroll
                for (int j = 0; j < 4; ++j) { c[j] = tot[255 - (4 * tid + j)]; s += c[j]; }
                int inc = s;
#pragma unroll
                for (int o = 1; o < 64; o <<= 1) { const int t = __shfl_up(inc, o); if (tid >= o) inc += t; }
                int above = inc - s;
                if (above < krem && inc >= krem) { int d = 255 - 4 * tid;
#pragma unroll
                    for (int j = 0; j < 3; ++j) if (above + c[j] < krem) { above += c[j]; --d; } else break;
                    bc[0] = prefix | ((unsigned)d << shift); bc[1] = (unsigned)(krem - above); }
            }
            __syncthreads();
            prefix = bc[0]; krem = (int)bc[1]; mask |= 255u << shift;
        }
        const unsigned T = prefix;
        int ceq = 0;
#pragma unroll
        for (int i = 0; i < 32; ++i) if (i < cnt && key[i] == T) ++ceq;
        int tot; const int eqb = block_excl_scan(ceq, sm, tot);
        unsigned selm = 0u; int csel = 0, er = eqb;
#pragma unroll
        for (int i = 0; i < 32; ++i) if (i < cnt) { bool s = key[i] > T; if (key[i] == T) { s = er < krem; ++er; } if (s) { selm |= 1u << i; ++csel; } }
        int tots; int pos = block_excl_scan(csel, sm, tots);
        const int sbase = isctx ? NSLOT_L + e * 256 + b * CAP_C : (b * NE + e) * CAP_L;
        const int rbase = b * RB + (isctx ? 0 : CTXL);
        int invv[32];
#pragma unroll
        for (int i = 0; i < 32; ++i) { invv[i] = -1; if (i < cnt) { const int r = rbase + i0 + i;
            if ((selm >> i) & 1u) { const int inv = sbase + pos; invv[i] = inv; SELI[inv] = r; SELG[inv] = __builtin_bit_cast(float, key[i]); ++pos; } } }
        if (isctx) { if (cnt) INVT[(size_t)e * R + rbase + i0] = invv[0]; }
        else { typedef int i32x4 __attribute__((ext_vector_type(4))); i32x4* dst = (i32x4*)(INVT + (size_t)e * R + rbase + i0);
#pragma unroll
            for (int i = 0; i < 8; ++i) dst[i] = (i32x4){invv[4 * i], invv[4 * i + 1], invv[4 * i + 2], invv[4 * i + 3]}; }
        if (isctx && b == 0 && tid < 192) { SELI[NSLOT_L + e * 256 + 64 + tid] = 0; SELG[NSLOT_L + e * 256 + 64 + tid] = 0.f; }
    }
}


__device__ __forceinline__ float reduce16(float (&v)[16], int lane) {
#pragma unroll
    for (int i = 0; i < 8; ++i) { const bool up = lane & 1; const float keep = up ? v[i + 8] : v[i], send = up ? v[i] : v[i + 8]; v[i] = keep + __shfl_xor(send, 1); }
#pragma unroll
    for (int i = 0; i < 4; ++i) { const bool up = lane & 2; const float keep = up ? v[i + 4] : v[i], send = up ? v[i] : v[i + 4]; v[i] = keep + __shfl_xor(send, 2); }
#pragma unroll
    for (int i = 0; i < 2; ++i) { const bool up = lane & 4; const float keep = up ? v[i + 2] : v[i], send = up ? v[i] : v[i + 2]; v[i] = keep + __shfl_xor(send, 4); }
    { const bool up = lane & 8; const float keep = up ? v[1] : v[0], send = up ? v[0] : v[1]; v[0] = keep + __shfl_xor(send, 8); }
    v[0] += __shfl_xor(v[0], 16); v[0] += __shfl_xor(v[0], 32);
    return v[0];
}
__device__ __forceinline__ float softmax16(float s) {
    float mx = s;
#pragma unroll
    for (int o = 1; o < 16; o <<= 1) mx = fmaxf(mx, __shfl_xor(mx, o));
    const float ex = expf(s - mx); float den = ex;
#pragma unroll
    for (int o = 1; o < 16; o <<= 1) den += __shfl_xor(den, o);
    return ex / den;
}
__device__ __forceinline__ void phase_norm2_router(const Params& P, int layer, LAS unsigned char* lds) {
    unsigned char* const ws = ows(P);
    const int tid = otid(), lane = tid & 63, wave = tid >> 6;
    const int gw = blockIdx.x * 8 + wave, NGW = gridDim.x * 8;
    LAS float* wT = (LAS float*)lds;
    { const f32x4* wr4 = (const f32x4*)(P.w_router + (size_t)layer * D * NE);
      for (int i = tid; i < D * NE / 4; i += NT) { const f32x4 w = wr4[i]; const int k = i >> 2, e0 = (i & 3) * 4; wT[(e0 + 0) * 1024 + k] = w.x; wT[(e0 + 1) * 1024 + k] = w.y; wT[(e0 + 2) * 1024 + k] = w.z; wT[(e0 + 3) * 1024 + k] = w.w; } }
    __syncthreads();
    bf16_t* XR = (bf16_t*)(ws + WS_XR); bf16_t* H = (bf16_t*)(ws + WS_H);
    const float* MOD = (const float*)(ws + WS_MOD) + (size_t)layer * 3 * 6144;
    const float* gain = P.norm_ffn_g + (size_t)layer * D;
    const float* OPART = (const float*)(ws + WS_XSEL);
    float* AFFL = (float*)(ws + WS_AFF); float* AFFC = AFFL + (size_t)NB * NE * SEQ;
    const int erev = ((lane & 1) << 3) | ((lane & 2) << 1) | ((lane & 4) >> 1) | ((lane & 8) >> 3);
    for (int pr = gw; pr < R / 2; pr += NGW) {
        const int r0 = 2 * pr; const int b = r0 / RB, j = r0 - b * RB; const int mv = j < CTXL ? 2 : b;
        if (layer == DEPTH - 1 && j < CTXL) continue;
        const float* sh = MOD + (size_t)mv * 6144 + 3072; const float* sc = sh + 1024;
        u32x2* xr = (u32x2*)(XR + (size_t)r0 * D) + lane;
        f32x4 v0[4], v1[4]; float ss0 = 0.f, ss1 = 0.f;
#pragma unroll
        for (int q = 0; q < 4; ++q) { const u32x2 a = xr[64 * q], b2 = xr[256 + 64 * q];
            v0[q] = (f32x4){__builtin_bit_cast(float, a.x << 16), __builtin_bit_cast(float, a.x & 0xffff0000u), __builtin_bit_cast(float, a.y << 16), __builtin_bit_cast(float, a.y & 0xffff0000u)};
            v1[q] = (f32x4){__builtin_bit_cast(float, b2.x << 16), __builtin_bit_cast(float, b2.x & 0xffff0000u), __builtin_bit_cast(float, b2.y << 16), __builtin_bit_cast(float, b2.y & 0xffff0000u)}; }
        if (j < CTXL) {
#pragma unroll
            for (int p = 0; p < 3; ++p) { const f32x4* pp = (const f32x4*)(OPART + ((size_t)p * 512 + (size_t)b * CTXL + j) * D) + lane;
#pragma unroll
                for (int q = 0; q < 4; ++q) { v0[q] += pp[64 * q]; v1[q] += pp[256 + 64 * q]; } }
#pragma unroll
            for (int q = 0; q < 4; ++q) { xr[64 * q] = (u32x2){pk2(v0[q].x, v0[q].y), pk2(v0[q].z, v0[q].w)}; xr[256 + 64 * q] = (u32x2){pk2(v1[q].x, v1[q].y), pk2(v1[q].z, v1[q].w)}; } }
#pragma unroll
        for (int q = 0; q < 4; ++q) { ss0 += (v0[q].x * v0[q].x + v0[q].y * v0[q].y) + (v0[q].z * v0[q].z + v0[q].w * v0[q].w); ss1 += (v1[q].x * v1[q].x + v1[q].y * v1[q].y) + (v1[q].z * v1[q].z + v1[q].w * v1[q].w); }
        const float rstd0 = 1.0f / sqrtf(wave_sum(ss0) * (1.f / D) + EPS), rstd1 = 1.0f / sqrtf(wave_sum(ss1) * (1.f / D) + EPS);
        unsigned long long* o8 = (unsigned long long*)(H + (size_t)r0 * D) + lane;
#pragma unroll
        for (int q = 0; q < 4; ++q) {
            const int c0 = 4 * lane + 256 * q;
            const f32x4 g4 = *(const f32x4*)(gain + c0), sc4 = *(const f32x4*)(sc + c0), sh4 = *(const f32x4*)(sh + c0);
            const f32x4 gm = g4 * (sc4 + 1.f);
            v0[q] = v0[q] * rstd0 * gm + sh4; v1[q] = v1[q] * rstd1 * gm + sh4;
            o8[64 * q] = (unsigned long long)pk2(v0[q].x, v0[q].y) | ((unsigned long long)pk2(v0[q].z, v0[q].w) << 32);
            o8[256 + 64 * q] = (unsigned long long)pk2(v1[q].x, v1[q].y) | ((unsigned long long)pk2(v1[q].z, v1[q].w) << 32);
        }
        float a0[16], a1[16];
#pragma unroll
        for (int e = 0; e < 16; ++e) {
            float s0 = 0.f, s1 = 0.f;
#pragma unroll
            for (int q = 0; q < 4; ++q) { const f32x4 w = *(const LAS f32x4*)(wT + e * 1024 + 4 * lane + 256 * q);
                s0 += (v0[q].x * w.x + v0[q].y * w.y) + (v0[q].z * w.z + v0[q].w * w.w); s1 += (v1[q].x * w.x + v1[q].y * w.y) + (v1[q].z * w.z + v1[q].w * w.w); }
            a0[e] = s0; a1[e] = s1;
            if (e & 1) asm volatile("" ::: "memory");
        }
        const float p0 = softmax16(reduce16(a0, lane)), p1 = softmax16(reduce16(a1, lane));
        if (lane < 16) { typedef float f32x2 __attribute__((ext_vector_type(2)));
            float* dst = j < CTXL ? AFFC + ((size_t)b * NE + erev) * CTXL + j : AFFL + ((size_t)b * NE + erev) * SEQ + (j - CTXL);
            *(f32x2*)dst = (f32x2){p0, p1}; }
    }
}

template <bool LAST>
__device__ __forceinline__ void phase_combine_norm(const Params& P, int layer) {
    unsigned char* const ws = ows(P);
    const int tid = otid(), lane = tid & 63, wave = tid >> 6; const int gw = blockIdx.x * 8 + wave, NGW = gridDim.x * 8;
    bf16_t* XR = (bf16_t*)(ws + WS_XR); const bf16_t* Y = (const bf16_t*)(ws + WS_Y); const int* INVT = (const int*)(ws + WS_INVT); bf16_t* H = (bf16_t*)(ws + WS_H);
    const float* MOD = (const float*)(ws + WS_MOD) + (size_t)layer * 3 * 6144;
    const float* gain = LAST ? P.final_norm_g : P.norm_mix_g + (size_t)(layer + 1) * D;
    int sv = (gw < R && lane < 16) ? INVT[(size_t)lane * R + gw] : -1;
    for (int r = gw; r < R; r += NGW) {
        const int b = r / RB, j = r - b * RB; const int mv = j < CTXL ? 2 : b;
        const int svc = sv; sv = (r + NGW < R && lane < 16) ? INVT[(size_t)lane * R + r + NGW] : -1;
        if (LAST && j < CTXL) continue;
        u32x2* xr = (u32x2*)(XR + (size_t)r * D) + lane;
        f32x4 x[4], acc[4];
#pragma unroll
        for (int q = 0; q < 4; ++q) { const u32x2 a = xr[64 * q]; x[q] = (f32x4){__builtin_bit_cast(float, a.x << 16), __builtin_bit_cast(float, a.x & 0xffff0000u), __builtin_bit_cast(float, a.y << 16), __builtin_bit_cast(float, a.y & 0xffff0000u)}; acc[q] = (f32x4){0.f, 0.f, 0.f, 0.f}; }
#pragma unroll
        for (int e = 0; e < NE; ++e) { const int s = __builtin_amdgcn_readlane(svc, e);
            if (s >= 0) {
                if (!LAST && s >= NSLOT_L) {
#pragma unroll
                    for (int p = 0; p < 4; ++p) { const u32x2* y = (const u32x2*)(Y + (size_t)(pg8::YP_ROW0 + 4096 * p + (s - NSLOT_L)) * D) + lane;
#pragma unroll
                        for (int q = 0; q < 4; ++q) { const u32x2 w = y[64 * q]; acc[q] += (f32x4){__builtin_bit_cast(float, w.x << 16), __builtin_bit_cast(float, w.x & 0xffff0000u), __builtin_bit_cast(float, w.y << 16), __builtin_bit_cast(float, w.y & 0xffff0000u)}; } } }
                else { const u32x2* y = (const u32x2*)(Y + (size_t)s * D) + lane;
#pragma unroll
                    for (int q = 0; q < 4; ++q) { const u32x2 w = y[64 * q]; acc[q] += (f32x4){__builtin_bit_cast(float, w.x << 16), __builtin_bit_cast(float, w.x & 0xffff0000u), __builtin_bit_cast(float, w.y << 16), __builtin_bit_cast(float, w.y & 0xffff0000u)}; } } } }
        const float* g2 = MOD + (size_t)mv * 6144 + 5120;
        float ss = 0.f;
#pragma unroll
        for (int q = 0; q < 4; ++q) { const f32x4 g4 = *(const f32x4*)(g2 + 4 * lane + 256 * q); x[q] = x[q] + g4 * acc[q]; if (!LAST) xr[64 * q] = (u32x2){pk2(x[q].x, x[q].y), pk2(x[q].z, x[q].w)};
            ss += (x[q].x * x[q].x + x[q].y * x[q].y) + (x[q].z * x[q].z + x[q].w * x[q].w); }
        const float rstd = 1.0f / sqrtf(wave_sum(ss) * (1.f / D) + EPS);
        if (LAST) { f32x4* o = (f32x4*)(P.out + ((size_t)b * SEQ + (j - CTXL)) * D) + lane;
#pragma unroll
            for (int q = 0; q < 4; ++q) { const f32x4 g4 = *(const f32x4*)(gain + 4 * lane + 256 * q); o[64 * q] = x[q] * rstd * g4; } }
        else { const float* sh = MOD + 3 * 6144 + (size_t)mv * 6144; const float* sc = sh + 1024;
            unsigned long long* o8 = (unsigned long long*)(H + (size_t)r * D) + lane;
#pragma unroll
            for (int q = 0; q < 4; ++q) { const int c0 = 4 * lane + 256 * q; const f32x4 g4 = *(const f32x4*)(gain + c0), sc4 = *(const f32x4*)(sc + c0), sh4 = *(const f32x4*)(sh + c0);
                const f32x4 h = x[q] * rstd * g4 * (sc4 + 1.f) + sh4;
                o8[64 * q] = (unsigned long long)pk2(h.x, h.y) | ((unsigned long long)pk2(h.z, h.w) << 32); } }
    }
}

#define XB_TMO      128
#define XB_XCNT(j)  (256  + 64 * (j))
#define XB_XSUB(j)  (1280 + 64 * (j))
#define XB_XGEN(j)  (2304 + 64 * (j))
#define XB_TOP      3328
#define XB_TOPGEN   3392
#define XCD_BAR_WORDS 3456
#define XB_SPIN_CAP (1u << 18)

__device__ __forceinline__ unsigned xb_ld(unsigned* p)              { return __hip_atomic_load(p, __ATOMIC_RELAXED, __HIP_MEMORY_SCOPE_AGENT); }
__device__ __forceinline__ unsigned xb_add(unsigned* p, unsigned v) { return __hip_atomic_fetch_add(p, v, __ATOMIC_RELAXED, __HIP_MEMORY_SCOPE_AGENT); }
__device__ __forceinline__ unsigned xb_xcc_id() { return (unsigned)__builtin_amdgcn_s_getreg((3 << 11) | 20) & 0xFu; }
#define XB_SPIN(cond, bar) do { unsigned _sp = 0; while (cond) { __builtin_amdgcn_s_sleep(1); \
    if ((++_sp & 255u) == 0u) { if (xb_ld(&(bar)[XB_TMO])) break; if (_sp > XB_SPIN_CAP) { atomicAdd(&(bar)[XB_TMO], 1u); break; } } } } while (0)

struct XcdBarrier {
    unsigned* bar; unsigned x;
    volatile LAS unsigned* st;
};

__device__ __forceinline__ XcdBarrier xcd_barrier_post(unsigned* bar, volatile LAS unsigned* st) {
    XcdBarrier b; b.bar = bar; b.x = xb_xcc_id(); b.st = st;
    if (threadIdx.x == 0) (void)xb_add(&bar[XB_XCNT(b.x)], 1u);
    return b;
}
__device__ __forceinline__ void xcd_barrier_complete(unsigned* bar, unsigned x, unsigned& nloc, unsigned& nx) {
    const unsigned G = gridDim.x * gridDim.y * gridDim.z;
    unsigned sum, cnt, mine, sp = 0u;
    for (;;) {
        sum = 0u; cnt = 0u; mine = 0u;
#pragma unroll
        for (unsigned j = 0; j < 16; ++j) { const unsigned c = xb_ld(&bar[XB_XCNT(j)]); sum += c; cnt += (c > 0u) ? 1u : 0u; mine = (j == x) ? c : mine; }
        if (sum == G) break;
        __builtin_amdgcn_s_sleep(1);
        if ((++sp & 255u) == 0u) { if (xb_ld(&bar[XB_TMO])) break; if (sp > XB_SPIN_CAP) { atomicAdd(&bar[XB_TMO], 1u); break; } }
    }
    nloc = mine > 0u ? mine : 1u; nx = cnt > 0u ? cnt : 1u;
}

__device__ __forceinline__ void xcd_barrier(const XcdBarrier& b) {
    asm volatile("s_waitcnt vmcnt(0)" ::: "memory");
    __syncthreads();
    if (threadIdx.x == 0) {
        unsigned* bar = b.bar; unsigned bx_ = b.x;
        asm volatile("" : "+s"(bar), "+s"(bx_));
        __builtin_amdgcn_s_waitcnt(0);
        unsigned nloc = b.st[0], nx = b.st[1];
        if (nloc == 0u) { xcd_barrier_complete(bar, bx_, nloc, nx); b.st[0] = nloc; b.st[1] = nx; }
        const unsigned old = xb_add(&bar[XB_XSUB(bx_)], 1u);
        const unsigned gen = old / nloc;
        if (old + 1u == (gen + 1u) * nloc) {
            __builtin_amdgcn_fence(__ATOMIC_RELEASE, "agent");
            asm volatile("s_waitcnt vmcnt(0)" ::: "memory");
            const unsigned og = xb_add(&bar[XB_TOP], 1u);
            const unsigned tg = og / nx;
            if (og + 1u == (tg + 1u) * nx) xb_add(&bar[XB_TOPGEN], 1u);
            else XB_SPIN(xb_ld(&bar[XB_TOPGEN]) == tg, bar);
            __builtin_amdgcn_fence(__ATOMIC_ACQUIRE, "agent");
            xb_add(&bar[XB_XGEN(bx_)], 1u);
            asm volatile("s_waitcnt vmcnt(0)" ::: "memory");
        } else {
            XB_SPIN(xb_ld(&bar[XB_XGEN(bx_)]) == gen, bar);
            __builtin_amdgcn_fence(__ATOMIC_ACQUIRE, "agent");
            asm volatile("s_waitcnt vmcnt(0)" ::: "memory");
        }
    }
    __syncthreads();
}


constexpr int LDS_RING = 131072;
constexpr int LDS_CTL_OFF = LDS_RING;
constexpr int LDS_BYTES = LDS_RING + 16384;
constexpr int CW_BAR = 4096;
constexpr size_t CTL_ZERO_BYTES = 64 * 1024;

template <int l>
__device__ __forceinline__ void layer_phases(const Params& P, LAS unsigned char* lds, char* lds_raw, const XcdBarrier& bar) {
    constexpr bool last = l == DEPTH - 1;
    phase_qkv(P, l, lds);
    xcd_barrier(bar);
    if (l & 1) phase_attn<true>(P, l, lds_raw); else phase_attn<false>(P, l, lds_raw);
    xcd_barrier(bar);
    phase_oproj(P, l, lds);
    xcd_barrier(bar);
    phase_norm2_router(P, l, lds);
    xcd_barrier(bar);
    phase_select(P, lds, last);
    xcd_barrier(bar);
    phase_gateup(P, l, lds);
    xcd_barrier(bar);
    phase_down(P, l, lds);
    xcd_barrier(bar);
    phase_combine_norm<last>(P, l);
    if (!last) xcd_barrier(bar);
}

__global__ void __launch_bounds__(512, 2) fwd_kernel(Params P) {
    extern __shared__ __attribute__((aligned(16))) unsigned char lds_raw[];
    LAS unsigned char* lds = (LAS unsigned char*)lds_raw;
    volatile LAS unsigned* xbw = (volatile LAS unsigned*)(lds + LDS_CTL_OFF);
    if (threadIdx.x < 4) xbw[threadIdx.x] = 0u;
    __syncthreads();
    XcdBarrier bar = xcd_barrier_post((unsigned*)(P.ws + WS_CTL) + CW_BAR, xbw);

    phase_weights(P, lds);
    __syncthreads();
    phase_mod(P, lds);
    phase_rope_init(P);
    xcd_barrier(bar);
    phase_norm1_l0(P);
    xcd_barrier(bar);
    layer_phases<0>(P, lds, (char*)lds_raw, bar);
    layer_phases<1>(P, lds, (char*)lds_raw, bar);
    layer_phases<2>(P, lds, (char*)lds_raw, bar);
    layer_phases<3>(P, lds, (char*)lds_raw, bar);
}

extern "C" void kernel_launch(void* const* d_in, const int* in_sizes, int n_in, void* d_out, int out_size, void* d_ws, size_t ws_size, hipStream_t stream) {
    static int grid = 0;
    if (grid == 0) {
        if (n_in != 18 || ws_size < WS_END || out_size != NB * SEQ * D) { fprintf(stderr, "kernel_launch: unexpected problem: n_in %d ws %zu (need %zu) out %d; nothing launched\n", n_in, ws_size, (size_t)WS_END, out_size); grid = -1; return; }
        int dev = 0, cus = 0, per_cu = 0;
        if (hipGetDevice(&dev) != hipSuccess || hipDeviceGetAttribute(&cus, hipDeviceAttributeMultiprocessorCount, dev) != hipSuccess) { fprintf(stderr, "kernel_launch: device query failed\n"); grid = -1; return; }
        if (hipFuncSetAttribute((const void*)fwd_kernel, hipFuncAttributeMaxDynamicSharedMemorySize, LDS_BYTES) != hipSuccess) { fprintf(stderr, "kernel_launch: hipFuncSetAttribute failed\n"); grid = -1; return; }
        if (hipOccupancyMaxActiveBlocksPerMultiprocessor(&per_cu, (const void*)fwd_kernel, 512, LDS_BYTES) != hipSuccess || per_cu < 1) { fprintf(stderr, "kernel_launch: occupancy query reports %d workgroups per CU\n", per_cu); }
        (void)hipGetLastError();
        grid = cus;
    }
    if (grid < 0) return;
    Params P{};
    P.x = (const float*)d_in[0]; P.c = (const float*)d_in[1]; P.ctx = (const float*)d_in[2]; P.c_ctx = (const float*)d_in[3]; P.w_mod = (const float*)d_in[4]; P.b_mod = (const float*)d_in[5];
    P.norm_mix_g = (const float*)d_in[6]; P.norm_ffn_g = (const float*)d_in[7]; P.w_qkv = (const float*)d_in[8]; P.w_o = (const float*)d_in[9]; P.q_norm_g = (const float*)d_in[10]; P.k_norm_g = (const float*)d_in[11];
    P.attn_sink = (const float*)d_in[12]; P.w_router = (const float*)d_in[13]; P.w_gate = (const float*)d_in[14]; P.w_up = (const float*)d_in[15]; P.w_down = (const float*)d_in[16]; P.final_norm_g = (const float*)d_in[17];
    P.out = (float*)d_out; P.ws = (unsigned char*)d_ws;
    if (hipMemsetAsync((char*)d_ws + WS_CTL, 0, CTL_ZERO_BYTES, stream) != hipSuccess) { fprintf(stderr, "kernel_launch: memset failed\n"); return; }
    hipLaunchKernelGGL(fwd_kernel, dim3(grid), dim3(512), LDS_BYTES, stream, P);
    const hipError_t le = hipPeekAtLastError();
    if (le != hipSuccess) fprintf(stderr, "kernel_launch: launch failed: %s (grid %d)\n", hipGetErrorName(le), grid);
}
```

```cpp
#include <hip/hip_runtime.h>
#include <hip/hip_bf16.h>
#include <cmath>
#include <cstdio>
#include <cstdint>

#define LAS __attribute__((address_space(3)))
typedef unsigned short bf16_t;
typedef float f32x4 __attribute__((ext_vector_type(4)));
typedef unsigned u32x4 __attribute__((ext_vector_type(4)));
typedef unsigned u32x2 __attribute__((ext_vector_type(2)));

namespace cfg {
constexpr int D = 1024, NB = 2, SEQ = 16384, DEPTH = 4, CTXL = 256, HD = 64, NQH = 16, NKVH = 4, QKVW = 1536;
constexpr int NE = 16, DE = 2048, CAP_L = 2048, CAP_C = 32;
constexpr int RB = CTXL + SEQ;
constexpr int R = NB * RB;
constexpr int NSLOT_L = NB * NE * CAP_L;
constexpr int NSLOT = NSLOT_L + NE * 256;
constexpr float EPS = 1e-6f;
constexpr float C2 = 0.125f * 1.4426950408889634f;
constexpr float LOG2E = 1.4426950408889634f;
constexpr int NT = 512;
}
using namespace cfg;

constexpr size_t MiB = 1u << 20;
constexpr size_t WS_CTL   = 0;
constexpr size_t WS_MOD   = 1 * MiB;
constexpr size_t WS_ROPE  = WS_MOD + 512 * 1024;
constexpr size_t WS_WQKV  = 2 * MiB;
constexpr size_t WS_WO    = WS_WQKV + 12 * MiB;
constexpr size_t WS_WGU   = WS_WO + 8 * MiB;
constexpr size_t WS_WD    = WS_WGU + 512 * MiB;
constexpr size_t WS_XR    = WS_WD + 256 * MiB;
constexpr size_t WS_H     = WS_XR + 130 * MiB;
constexpr size_t WS_Q     = WS_H + 65 * MiB;
constexpr size_t WS_K     = WS_Q + 65 * MiB;
constexpr size_t WS_V     = WS_K + 17 * MiB;
constexpr size_t WS_O     = WS_V + 17 * MiB;
constexpr size_t WS_AFF   = WS_O + 65 * MiB;
constexpr size_t WS_SELI  = WS_AFF + 3 * MiB;
constexpr size_t WS_SELG  = WS_SELI + 512 * 1024;
constexpr size_t WS_INVT  = WS_SELG + 512 * 1024;
constexpr size_t WS_XSEL  = WS_INVT + 3 * MiB;
constexpr size_t WS_ACT   = WS_XSEL + 136 * MiB;
constexpr size_t WS_Y     = WS_ACT + 272 * MiB;
constexpr size_t WS_END   = WS_Y + 272 * MiB;

struct Params {
    const float *x, *c, *ctx, *c_ctx, *w_mod, *b_mod, *norm_mix_g, *norm_ffn_g, *w_qkv, *w_o, *q_norm_g, *k_norm_g, *attn_sink, *w_router, *w_gate, *w_up, *w_down, *final_norm_g;
    float* out; unsigned char* ws;
};

__device__ __forceinline__ unsigned f2bf(float f) { unsigned u = __builtin_bit_cast(unsigned, f); return (u + 0x7fffu + ((u >> 16) & 1u)) >> 16; }
__device__ __forceinline__ unsigned pk2(float lo, float hi) { return f2bf(lo) | (f2bf(hi) << 16); }
__device__ __forceinline__ float bf2f(unsigned short h) { return __builtin_bit_cast(float, (unsigned)h << 16); }
__device__ __forceinline__ float wave_sum(float v) {
#pragma unroll
    for (int o = 1; o < 64; o <<= 1) v += __shfl_xor(v, o);
    return v;
}
__device__ __forceinline__ int otid() { int t = threadIdx.x; asm volatile("" : "+v"(t)); return t; }
__device__ __forceinline__ unsigned char* ows(const Params& P) {
    __attribute__((address_space(1))) unsigned char* g = (__attribute__((address_space(1))) unsigned char*)P.ws; asm volatile("" : "+s"(g)); return (unsigned char*)g; }
__device__ __forceinline__ float silu_f(float v) { return v / (1.f + expf(-v)); }
__device__ __forceinline__ int mod_vec_of_row(int r) { const int b = r / RB, j = r - b * RB; return j < CTXL ? 2 : b; }

__device__ __forceinline__ size_t wtile_off(int n, int k, int K) {
    const int r = n & 127, c = k & 63; const int st = (r >> 4) * 2 + (c >> 5), ob = (r & 15) * 64 + (c & 31) * 2;
    return ((size_t)(n >> 7) * (K >> 6) + (k >> 6)) * 8192 + (size_t)((st * 1024 + (ob ^ (((ob >> 9) & 1) << 5))) >> 1);
}
template <bool KPERM = false, class RowMap>
__device__ __forceinline__ void transpose_item(const float* W, int K, int N, bf16_t* WT, const RowMap& rowmap, int item, int lane, float scale = 1.f) {
    const int nblk = N / 64, kb = item / nblk, nb = item % nblk, k0 = 64 * kb, n = 64 * nb + lane;
    const float* src = W + (size_t)k0 * N + n; const int row = rowmap(n);
#pragma unroll
    for (int half = 0; half < 2; ++half) {
        float v[32];
#pragma unroll
        for (int j = 0; j < 32; ++j) v[j] = src[(size_t)(32 * half + j) * N] * scale;
#pragma unroll
        for (int kc = 0; kc < 4; ++kc) { const int ka = k0 + 32 * half + 8 * kc;
            u32x4 o; o.x = pk2(v[8 * kc], v[8 * kc + 1]); o.y = pk2(v[8 * kc + 2], v[8 * kc + 3]); o.z = pk2(v[8 * kc + 4], v[8 * kc + 5]); o.w = pk2(v[8 * kc + 6], v[8 * kc + 7]);
            if (KPERM) { const int kb_ = ka + 4;
                const int pa = (ka & ~31) + 8 * ((ka >> 2) & 3) + 4 * ((ka >> 4) & 1), pb = (kb_ & ~31) + 8 * ((kb_ >> 2) & 3) + 4 * ((kb_ >> 4) & 1);
                *(u32x2*)(WT + wtile_off(row, pa, K)) = (u32x2){o.x, o.y}; *(u32x2*)(WT + wtile_off(row, pb, K)) = (u32x2){o.z, o.w}; }
            else *(u32x4*)(WT + wtile_off(row, ka, K)) = o; }
    }
}

__device__ __forceinline__ void phase_weights(const Params& P, LAS unsigned char* lds) {
    unsigned char* const ws = ows(P);
    const int tid = otid(), lane = tid & 63, wave = tid >> 6;
    const int gw = blockIdx.x * 8 + wave, NGW = gridDim.x * 8;
    constexpr int I_QKV = 16 * 24, I_O = 16 * 16, I_G = 16 * 32, I_D = 32 * 16;
    constexpr int PER_LAYER = I_QKV + I_O + NE * (2 * I_G + I_D);
    for (int it = gw; it < DEPTH * PER_LAYER; it += NGW) {
        const int l = it / PER_LAYER; int r = it % PER_LAYER;
        if (r < I_QKV) { bf16_t* dst = (bf16_t*)(ws + WS_WQKV) + (size_t)l * QKVW * D;
            transpose_item(P.w_qkv + (size_t)l * D * QKVW, D, QKVW, dst, [](int n) { const int hh = n >> 6; return 256 * (hh >> 2) + 128 * ((n >> 5) & 1) + 32 * (hh & 3) + (n & 31); }, r, lane); continue; }
        r -= I_QKV;
        if (r < I_O) { bf16_t* dst = (bf16_t*)(ws + WS_WO) + (size_t)l * D * D;
            transpose_item<true>(P.w_o + (size_t)l * D * D, D, D, dst, [](int n) { const int c = n & 31; return (n & ~31) + 16 * ((c >> 2) & 1) + 4 * (c >> 3) + (c & 3); }, r, lane); continue; }
        r -= I_O;
        const int e = r / (2 * I_G + I_D); r = r % (2 * I_G + I_D);
        const size_t le = (size_t)l * NE + e;
        if (r < I_G) { bf16_t* dst = (bf16_t*)(ws + WS_WGU) + le * (size_t)(2 * DE) * D;
            transpose_item(P.w_gate + le * (size_t)D * DE, D, DE, dst, [](int f) { return 256 * (f >> 7) + 128 * ((f >> 2) & 1) + 32 * ((f >> 5) & 3) + 4 * ((f >> 3) & 3) + (f & 3); }, r, lane, -1.4426950408889634f); continue; }
        r -= I_G;
        if (r < I_G) { bf16_t* dst = (bf16_t*)(ws + WS_WGU) + le * (size_t)(2 * DE) * D;
            transpose_item(P.w_up + le * (size_t)D * DE, D, DE, dst, [](int f) { return 256 * (f >> 7) + 128 * ((f >> 2) & 1) + 32 * ((f >> 5) & 3) + 16 + 4 * ((f >> 3) & 3) + (f & 3); }, r, lane, -0.6931471805599453f); continue; }
        r -= I_G;
        { bf16_t* dst = (bf16_t*)(ws + WS_WD) + le * (size_t)D * DE;
            transpose_item(P.w_down + le * (size_t)DE * D, DE, D, dst, [](int n) { const int c = n & 31; return (n & ~31) + 16 * ((c >> 2) & 1) + 4 * (c >> 3) + (c & 3); }, r, lane); }
    }
}

__device__ __forceinline__ void phase_mod(const Params& P, LAS unsigned char* lds) {
    unsigned char* const ws = ows(P);
    const int tid = otid(), lane = tid & 63, wave = tid >> 6;
    LAS float* sc = (LAS float*)lds;
    LAS float* red = sc + 3 * 1024;
    for (int i = tid; i < 3 * D; i += NT) { const int v = i / D, k = i % D; const float cv = v < 2 ? P.c[v * D + k] : P.c_ctx[k]; sc[i] = silu_f(cv); }
    __syncthreads();
    float* MOD = (float*)(ws + WS_MOD);
    for (int it = blockIdx.x; it < DEPTH * 96; it += gridDim.x) {
        const int l = it / 96, col = (it % 96) * 64 + lane;
        const float* W = P.w_mod + (size_t)l * D * 6144 + col;
        float a0 = 0.f, a1 = 0.f, a2 = 0.f;
#pragma unroll 4
        for (int k = wave; k < D; k += 8) { const float w = W[(size_t)k * 6144]; a0 += sc[k] * w; a1 += sc[D + k] * w; a2 += sc[2 * D + k] * w; }
        red[(wave * 3 + 0) * 64 + lane] = a0; red[(wave * 3 + 1) * 64 + lane] = a1; red[(wave * 3 + 2) * 64 + lane] = a2;
        __syncthreads();
        if (wave < 3) { float s = 0.f;
#pragma unroll
            for (int w = 0; w < 8; ++w) s += red[(w * 3 + wave) * 64 + lane];
            MOD[((size_t)l * 3 + wave) * 6144 + col] = s + P.b_mod[(size_t)l * 6144 + col]; }
        __syncthreads();
    }
}

__device__ __forceinline__ void phase_rope_init(const Params& P) {
    unsigned char* const ws = ows(P);
    float* T = (float*)(ws + WS_ROPE);
    for (int i = blockIdx.x * NT + otid(); i < 256 * 16; i += gridDim.x * NT) {
        const int p = i >> 4, f = i & 15;
        const float inv = (float)(1.0 / pow(10000.0, (double)f / 16.0));
        const float ang = (float)p * inv;
        T[2 * i] = (float)cos((double)ang); T[2 * i + 1] = (float)sin((double)ang);
    }
}


__device__ __forceinline__ void phase_norm1_l0(const Params& P) {
    unsigned char* const ws = ows(P);
    const int tid = otid(), lane = tid & 63, wave = tid >> 6;
    const int gw = blockIdx.x * 8 + wave, NGW = gridDim.x * 8;
    bf16_t* H = (bf16_t*)(ws + WS_H); const float* MOD = (const float*)(ws + WS_MOD); const float* gain = P.norm_mix_g;
    for (int r = gw; r < R; r += NGW) {
        const int b = r / RB, j = r - b * RB; const int mv = j < CTXL ? 2 : b;
        const float* sh = MOD + (size_t)mv * 6144; const float* sc = sh + 1024;
        const f32x4* xr = (const f32x4*)(j < CTXL ? P.ctx + ((size_t)b * CTXL + j) * D : P.x + ((size_t)b * SEQ + (j - CTXL)) * D) + lane;
        f32x4 v[4]; float ss = 0.f;
#pragma unroll
        for (int q = 0; q < 4; ++q) { v[q] = xr[64 * q]; ss += (v[q].x * v[q].x + v[q].y * v[q].y) + (v[q].z * v[q].z + v[q].w * v[q].w); }
        const float rstd = 1.0f / sqrtf(wave_sum(ss) * (1.f / D) + EPS);
        unsigned long long* o8 = (unsigned long long*)(H + (size_t)r * D) + lane;
#pragma unroll
        for (int q = 0; q < 4; ++q) { const int c0 = 4 * lane + 256 * q;
            const f32x4 g4 = *(const f32x4*)(gain + c0), sc4 = *(const f32x4*)(sc + c0), sh4 = *(const f32x4*)(sh + c0);
            const f32x4 h = v[q] * rstd * g4 * (sc4 + 1.f) + sh4;
            o8[64 * q] = (unsigned long long)pk2(h.x, h.y) | ((unsigned long long)pk2(h.z, h.w) << 32); }
    }
}


namespace pg8 {
#define PG8_LAS __attribute__((address_space(3)))
typedef unsigned short bf16_t;
typedef short bf16x8 __attribute__((ext_vector_type(8)));
typedef float f32x4 __attribute__((ext_vector_type(4)));
typedef unsigned u32x4 __attribute__((ext_vector_type(4)));
constexpr int BM = 256, BK = 64, HALF = 128, HTB = HALF * BK * 2  , STAGE_BYTES = 8 * HTB, NXCD = 8, WGM = 8;

__host__ __device__ __forceinline__ int lds_byte(int r, int c) { const int st = (r >> 4) * 2 + (c >> 5), rr = r & 15, cc = c & 31, ob = rr * 64 + cc * 2; return st * 1024 + (ob ^ (((ob >> 9) & 1) << 5)); }
__host__ __device__ __forceinline__ void stage_rc(int b, int& R, int& C) { const int st = b / 1024, sb = b % 1024, swz = sb ^ (((sb >> 9) & 1) << 5); R = (st >> 1) * 16 + swz / 64; C = (st & 1) * 32 + (swz % 64) / 2; }
__host__ __device__ __forceinline__ int perm32(int rho) { const int n = rho >> 4, i = rho & 15; return 8 * (i >> 2) + 4 * n + (i & 3); }

struct Unit { int pm, pn; int par = 0; int kt0 = 0, nkt = 0, kq = -1; };
struct Gemm { const bf16_t* A; const bf16_t* Bt; int M, N, K; const int* gidx; };


__device__ __forceinline__ unsigned cvt_pk_bf16(float lo, float hi) { unsigned r; asm volatile("v_cvt_pk_bf16_f32 %0, %1, %2" : "=v"(r) : "v"(lo), "v"(hi)); return r; }
typedef unsigned u32x2 __attribute__((ext_vector_type(2)));

struct EpiQKV {
    static constexpr bool PERM = false, AFTER_DRAIN = false, PRE = false;
    unsigned char* ws; const float* rope; const float* qg; const float* kg; int do_norm; const PG8_LAS float* ropel;
    __device__ __forceinline__ void operator()(const f32x4 (&acc)[2][2][4][2], const Unit& u, int wr_, int wc_, int fr_, int fq_) const {
        int wr = wr_, wc = wc_, fr = fr_, fq = fq_; asm volatile("" : "+s"(wr), "+s"(wc), "+v"(fr), "+v"(fq));
        const int type = u.pn < 4 ? 0 : (u.pn == 4 ? 1 : 2);
        const int pb = u.pm / 65, pj = u.pm - pb * 65;
        const bool lat = pj != 0, nrm = do_norm && type < 2;
        const size_t dbyte = type == 0 ? ::WS_Q + (size_t)(u.pn * 4 + wc) * 128 : (type == 1 ? ::WS_K : ::WS_V) + (size_t)wc * 128;
        bf16_t* dst = (bf16_t*)(ws + dbyte);
        const int ldd = type == 0 ? 1024 : 256;
        f32x4 gv[2][2];
#pragma unroll
        for (int bj = 0; bj < 2; ++bj)
#pragma unroll
            for (int n = 0; n < 2; ++n) { const f32x4 a = *(const f32x4*)(qg + 32 * bj + 16 * n + 4 * fq), b = *(const f32x4*)(kg + 32 * bj + 16 * n + 4 * fq);
                gv[bj][n] = nrm ? (type == 0 ? a : b) : (f32x4){1.f, 1.f, 1.f, 1.f}; }
        const float osc = type == 0 ? cfg::C2 : 1.f;
        const bool dorope = lat && type < 2;
#pragma unroll
        for (int ai = 0; ai < 2; ++ai) {
            f32x4 rr0 = (f32x4){1.f, 0.f, 1.f, 0.f}, rr1 = rr0;
            if (dorope) { const int prow = (pj - 1) * 4 + 2 * ai + wr; const f32x4* cs = (const f32x4*)(rope + (size_t)(prow * 16 + 4 * fq) * 2); rr0 = cs[0]; rr1 = cs[1]; }
#pragma unroll
            for (int mp = 0; mp < 2; ++mp) {
            f32x4 rc0[2], rc1[2];
#pragma unroll
            for (int mm = 0; mm < 2; ++mm) { rc0[mm] = (f32x4){1.f, 0.f, 1.f, 0.f}; rc1[mm] = rc0[mm]; }
            if (dorope) {
#pragma unroll
                for (int mm = 0; mm < 2; ++mm) { const PG8_LAS f32x4* cc = (const PG8_LAS f32x4*)(ropel + ((16 * (2 * mp + mm) + fr) * 16 + 4 * fq) * 2); rc0[mm] = cc[0]; rc1[mm] = cc[1]; }
            }
#pragma unroll
            for (int mm = 0; mm < 2; ++mm) {
                const int m = 2 * mp + mm;
                const int rt = ai * HALF + wr * 64 + m * 16 + fr;
                f32x4 v[2][2];
#pragma unroll
                for (int bj = 0; bj < 2; ++bj)
#pragma unroll
                    for (int n = 0; n < 2; ++n) v[bj][n] = acc[ai][bj][m][n];
                if (nrm) {
                    float ss = 0.f;
#pragma unroll
                    for (int bj = 0; bj < 2; ++bj)
#pragma unroll
                        for (int n = 0; n < 2; ++n) { const f32x4 x = v[bj][n]; ss += (x[0] * x[0] + x[1] * x[1]) + (x[2] * x[2] + x[3] * x[3]); }
                    ss += __shfl_xor(ss, 16); ss += __shfl_xor(ss, 32);
                    const float rstd = 1.0f / sqrtf(ss * (1.f / 64.f) + cfg::EPS);
#pragma unroll
                    for (int bj = 0; bj < 2; ++bj)
#pragma unroll
                        for (int n = 0; n < 2; ++n) v[bj][n] = v[bj][n] * rstd * gv[bj][n];
                }
                if (dorope) {
#pragma unroll
                    for (int bj = 0; bj < 2; ++bj) {
                        const f32x4 A = bj == 0 ? rr0 : rc0[mm], B = bj == 0 ? rr1 : rc1[mm];
                        const f32x4 c = (f32x4){A[0], A[2], B[0], B[2]}, s = (f32x4){A[1], A[3], B[1], B[3]};
                        const f32x4 x1 = v[bj][0], x2 = v[bj][1];
                        v[bj][0] = x1 * c - x2 * s; v[bj][1] = x2 * c + x1 * s;
                    }
                }
                const size_t tile_ = (size_t)((pb * 4 + wc) * 260 + pj * 4 + (rt >> 6));
                bf16_t* rowp = type == 1 ? (bf16_t*)(ws + ::WS_K) + (tile_ * 8 + fq) * 512 + (rt & 63) * 8
                             : type == 2 ? (bf16_t*)(ws + ::WS_V) + tile_ * 4096 + (rt & 63) * 32 + 8 * fq
                                         : dst + ((size_t)u.pm * BM + rt) * ldd + 8 * fq;
                const int sbj = type == 0 ? 32 : 2048;
#pragma unroll
                for (int bj = 0; bj < 2; ++bj) { const f32x4 o0 = v[bj][0] * osc, o1 = v[bj][1] * osc; u32x4 w; w.x = cvt_pk_bf16(o0[0], o0[1]); w.y = cvt_pk_bf16(o0[2], o0[3]); w.z = cvt_pk_bf16(o1[0], o1[1]); w.w = cvt_pk_bf16(o1[2], o1[3]);
                    *(u32x4*)(rowp + sbj * bj) = w; }
            }
            asm volatile("" ::: "memory");
            }
        }
    }
};
struct EpiResid {
    static constexpr bool PERM = false, AFTER_DRAIN = false, PRE = false;
    bf16_t* XR; const float* modl; const float* in_x; const float* in_ctx; int first;
    float* part = nullptr;
    __device__ __forceinline__ void operator()(const f32x4 (&acc)[2][2][4][2], const Unit& u, int wr_, int wc_, int fr_, int fq_) const {
        int wr = wr_, wc = wc_, fr = fr_, fq = fq_; asm volatile("" : "+s"(wr), "+s"(wc), "+v"(fr), "+v"(fq));
        const int pb = u.pm / 65, pj = u.pm - pb * 65; const int mv = pj == 0 ? 2 : pb;
        const int col0 = u.pn * BM + wc * 32 + 8 * fq;
        const float* g1 = modl + (size_t)mv * 6144 + 2048 + col0;
        const float* rin = pj == 0 ? in_ctx + (size_t)pb * 256 * 1024 : in_x + ((size_t)pb * 16384 + (size_t)(pj - 1) * 256) * 1024;
        f32x4 gv[2][2];
#pragma unroll
        for (int bj = 0; bj < 2; ++bj)
#pragma unroll
            for (int n = 0; n < 2; ++n) gv[bj][n] = *(const f32x4*)(g1 + bj * HALF + n * 4);
        if (u.kq > 0) {
            float* pb0 = part + ((size_t)(u.kq - 1) * 512 + (size_t)pb * 256) * 1024 + col0;
#pragma unroll
            for (int ai = 0; ai < 2; ++ai)
#pragma unroll
                for (int m = 0; m < 4; ++m) { float* rowp = pb0 + (size_t)(ai * HALF + wr * 64 + m * 16 + fr) * 1024;
#pragma unroll
                    for (int bj = 0; bj < 2; ++bj)
#pragma unroll
                        for (int n = 0; n < 2; ++n) *(f32x4*)(rowp + bj * HALF + n * 4) = gv[bj][n] * acc[ai][bj][m][n]; }
            return; }
#pragma unroll
        for (int ai = 0; ai < 2; ++ai)
#pragma unroll
            for (int mp = 0; mp < 2; ++mp) {
                f32x4 xv[2][2][2];
#pragma unroll
                for (int mm = 0; mm < 2; ++mm) { const size_t ro = (size_t)(ai * HALF + wr * 64 + (2 * mp + mm) * 16 + fr) * 1024 + col0;
                    if (first) { const float* rowp = rin + ro;
#pragma unroll
                        for (int bj = 0; bj < 2; ++bj)
#pragma unroll
                            for (int n = 0; n < 2; ++n) xv[mm][bj][n] = *(const f32x4*)(rowp + bj * HALF + n * 4); }
                    else { const bf16_t* rowp = XR + (size_t)u.pm * BM * 1024 + ro;
#pragma unroll
                        for (int bj = 0; bj < 2; ++bj) { const u32x4 w = *(const u32x4*)(rowp + bj * HALF);
                            xv[mm][bj][0] = (f32x4){__builtin_bit_cast(float, w.x << 16), __builtin_bit_cast(float, w.x & 0xffff0000u), __builtin_bit_cast(float, w.y << 16), __builtin_bit_cast(float, w.y & 0xffff0000u)};
                            xv[mm][bj][1] = (f32x4){__builtin_bit_cast(float, w.z << 16), __builtin_bit_cast(float, w.z & 0xffff0000u), __builtin_bit_cast(float, w.w << 16), __builtin_bit_cast(float, w.w & 0xffff0000u)}; } } }
#pragma unroll
                for (int mm = 0; mm < 2; ++mm) { bf16_t* rowp = XR + ((size_t)u.pm * BM + ai * HALF + wr * 64 + (2 * mp + mm) * 16 + fr) * 1024 + col0;
#pragma unroll
                    for (int bj = 0; bj < 2; ++bj) { const f32x4 o0 = xv[mm][bj][0] + gv[bj][0] * acc[ai][bj][2 * mp + mm][0], o1 = xv[mm][bj][1] + gv[bj][1] * acc[ai][bj][2 * mp + mm][1];
                        u32x4 w; w.x = cvt_pk_bf16(o0[0], o0[1]); w.y = cvt_pk_bf16(o0[2], o0[3]); w.z = cvt_pk_bf16(o1[0], o1[1]); w.w = cvt_pk_bf16(o1[2], o1[3]);
                        *(u32x4*)(rowp + bj * HALF) = w; } }
                asm volatile("" ::: "memory");
            }
    }
};
struct EpiSwiGLU {
    static constexpr bool PERM = false, AFTER_DRAIN = false, PRE = false;
    bf16_t* ACT; int ntn;
    __device__ __forceinline__ void operator()(const f32x4 (&acc)[2][2][4][2], const Unit& u, int wr_, int wc_, int fr_, int fq_) const {
        int wr = wr_, wc = wc_, fr = fr_, fq = fq_; asm volatile("" : "+s"(wr), "+s"(wc), "+v"(fr), "+v"(fq));
        const int pnl = u.pn % ntn; const int f0 = 128 * pnl + 32 * wc + 8 * fq;
#pragma unroll
        for (int ai = 0; ai < 2; ++ai)
#pragma unroll
            for (int m = 0; m < 4; ++m) { bf16_t* rowp = ACT + ((size_t)u.pm * BM + ai * HALF + wr * 64 + m * 16 + fr) * 2048 + f0;
                u32x4 w;
#pragma unroll
                for (int bj = 0; bj < 2; ++bj) { const f32x4 g = acc[ai][bj][m][0], up = acc[ai][bj][m][1]; f32x4 a;
#pragma unroll
                    for (int q = 0; q < 4; ++q) a[q] = (g[q] * up[q]) * __builtin_amdgcn_rcpf(1.f + __builtin_amdgcn_exp2f(g[q]));
                    if (bj == 0) { w.x = cvt_pk_bf16(a[0], a[1]); w.y = cvt_pk_bf16(a[2], a[3]); } else { w.z = cvt_pk_bf16(a[0], a[1]); w.w = cvt_pk_bf16(a[2], a[3]); } }
                *(u32x4*)rowp = w; }
    }
};
constexpr int YP_ROW0 = NSLOT;
struct EpiDown {
    static constexpr bool PERM = false, AFTER_DRAIN = false, PRE = true;
    bf16_t* Y; const float* selg; int ntn; PG8_LAS float* gl;
    __device__ __forceinline__ void pre(const Unit& u, int wid, int lane) const { if (wid < 4) __builtin_amdgcn_global_load_lds((const unsigned*)(selg + (size_t)u.pm * BM + wid * 64 + lane), (PG8_LAS unsigned*)(gl + u.par * 256 + wid * 64), 4, 0, 0); }
    __device__ __forceinline__ void operator()(const f32x4 (&acc)[2][2][4][2], const Unit& u, int wr_, int wc_, int fr_, int fq_) const {
        int wr = wr_, wc = wc_, fr = fr_, fq = fq_; asm volatile("" : "+s"(wr), "+s"(wc), "+v"(fr), "+v"(fq));
        const int pnl = u.pn % ntn; const int col0 = pnl * BM + wc * 32 + 8 * fq;
        const size_t rowb = u.kq < 0 ? (size_t)u.pm * BM : (size_t)(YP_ROW0 + 4096 * u.kq) + (size_t)(u.pm - 256) * BM;
        float gts[2][4];
#pragma unroll
        for (int ai = 0; ai < 2; ++ai)
#pragma unroll
            for (int m = 0; m < 4; ++m) gts[ai][m] = gl[u.par * 256 + ai * HALF + wr * 64 + m * 16 + fr];
#pragma unroll
        for (int ai = 0; ai < 2; ++ai)
#pragma unroll
            for (int m = 0; m < 4; ++m) { const size_t row = rowb + ai * HALF + wr * 64 + m * 16 + fr; const float gt = gts[ai][m]; bf16_t* rowp = Y + row * 1024 + col0;
#pragma unroll
                for (int bj = 0; bj < 2; ++bj) { const f32x4 o0 = acc[ai][bj][m][0] * gt, o1 = acc[ai][bj][m][1] * gt; u32x4 w; w.x = cvt_pk_bf16(o0[0], o0[1]); w.y = cvt_pk_bf16(o0[2], o0[3]); w.z = cvt_pk_bf16(o1[0], o1[1]); w.w = cvt_pk_bf16(o1[2], o1[3]);
                    *(u32x4*)(rowp + bj * HALF) = w; } }
    }
};
struct MoeOrder {
    int nMe, nN, nwg, G, c;
    __device__ void init(int nMe_, int nN_, int G_, int c_) { nMe = nMe_; nN = nN_; nwg = 16 * nMe * nN; G = G_; c = c_; }
    __device__ bool next(int i, Unit& u) const {
        const int L = i * G + c; if (L >= nwg) return false;
        int wgid = L; { const int q = nwg / NXCD, r = nwg % NXCD, xcd = wgid % NXCD, off = wgid / NXCD; wgid = (xcd < r ? xcd * (q + 1) : r * (q + 1) + (xcd - r) * q) + off; }
        const int per = nMe * nN, e = wgid / per, idx = wgid - e * per;
        const int nig = WGM * nN, gid = idx / nig, fm = gid * WGM, gsz = (nMe - fm) < WGM ? (nMe - fm) : WGM;
        const int pml = fm + ((idx % nig) % gsz), pnl = (idx % nig) / gsz;
        u.pm = pml < 8 ? e * 8 + pml : (pml < 16 ? (16 + e) * 8 + (pml - 8) : 256 + e);
        u.pn = e * nN + pnl; return true;
    }
    __device__ __forceinline__ void a_ready(const Unit&) const {}
    __device__ __forceinline__ void done(const Unit&) const {}
};
struct MoeSplitOrder {
    MoeOrder lat; int G, c;
    __device__ void init(int G_, int c_) { lat.init(16, 4, G_, c_); G = G_; c = c_; }
    __device__ bool next(int i, Unit& u) const {
        Unit v; v.pm = 0; v.pn = 0; const bool isl = lat.next(i, v);
        const int Lq = i * G + c - lat.nwg; if (!isl && Lq >= 256) return false;
        const int xcd = Lq & (NXCD - 1), off = Lq >> 3, e = 2 * xcd + (off >> 4), kq = off & 3;
        u.pm = isl ? v.pm : 256 + e; u.pn = isl ? v.pn : e * 4 + ((off >> 2) & 3); u.kq = isl ? -1 : kq; u.kt0 = isl ? 0 : 8 * kq; u.nkt = isl ? 32 : 8; return true;
    }
    __device__ __forceinline__ void a_ready(const Unit&) const {}
    __device__ __forceinline__ void done(const Unit&) const {}
};
struct CtxGateUpOrder {
    int G, c;
    __device__ void init(int G_, int c_) { G = G_; c = c_; }
    __device__ bool next(int i, Unit& u) const { const int L = i * G + c; if (L >= 256) return false;
        const int xcd = L & (NXCD - 1), off = L >> 3, e = 2 * xcd + (off >> 4); u.pm = 256 + e; u.pn = e * 16 + (off & 15); return true; }
    __device__ __forceinline__ void a_ready(const Unit&) const {}
    __device__ __forceinline__ void done(const Unit&) const {}
};
struct CtxDownOrder {
    int G, c;
    __device__ void init(int G_, int c_) { G = G_; c = c_; }
    __device__ bool next(int i, Unit& u) const { const int L = i * G + c; if (L >= 256) return false;
        const int xcd = L & (NXCD - 1), off = L >> 3, e = 2 * xcd + (off >> 4), kq = off & 3; u.pm = 256 + e; u.pn = e * 4 + ((off >> 2) & 3); u.kq = kq; u.kt0 = 8 * kq; u.nkt = 8; return true; }
    __device__ __forceinline__ void a_ready(const Unit&) const {}
    __device__ __forceinline__ void done(const Unit&) const {}
};
struct MoeCtxLastOrder {
    MoeOrder lat; int G, c;
    __device__ void init(int G_, int c_) { lat.init(16, 16, G_, c_); G = G_; c = c_; }
    __device__ bool next(int i, Unit& u) const {
        Unit v; v.pm = 0; v.pn = 0; const bool isl = lat.next(i, v);
        const int Lq = i * G + c - lat.nwg; if (!isl && Lq >= 256) return false;
        const int xcd = Lq & (NXCD - 1), off = Lq >> 3, e = 2 * xcd + (off >> 4);
        u.pm = isl ? v.pm : 256 + e; u.pn = isl ? v.pn : e * 16 + (off & 15); return true;
    }
    __device__ __forceinline__ void a_ready(const Unit&) const {}
    __device__ __forceinline__ void done(const Unit&) const {}
};
struct DenseOrder {
    int nM, nN, nwg, G, c, skipctx;
    __device__ void init(int M, int N, int G_, int c_, int skipctx_ = 0) { nM = M / BM; nN = N / BM; nwg = nM * nN; G = G_; c = c_; skipctx = skipctx_; }
    __device__ bool next(int i, Unit& u) const {
        const int L = i * G + c; if (L >= nwg) return false;
        int wgid = L; { const int q = nwg / NXCD, r = nwg % NXCD, xcd = wgid % NXCD, off = wgid / NXCD; wgid = (xcd < r ? xcd * (q + 1) : r * (q + 1) + (xcd - r) * q) + off; }
        const int nig = WGM * nN, gid = wgid / nig, fm = gid * WGM, gsz = (nM - fm) < WGM ? (nM - fm) : WGM;
        u.pm = fm + ((wgid % nig) % gsz); u.pn = (wgid % nig) / gsz; if (skipctx) u.pm += 1 + (u.pm >= 64 ? 1 : 0); return true;
    }
    __device__ __forceinline__ void a_ready(const Unit&) const {}
    __device__ __forceinline__ void done(const Unit&) const {}
};
struct DenseSplitOrder {
    DenseOrder lat; int G, c;
    __device__ void init(int G_, int c_) { lat.init(NB * SEQ, D, G_, c_, 1); G = G_; c = c_; }
    __device__ bool next(int i, Unit& u) const {
        Unit v; v.pm = 0; v.pn = 0; const bool isl = lat.next(i, v);
        const int Lq = i * G + c - lat.nwg; if (!isl && Lq >= 32) return false;
        const int xcd = Lq & (NXCD - 1), kq = (Lq >> 3) & 3;
        u.pm = isl ? v.pm : ((xcd >> 2) ? 65 : 0); u.pn = isl ? v.pn : (xcd & 3); u.kq = isl ? -1 : kq; u.kt0 = isl ? 0 : 4 * kq; u.nkt = isl ? 16 : 4; return true;
    }
    __device__ __forceinline__ void a_ready(const Unit&) const {}
    __device__ __forceinline__ void done(const Unit&) const {}
};

template <class Epi, class Sched, bool ALIGN_EPI = false, bool SP2 = false, bool GATHER = false, bool BTILED = true, bool SPLITK = false, bool THIN = false>
__device__ __forceinline__ void gemm_phase(PG8_LAS unsigned char* lds, const Gemm g, const Sched& S, const Epi& E) {
    const int tid = otid(), wid = __builtin_amdgcn_readfirstlane(tid >> 6), lane = tid & 63, wr = wid >> 2, wc = wid & 3, fr = lane & 15, fq = lane >> 4;
    const int K = g.K, nt = K / BK;
    static_assert(!GATHER || SP2, "GATHER is wired into the SP2 loop only");
    unsigned voffA[2], voffB[2], goC[2][2], goN[2][2]; int gR[2]; unsigned gC[2];
#pragma unroll
    for (int i = 0; i < 2; ++i) { int R, C; stage_rc(tid * 16 + i * 8192, R, C); const int Rb = Epi::PERM ? ((R & ~31) + perm32(R & 31)) : R;
        voffA[i] = (unsigned)(R * K + C) * 2u; voffB[i] = BTILED ? (unsigned)(tid * 16 + i * 8192) : (unsigned)(Rb * K + C) * 2u; gR[i] = R; gC[i] = (unsigned)C * 2u; }
    static_assert(!BTILED || !Epi::PERM, "BTILED: the weight copy is already in LDS image order (no perm32)");
    PG8_LAS int* gix = (PG8_LAS int*)(lds + STAGE_BYTES + 64);
    const size_t kstep = (size_t)(BK * 2);
    const size_t kstepB = BTILED ? (size_t)HTB : kstep;
    const size_t hstep = (size_t)HALF * K * 2;
    const size_t tstep = 2 * hstep;
    const unsigned ldsw = (unsigned)wid * 1024u;
    const int aoff = lds_byte(wr * 64 + fr, fq * 8), boff = lds_byte(wc * 32 + fr, fq * 8);
#define PG8_SA(b, h) (((b) * 2 + (h)) * HTB)
#define PG8_SB(b, h) ((4 + (b) * 2 + (h)) * HTB)
#define PG8_STAGE(bufoff, gbase, voff) do { _Pragma("unroll") for (int _i = 0; _i < 2; ++_i) \
        __builtin_amdgcn_global_load_lds((const unsigned*)((const char*)(gbase) + (voff)[_i]), (PG8_LAS unsigned*)(lds + (bufoff) + ldsw + _i * 8192), 16, 0, 0); } while (0)
#define PG8_STAGE_A(bufoff, ptr, kb, h, NX) do { if constexpr (GATHER) { const char* _gb = (const char*)g.A + (kb); const unsigned _v0 = (NX) ? goN[h][0] : goC[h][0], _v1 = (NX) ? goN[h][1] : goC[h][1]; \
        __builtin_amdgcn_global_load_lds((const unsigned*)(_gb + _v0), (PG8_LAS unsigned*)(lds + (bufoff) + ldsw), 16, 0, 0); __builtin_amdgcn_global_load_lds((const unsigned*)(_gb + _v1), (PG8_LAS unsigned*)(lds + (bufoff) + ldsw + 8192), 16, 0, 0); } \
    else { PG8_STAGE(bufoff, ptr, voffA); } } while (0)
#define PG8_LDA(dst, b, h) do { _Pragma("unroll") for (int m = 0; m < 4; ++m) _Pragma("unroll") for (int k = 0; k < 2; ++k) dst[m][k] = *(const PG8_LAS bf16x8*)(lds + PG8_SA(b, h) + aoff + m * 2048 + k * 1024); } while (0)
#define PG8_LDB(dst, b, h) do { _Pragma("unroll") for (int n = 0; n < 2; ++n) _Pragma("unroll") for (int k = 0; k < 2; ++k) dst[n][k] = *(const PG8_LAS bf16x8*)(lds + PG8_SB(b, h) + boff + n * 2048 + k * 1024); } while (0)
#define PG8_MMA(ai, bj, At, Bt) do { __builtin_amdgcn_s_setprio(1); _Pragma("unroll") for (int m = 0; m < 4; ++m) _Pragma("unroll") for (int n = 0; n < 2; ++n) _Pragma("unroll") for (int k = 0; k < 2; ++k) \
        acc[ai][bj][m][n] = __builtin_amdgcn_mfma_f32_16x16x32_bf16(Bt[n][k], At[m][k], acc[ai][bj][m][n], 0, 0, 0); __builtin_amdgcn_s_setprio(0); } while (0)
#define PG8_WAIT_V(n) asm volatile("s_waitcnt vmcnt(" #n ")" ::: "memory")
#define PG8_WAIT_L(n) asm volatile("s_waitcnt lgkmcnt(" #n ")" ::: "memory")
#define PG8_BAR __builtin_amdgcn_s_barrier()
#define PG8_SCHED __builtin_amdgcn_sched_barrier(0)
    Unit cur, nxt; int ui = 0;
    if (!S.next(0, cur)) return;
    cur.par = 0;
    f32x4 acc[2][2][4][2];
#pragma unroll
    for (int a = 0; a < 2; ++a)
#pragma unroll
        for (int b = 0; b < 2; ++b)
#pragma unroll
            for (int m = 0; m < 4; ++m)
#pragma unroll
                for (int n = 0; n < 2; ++n) acc[a][b][m][n] = (f32x4){0.f, 0.f, 0.f, 0.f};
    bf16x8 At[4][2], B0[2][2], B1[2][2];
    const char* cA = (const char*)g.A + (size_t)cur.pm * tstep; const char* cB = (const char*)g.Bt + (size_t)cur.pn * tstep;
    if constexpr (SPLITK) { cA += (size_t)cur.kt0 * kstep; cB += (size_t)cur.kt0 * kstepB; }
    if constexpr (GATHER) {
#pragma unroll
        for (int h = 0; h < 2; ++h)
#pragma unroll
            for (int i = 0; i < 2; ++i) { goC[h][i] = (unsigned)g.gidx[(size_t)cur.pm * BM + h * HALF + gR[i]] * (unsigned)(K * 2) + gC[i]; goN[h][i] = goC[h][i]; } }
    S.a_ready(cur);
    if constexpr (SP2) {
        PG8_STAGE(PG8_SB(0, 0), cB, voffB); PG8_STAGE(PG8_SB(0, 1), cB + hstep, voffB); PG8_STAGE_A(PG8_SA(0, 0), cA, 0, 0, false); PG8_STAGE_A(PG8_SA(0, 1), cA + hstep, 0, 1, false);
        if (wr == 1) PG8_BAR;
        PG8_WAIT_V(2); PG8_BAR;
        PG8_STAGE(PG8_SB(1, 0), cB + kstepB, voffB); PG8_STAGE_A(PG8_SA(1, 0), cA + kstep, kstep, 0, false); PG8_STAGE(PG8_SB(1, 1), cB + hstep + kstepB, voffB);
        PG8_WAIT_V(6); PG8_BAR;
    } else {
        PG8_STAGE(PG8_SB(0, 0), cB, voffB); PG8_STAGE(PG8_SA(0, 0), cA, voffA); PG8_STAGE(PG8_SB(0, 1), cB + hstep, voffB); PG8_STAGE(PG8_SA(0, 1), cA + hstep, voffA);
        if (wr == 1) PG8_BAR;
        PG8_WAIT_V(4); PG8_BAR;
        PG8_STAGE(PG8_SB(1, 0), cB + kstepB, voffB); PG8_STAGE(PG8_SA(1, 0), cA + kstep, voffA); PG8_STAGE(PG8_SB(1, 1), cB + hstep + kstepB, voffB);
        PG8_WAIT_V(6); PG8_BAR;
    }
    for (;;) {
        const bool has_next = S.next(ui + 1, nxt);
        nxt.par = (ui + 1) & 1;
        const char* nA = has_next ? (const char*)g.A + (size_t)nxt.pm * tstep + (SPLITK ? (size_t)nxt.kt0 * kstep : (size_t)0) : cA; const char* nB = has_next ? (const char*)g.Bt + (size_t)nxt.pn * tstep + (SPLITK ? (size_t)nxt.kt0 * kstepB : (size_t)0) : cB;
        const int ntc = SPLITK ? cur.nkt : nt;
        constexpr bool thin = THIN;
        if constexpr (Epi::PRE) E.pre(cur, wid, lane);
        if constexpr (GATHER) { if (has_next && wid < 4) __builtin_amdgcn_global_load_lds((const unsigned*)(g.gidx + (size_t)nxt.pm * BM + wid * 64 + lane), (PG8_LAS unsigned*)(gix + ((ui + 1) & 1) * 256 + wid * 64), 4, 0, 0); }
        for (int t = 0; t < ntc; t += 2) {
            const bool last = (t == ntc - 2);
            const char* a1 = cA + (size_t)(t + 1) * kstep;
            const char* a2 = last ? nA : cA + (size_t)(t + 2) * kstep; const char* b2 = last ? nB : cB + (size_t)(t + 2) * kstepB;
            const char* a3 = a2 + kstep; const char* b3 = b2 + kstepB;
            if (last && has_next) S.a_ready(nxt);
            const size_t kb2 = last ? (size_t)0 : (size_t)(t + 2) * kstep;
            if constexpr (GATHER) { if (last && has_next) {
#pragma unroll
                for (int h = 0; h < 2; ++h)
#pragma unroll
                    for (int i = 0; i < 2; ++i) goN[h][i] = (unsigned)gix[((ui + 1) & 1) * 256 + h * HALF + gR[i]] * (unsigned)(K * 2) + gC[i]; } }
            if constexpr (SP2) {
            PG8_LDB(B0, 0, 0); PG8_LDB(B1, 0, 1); PG8_SCHED; PG8_LDA(At, 0, 0); PG8_STAGE_A(PG8_SA(1, 1), a1 + hstep, (size_t)(t + 1) * kstep, 1, false);
            PG8_WAIT_V(8); PG8_WAIT_L(0); PG8_BAR; PG8_MMA(0, 0, At, B0); PG8_MMA(0, 1, At, B1); PG8_BAR; PG8_SCHED;
            PG8_LDA(At, 0, 1); PG8_STAGE(PG8_SB(0, 0), b2, voffB); PG8_STAGE(PG8_SB(0, 1), b2 + hstep, voffB); PG8_STAGE_A(PG8_SA(0, 0), a2, kb2, 0, last);
            PG8_WAIT_V(8); PG8_WAIT_L(0); PG8_BAR; if (!thin) { PG8_MMA(1, 0, At, B0); PG8_MMA(1, 1, At, B1); } PG8_BAR; PG8_SCHED;
            PG8_LDB(B0, 1, 0); PG8_LDB(B1, 1, 1); PG8_SCHED; PG8_LDA(At, 1, 0); PG8_STAGE_A(PG8_SA(0, 1), a2 + hstep, kb2, 1, last);
            PG8_WAIT_V(8); PG8_WAIT_L(0); PG8_BAR; PG8_MMA(0, 0, At, B0); PG8_MMA(0, 1, At, B1); PG8_BAR; PG8_SCHED;
            PG8_LDA(At, 1, 1); PG8_STAGE(PG8_SB(1, 0), b3, voffB); PG8_STAGE(PG8_SB(1, 1), b3 + hstep, voffB); PG8_STAGE_A(PG8_SA(1, 0), a3, kb2 + kstep, 0, last);
            PG8_WAIT_V(8); PG8_WAIT_L(0); PG8_BAR; if (!thin) { PG8_MMA(1, 0, At, B0); PG8_MMA(1, 1, At, B1); } PG8_BAR; PG8_SCHED;
            } else {
            PG8_LDB(B0, 0, 0); PG8_SCHED; PG8_LDA(At, 0, 0); PG8_STAGE(PG8_SA(1, 1), a1 + hstep, voffA);
            PG8_WAIT_L(8); PG8_BAR; PG8_WAIT_L(0); PG8_MMA(0, 0, At, B0); PG8_BAR; PG8_SCHED;
            PG8_LDB(B1, 0, 1); PG8_STAGE(PG8_SB(0, 0), b2, voffB);
            PG8_BAR; PG8_WAIT_L(0); PG8_MMA(0, 1, At, B1); PG8_BAR;
            PG8_LDA(At, 0, 1); PG8_STAGE(PG8_SA(0, 0), a2, voffA);
            PG8_BAR; PG8_WAIT_L(0); PG8_MMA(1, 0, At, B0); PG8_BAR; PG8_SCHED;
            PG8_STAGE(PG8_SB(0, 1), b2 + hstep, voffB);
            PG8_WAIT_V(6); PG8_BAR; PG8_MMA(1, 1, At, B1); PG8_BAR;
            PG8_LDB(B0, 1, 0); PG8_SCHED; PG8_LDA(At, 1, 0); PG8_STAGE(PG8_SA(0, 1), a2 + hstep, voffA);
            PG8_WAIT_L(8); PG8_BAR; PG8_WAIT_L(0); PG8_MMA(0, 0, At, B0); PG8_BAR; PG8_SCHED;
            PG8_LDB(B1, 1, 1); PG8_STAGE(PG8_SB(1, 0), b3, voffB);
            PG8_BAR; PG8_WAIT_L(0); PG8_MMA(0, 1, At, B1); PG8_BAR;
            PG8_LDA(At, 1, 1); PG8_STAGE(PG8_SA(1, 0), a3, voffA);
            PG8_BAR; PG8_WAIT_L(0); PG8_MMA(1, 0, At, B0); PG8_BAR; PG8_SCHED;
            PG8_STAGE(PG8_SB(1, 1), b3 + hstep, voffB);
            PG8_WAIT_V(6); PG8_BAR; PG8_MMA(1, 1, At, B1); PG8_BAR;
            }
        }
        if constexpr (ALIGN_EPI) { if (wr == 0) PG8_BAR; }
        if constexpr (!Epi::AFTER_DRAIN) { E(acc, cur, wr, wc, fr, fq); S.done(cur); }
        if (!has_next) break;
#pragma unroll
        for (int a = 0; a < 2; ++a)
#pragma unroll
            for (int b = 0; b < 2; ++b)
#pragma unroll
                for (int m = 0; m < 4; ++m)
#pragma unroll
                    for (int n = 0; n < 2; ++n) acc[a][b][m][n] = (f32x4){0.f, 0.f, 0.f, 0.f};
        cur = nxt; cA = nA; cB = nB; ++ui;
        if constexpr (GATHER) {
#pragma unroll
            for (int h = 0; h < 2; ++h)
#pragma unroll
                for (int i = 0; i < 2; ++i) goC[h][i] = goN[h][i]; }
        if constexpr (ALIGN_EPI) { if (wr == 1) PG8_BAR; }
    }
    PG8_WAIT_V(0);
    if constexpr (!ALIGN_EPI) { if (wr == 0) PG8_BAR; }
    PG8_BAR;
    if constexpr (Epi::AFTER_DRAIN) { E.fused(acc, cur, wr, wc, fr, fq, lds, wid, lane); S.done(cur); }
#undef PG8_SA
#undef PG8_SB
#undef PG8_STAGE
#undef PG8_STAGE_A
#undef PG8_LDA
#undef PG8_LDB
#undef PG8_MMA
#undef PG8_WAIT_V
#undef PG8_WAIT_L
#undef PG8_BAR
#undef PG8_SCHED
}
}


__device__ __forceinline__ void phase_qkv(const Params& P, int layer, LAS unsigned char* lds) {
    unsigned char* const ws = ows(P);
    pg8::Gemm g{(const bf16_t*)(ws + WS_H), (const bf16_t*)(ws + WS_WQKV) + (size_t)layer * QKVW * D, R, QKVW, D};
    pg8::DenseOrder S; S.init(R, QKVW, (int)gridDim.x, (int)blockIdx.x);
    LAS float* ropel = (LAS float*)(lds + pg8::STAGE_BYTES + 4608);
    { const int tid = otid(); ((LAS f32x4*)ropel)[tid] = ((const f32x4*)(ws + WS_ROPE))[tid]; __syncthreads(); }
    pg8::EpiQKV E{ws, (const float*)(ws + WS_ROPE), P.q_norm_g + (layer >> 1) * 64, P.k_norm_g + (layer >> 1) * 64, (layer & 1) == 0 ? 1 : 0, ropel};
    pg8::gemm_phase<pg8::EpiQKV, pg8::DenseOrder, true, true>(lds, g, S, E);
}
__device__ __forceinline__ void phase_oproj(const Params& P, int layer, LAS unsigned char* lds) {
    unsigned char* const ws = ows(P);
    pg8::Gemm g{(const bf16_t*)(ws + WS_O), (const bf16_t*)(ws + WS_WO) + (size_t)layer * D * D, R, D, D};
    pg8::EpiResid E{(bf16_t*)(ws + WS_XR), (const float*)(ws + WS_MOD) + (size_t)layer * 3 * 6144, P.x, P.ctx, layer == 0 ? 1 : 0, (float*)(ws + WS_XSEL)};
    if (layer == DEPTH - 1) { pg8::DenseOrder S; S.init(NB * SEQ, D, (int)gridDim.x, (int)blockIdx.x, 1); pg8::gemm_phase<pg8::EpiResid, pg8::DenseOrder, true, true>(lds, g, S, E); }
    else { pg8::DenseSplitOrder S; S.init((int)gridDim.x, (int)blockIdx.x); pg8::gemm_phase<pg8::EpiResid, pg8::DenseSplitOrder, true, true, false, true, true>(lds, g, S, E); }
}
__device__ __forceinline__ void phase_gateup(const Params& P, int layer, LAS unsigned char* lds) {
    unsigned char* const ws = ows(P);
    pg8::Gemm g{(const bf16_t*)(ws + WS_H), (const bf16_t*)(ws + WS_WGU) + (size_t)layer * NE * (2 * DE) * D, NSLOT, 2 * DE, D, (const int*)(ws + WS_SELI)};
    pg8::EpiSwiGLU E{(bf16_t*)(ws + WS_ACT), 16};
    { pg8::MoeOrder S; S.init(16, 16, (int)gridDim.x, (int)blockIdx.x); pg8::gemm_phase<pg8::EpiSwiGLU, pg8::MoeOrder, true, true, true>(lds, g, S, E); }
    if (layer != DEPTH - 1) { pg8::CtxGateUpOrder S; S.init((int)gridDim.x, (int)blockIdx.x); pg8::gemm_phase<pg8::EpiSwiGLU, pg8::CtxGateUpOrder, true, true, true, true, false, true>(lds, g, S, E); }
}
__device__ __forceinline__ void phase_down(const Params& P, int layer, LAS unsigned char* lds) {
    unsigned char* const ws = ows(P);
    pg8::Gemm g{(const bf16_t*)(ws + WS_ACT), (const bf16_t*)(ws + WS_WD) + (size_t)layer * NE * D * DE, NSLOT, D, DE};
    pg8::EpiDown E{(bf16_t*)(ws + WS_Y), (const float*)(ws + WS_SELG), 4, (LAS float*)(lds + pg8::STAGE_BYTES + 2112)};
    { pg8::MoeOrder S; S.init(16, 4, (int)gridDim.x, (int)blockIdx.x); pg8::gemm_phase<pg8::EpiDown, pg8::MoeOrder, true, true>(lds, g, S, E); }
    if (layer != DEPTH - 1) { pg8::CtxDownOrder S; S.init((int)gridDim.x, (int)blockIdx.x); pg8::gemm_phase<pg8::EpiDown, pg8::CtxDownOrder, true, true, false, true, true, true>(lds, g, S, E); }
}
namespace attn_body {
using bf16=__hip_bfloat16;
using bf16x8=__attribute__((ext_vector_type(8)))short;
using s16x4=__attribute__((ext_vector_type(4)))short;
using f32x16=__attribute__((ext_vector_type(16)))float;
using u32x4=__attribute__((ext_vector_type(4)))unsigned;
constexpr int D=64,DM=1024,KP=256;
constexpr int NW=8,QBLK=32,QB=QBLK*NW,KVBLK=64;
__device__ __forceinline__ int crow(int r,int hi){return (r&3)+8*(r>>2)+4*hi;}
#define SBAR() __builtin_amdgcn_sched_barrier(0)
__device__ __forceinline__ void wmask(f32x16&p0,f32x16&p1,int dk0,int hi){
  const float NEG=-INFINITY; const int kb=dk0+4*hi;
  #pragma unroll
  for(int r=0;r<16;++r){const int dk=kb+(r&3)+8*(r>>2); if(dk<-128||dk>128)p0[r]=NEG; if(dk+32<-128||dk+32>128)p1[r]=NEG;}
}

constexpr int NSLOT=3, SLOTB=8192;
constexpr int LDS_K=0, LDS_V=NSLOT*SLOTB, LDS_WS=2*NSLOT*SLOTB, LDS_OST=LDS_WS+NW*64*4, LDS_BYTES=LDS_OST+NW*4096;
constexpr float C2=0.125f*1.4426950408889634f;
__device__ __forceinline__ void glds16(const void*gsrc,unsigned lds_dst){unsigned keep;
  asm volatile("s_mov_b32 %0, m0\n\ts_mov_b32 m0, %2\n\ts_nop 0\n\tglobal_load_lds_dwordx4 %1, off\n\ts_mov_b32 m0, %0":"=&s"(keep):"v"(gsrc),"s"(lds_dst):"memory");}
__device__ __forceinline__ float max3f(float a,float b,float c){float r;asm("v_max3_f32 %0, %1, %2, %3":"=v"(r):"v"(a),"v"(b),"v"(c));return r;}
__device__ __forceinline__ float max2f(float a,float b){float r;asm("v_max_f32_e32 %0, %1, %2":"=v"(r):"v"(a),"v"(b));return r;}
__device__ __forceinline__ float fadd_s(float a,float b){float r;asm("v_add_f32_e32 %0, %1, %2":"=v"(r):"v"(a),"v"(b));return r;}
__device__ __forceinline__ float fsub_s(float a,float b){float r;asm("v_sub_f32_e32 %0, %1, %2":"=v"(r):"v"(a),"v"(b));return r;}
typedef float f32x2_t __attribute__((ext_vector_type(2))); typedef __bf16 bf16x2_t __attribute__((ext_vector_type(2)));
__device__ __forceinline__ unsigned cvtpk_s(float lo,float hi){f32x2_t v={lo,hi};bf16x2_t b=__builtin_convertvector(v,bf16x2_t);return __builtin_bit_cast(unsigned,b);}
#define WAIT_BAR(N) asm volatile("s_waitcnt vmcnt(" #N ") lgkmcnt(0)\n\ts_barrier":::"memory")

__device__ __forceinline__ void qkt(f32x16&p0,f32x16&p1,const char*Kslot,const bf16x8*qr,const f32x16&negm,int r32,int hi){
  const char*kb=Kslot+hi*1024+r32*16;
  #pragma unroll
  for(int d0=0;d0<4;++d0){
    const bf16x8 b0=*reinterpret_cast<const bf16x8*>(kb+d0*2048);
    const bf16x8 b1=*reinterpret_cast<const bf16x8*>(kb+d0*2048+512);
    if(d0==0){p0=__builtin_amdgcn_mfma_f32_32x32x16_bf16(b0,qr[0],negm,0,0,0);p1=__builtin_amdgcn_mfma_f32_32x32x16_bf16(b1,qr[0],negm,0,0,0);}
    else{p0=__builtin_amdgcn_mfma_f32_32x32x16_bf16(b0,qr[d0],p0,0,0,0);p1=__builtin_amdgcn_mfma_f32_32x32x16_bf16(b1,qr[d0],p1,0,0,0);}}
}
typedef __attribute__((address_space(3))) const char* lds_cptr;
typedef short v4i16_t __attribute__((ext_vector_type(4)));
__device__ __forceinline__ void kload8(bf16x8*kf,lds_cptr kp){
  kf[0]=*(const __attribute__((address_space(3))) bf16x8*)(kp);      kf[1]=*(const __attribute__((address_space(3))) bf16x8*)(kp+512);
  kf[2]=*(const __attribute__((address_space(3))) bf16x8*)(kp+2048); kf[3]=*(const __attribute__((address_space(3))) bf16x8*)(kp+2560);
  kf[4]=*(const __attribute__((address_space(3))) bf16x8*)(kp+4096); kf[5]=*(const __attribute__((address_space(3))) bf16x8*)(kp+4608);
  kf[6]=*(const __attribute__((address_space(3))) bf16x8*)(kp+6144); kf[7]=*(const __attribute__((address_space(3))) bf16x8*)(kp+6656);
}
__device__ __forceinline__ void kload2(bf16x8*kf,lds_cptr kp,int j){ kf[2*j]=*(const __attribute__((address_space(3))) bf16x8*)(kp+j*2048); kf[2*j+1]=*(const __attribute__((address_space(3))) bf16x8*)(kp+j*2048+512); }
__device__ __forceinline__ s16x4 vtr(lds_cptr p){ return __builtin_bit_cast(s16x4,__builtin_amdgcn_ds_read_tr16_b64_v4i16((__attribute__((address_space(3))) v4i16_t*)p)); }
__device__ __forceinline__ float rowmax(const f32x16&p0,const f32x16&p1){
  float a=max3f(p0[0],p0[1],p1[0]),b=max3f(p0[2],p0[3],p1[1]);a=max3f(a,p1[2],p1[3]);
  #pragma unroll
  for(int r=4;r<16;r+=4){a=max3f(a,p0[r],p0[r+1]);b=max3f(b,p0[r+2],p0[r+3]);a=max3f(a,p1[r],p1[r+1]);b=max3f(b,p1[r+2],p1[r+3]);}
  const float m=max2f(a,b);
  auto rr=__builtin_amdgcn_permlane32_swap(__float_as_uint(m),__float_as_uint(m),false,false);
  return max2f(__uint_as_float(rr[0]),__uint_as_float(rr[1]));
}
__device__ __forceinline__ void pv(f32x16*o,int vb,bf16x8 pa0,bf16x8 pa1,bf16x8 pa2,bf16x8 pa3){
  #pragma unroll
  for(int d0=0;d0<2;++d0){s16x4 lo[4],hi[4];
    #pragma unroll
    for(int ks=0;ks<4;++ks){
      asm volatile("ds_read_b64_tr_b16 %0,%1 offset:%c2":"=&v"(lo[ks]):"v"(vb),"i"(d0*4096+ks*1024):"memory");
      asm volatile("ds_read_b64_tr_b16 %0,%1 offset:%c2":"=&v"(hi[ks]):"v"(vb),"i"(d0*4096+ks*1024+512):"memory");}
    asm volatile("s_waitcnt lgkmcnt(0)":::"memory");SBAR();
    #define PK(k) (bf16x8){lo[k][0],lo[k][1],lo[k][2],lo[k][3],hi[k][0],hi[k][1],hi[k][2],hi[k][3]}
    o[d0]=__builtin_amdgcn_mfma_f32_32x32x16_bf16(pa0,PK(0),o[d0],0,0,0);
    o[d0]=__builtin_amdgcn_mfma_f32_32x32x16_bf16(pa1,PK(1),o[d0],0,0,0);
    o[d0]=__builtin_amdgcn_mfma_f32_32x32x16_bf16(pa2,PK(2),o[d0],0,0,0);
    o[d0]=__builtin_amdgcn_mfma_f32_32x32x16_bf16(pa3,PK(3),o[d0],0,0,0);
    #undef PK
  }
}

#ifndef ATTN_STORE16
#define ATTN_STORE16(p,v) (*(u32x4*)(p)=(v))
#endif
struct AttnUnit { int qrow0, kvrow0, h, nt, lo, t0, kt0; };
template<int THRL,bool WINDOW,bool FIXREF> __device__ __forceinline__ void attn_unit(const AttnUnit u,const bf16*Q,const bf16*__restrict__ K,const bf16*__restrict__ V,bf16*O,char*shm,float sinkl2,float mfix){
  const int tid=otid(),lane=tid&63,r32=lane&31,hi=lane>>5; const int wid=__builtin_amdgcn_readfirstlane(tid>>6);
  const bf16*Qw=Q+((long)u.qrow0+wid*QBLK)*DM+u.h*D;
  const bf16*Kh=K+(long)u.kt0*4096,*Vh=V+(long)u.kt0*4096;
  const unsigned lds0=(unsigned)(uintptr_t)shm;
  float*wsf=(float*)(shm+LDS_WS)+wid*64;
  const bf16*ksrc=Kh+wid*512+lane*8;
  const bf16*vsrc=Vh+(wid>>2)*2048+(16*(wid&3)+(lane>>2))*32+(lane&3)*8;
  const unsigned kdst=lds0+LDS_K+wid*1024, vdst=lds0+LDS_V+wid*1024;
  #define TROW(t) (KVBLK*(t)+((WINDOW&&(t)>=4)?u.lo:0))
  #define DMA_K(t,slot) glds16(ksrc+(long)(TROW(t)>>6)*4096,(unsigned)__builtin_amdgcn_readfirstlane(kdst+(slot)))
  #define DMA_V(t,slot) glds16(vsrc+(long)(TROW(t)>>6)*4096,(unsigned)__builtin_amdgcn_readfirstlane(vdst+(slot)))
  const int vb0=(int)(lds0+LDS_V)+((lane>>4)&1)*32+(lane&3)*8+(4*hi+((lane&15)>>2))*64;
  const char*Kbase=shm+LDS_K; bf16x8 kf[8];
  const lds_cptr shm3=(lds_cptr)shm; const lds_cptr kp0=shm3+LDS_K+hi*1024+r32*16; const lds_cptr vp0=shm3+LDS_V+((lane>>4)&1)*32+(lane&3)*8+(4*hi+((lane&15)>>2))*64;
  const int NT=u.nt;
  DMA_K(0,0);DMA_V(0,0);DMA_K(1,SLOTB);
  bf16x8 qr[4];
  #pragma unroll
  for(int d0=0;d0<4;++d0)qr[d0]=*reinterpret_cast<const bf16x8*>(&Qw[(long)r32*DM+d0*16+hi*8]);
  float mhat=FIXREF?mfix:0.f,l_reg=0.f;f32x16 o[2];o[0]=f32x16{};o[1]=f32x16{};f32x16 negm=f32x16{};
  if(FIXREF){_Pragma("unroll") for(int r=0;r<16;++r)negm[r]=-mfix;} asm volatile("":"+v"(negm));
  const int qrel=wid*QBLK+r32;
  #define CMASK(P0,P1,t) do{ if(WINDOW){ if((t)>=4){ const int kq_=u.lo+KVBLK*((t)-4)-u.t0-wid*QBLK;     \
      if(kq_<31-128||kq_+63>128) wmask(P0,P1,kq_-r32,hi); } } }while(0)
  bool resc=false;
  #define START(P0,P1) do{ resc=false; \
    if constexpr(!FIXREF){ const float rm=rowmax(P0,P1); const float dl=rm; mhat=fadd_s(mhat,dl); \
      _Pragma("unroll") for(int r=0;r<16;++r){P0[r]=fsub_s(P0[r],dl);P1[r]=fsub_s(P1[r],dl);} \
      _Pragma("unroll") for(int r=0;r<16;++r)negm[r]=-mhat; asm volatile("":"+v"(negm)); } \
    _Pragma("unroll") for(int r=0;r<16;++r)P0[r]=__builtin_amdgcn_exp2f(P0[r]); }while(0)
  #define RESC() do{ if(!FIXREF&&resc){ asm volatile("s_waitcnt lgkmcnt(0)":::"memory"); \
      _Pragma("unroll") for(int d_=0;d_<2;++d_) _Pragma("unroll") for(int r=0;r<16;++r)o[d_][r]*=wsf[crow(r,hi)]; } }while(0)
  f32x16 pA0,pA1,pB0,pB1;
  int sl_prev=0,sl_cur=0,sl_next=SLOTB;
  #define ROT() do{sl_prev=sl_cur;sl_cur=sl_next;sl_next=(sl_next==(NSLOT-1)*SLOTB)?0:sl_next+SLOTB;}while(0)
  DMA_K(2,2*SLOTB);
  WAIT_BAR(3);
  qkt(pA0,pA1,Kbase,qr,negm,r32,hi);asm volatile("s_nop 15\n\ts_nop 7":"+v"(pA0),"+v"(pA1));CMASK(pA0,pA1,0);
  START(pA0,pA1);
  _Pragma("unroll") for(int r=0;r<16;++r)pA1[r]=__builtin_amdgcn_exp2f(pA1[r]);
  WAIT_BAR(0);
  DMA_K(3,0);DMA_V(1,SLOTB);
  ROT();
  kload8(kf,kp0+sl_cur);
  WAIT_BAR(2);
  s16x4 vlo[8],vhi[8]; u32x4 pw0,pw1,pw2,pw3;
  #define PKW(P,B) cvtpk_s(P[B],P[B+1])
  #define PAF(k) __builtin_bit_cast(bf16x8,pw##k)
  #define VFR(i) (bf16x8){vlo[i][0],vlo[i][1],vlo[i][2],vlo[i][3],vhi[i][0],vhi[i][1],vhi[i][2],vhi[i][3]}
  #define PIN(x) asm volatile("":"+v"(x))
  #define MX3(a,b,c) __builtin_fmaxf(__builtin_fmaxf((a),(b)),(c))
  #define GAPA(MF,A0,A1,A2,A3,W0,W1,PW) do{ MF; sacc+=A0; sacc+=A1; sacc+=A2; sacc+=A3; PIN(sacc); W0; W1; PIN(PW); SBAR(); }while(0)
  #define EX(v) __builtin_amdgcn_exp2f(v)
  #define GAPB(MF,X,B) do{ MF; X[B]=EX(X[B]); X[B+1]=EX(X[B+1]); X[B+2]=EX(X[B+2]); X[B+3]=EX(X[B+3]); PIN(X); SBAR(); }while(0)
  #define VRD(i) do{ vlo[i]=vtr(vp_+(((i)>>2)*4096+((i)&3)*1024)); vhi[i]=vtr(vp_+(((i)>>2)*4096+((i)&3)*1024+512)); }while(0)
  #define KRD(G,j) do{ if(G){ kload2(kf,kp0+sl_next,j); SBAR(); } }while(0)
  #define STEP(C0,C1,P0,P1,t,GK,GV,GL) do{ SBAR(); \
    const lds_cptr vp_=vp0+sl_prev; \
    VRD(0); SBAR(); float sacc=(P0[0]+P0[1]); \
    GAPA(C0=__builtin_amdgcn_mfma_f32_32x32x16_bf16(kf[0],qr[0],negm,0,0,0), P0[2],P0[3],P0[4],P0[5],     pw0[0]=PKW(P0,0), pw0[1]=PKW(P0,2), pw0); \
    VRD(4); SBAR(); GAPA(C1=__builtin_amdgcn_mfma_f32_32x32x16_bf16(kf[1],qr[0],negm,0,0,0), P0[6],P0[7],P0[8],P0[9],     pw0[2]=PKW(P0,4), pw0[3]=PKW(P0,6), pw0); \
    VRD(1); SBAR(); GAPA(C0=__builtin_amdgcn_mfma_f32_32x32x16_bf16(kf[2],qr[1],C0,0,0,0),   P0[10],P0[11],P0[12],P0[13], pw1[0]=PKW(P0,8), pw1[1]=PKW(P0,10), pw1); \
    VRD(5); SBAR(); GAPA(C1=__builtin_amdgcn_mfma_f32_32x32x16_bf16(kf[3],qr[1],C1,0,0,0),   P0[14],P0[15],P1[0],P1[1],   pw1[2]=PKW(P0,12),pw1[3]=PKW(P0,14), pw1); \
    VRD(2); SBAR(); GAPA(C0=__builtin_amdgcn_mfma_f32_32x32x16_bf16(kf[4],qr[2],C0,0,0,0),   P1[2],P1[3],P1[4],P1[5],     pw2[0]=PKW(P1,0), pw2[1]=PKW(P1,2), pw2); \
    VRD(6); SBAR(); GAPA(C1=__builtin_amdgcn_mfma_f32_32x32x16_bf16(kf[5],qr[2],C1,0,0,0),   P1[6],P1[7],P1[8],P1[9],     pw2[2]=PKW(P1,4), pw2[3]=PKW(P1,6), pw2); \
    VRD(3); SBAR(); GAPA(C0=__builtin_amdgcn_mfma_f32_32x32x16_bf16(kf[6],qr[3],C0,0,0,0),   P1[10],P1[11],P1[12],P1[13], pw3[0]=PKW(P1,8), pw3[1]=PKW(P1,10), pw3); \
    VRD(7); SBAR(); GAPA(C1=__builtin_amdgcn_mfma_f32_32x32x16_bf16(kf[7],qr[3],C1,0,0,0),   P1[14],P1[15],0.f,0.f,       pw3[2]=PKW(P1,12),pw3[3]=PKW(P1,14), pw3); \
    l_reg+=sacc; \
    if(GK){DMA_K((t)+3,sl_cur);} if(GV){DMA_V((t)+1,sl_next);} \
    CMASK(C0,C1,t); \
    if constexpr(!FIXREF){ float a=MX3(C0[0],C0[1],C1[0]),b=MX3(C0[2],C0[3],C1[1]); a=MX3(a,C1[2],C1[3]); \
      _Pragma("unroll") for(int r=4;r<16;r+=4){a=MX3(a,C0[r],C0[r+1]);b=MX3(b,C0[r+2],C0[r+3]);a=MX3(a,C1[r],C1[r+1]);b=MX3(b,C1[r+2],C1[r+3]);} \
      float rm=__builtin_fmaxf(a,b); { auto rr=__builtin_amdgcn_permlane32_swap(__float_as_uint(rm),__float_as_uint(rm),false,false); rm=__builtin_fmaxf(__uint_as_float(rr[0]),__uint_as_float(rr[1])); } \
      resc=false; \
      if(__builtin_expect(__any(rm>(float)THRL),0)){ const float dl=__builtin_fmaxf(rm,0.f); mhat+=dl; \
        _Pragma("unroll") for(int r=0;r<16;++r){C0[r]-=dl;C1[r]-=dl;} \
        _Pragma("unroll") for(int r=0;r<16;++r)negm[r]=-mhat; asm volatile("":"+v"(negm)); \
        const float f=__builtin_amdgcn_exp2f(-dl); l_reg*=f; if(hi==0)wsf[r32]=f; resc=true; } } \
    SBAR(); \
    GAPB(o[0]=__builtin_amdgcn_mfma_f32_32x32x16_bf16(PAF(0),VFR(0),o[0],0,0,0), C0,0); \
    GAPB(o[1]=__builtin_amdgcn_mfma_f32_32x32x16_bf16(PAF(0),VFR(4),o[1],0,0,0), C0,4); \
    KRD(GL,0); GAPB(o[0]=__builtin_amdgcn_mfma_f32_32x32x16_bf16(PAF(1),VFR(1),o[0],0,0,0), C0,8); \
    KRD(GL,1); GAPB(o[1]=__builtin_amdgcn_mfma_f32_32x32x16_bf16(PAF(1),VFR(5),o[1],0,0,0), C0,12); \
    KRD(GL,2); GAPB(o[0]=__builtin_amdgcn_mfma_f32_32x32x16_bf16(PAF(2),VFR(2),o[0],0,0,0), C1,0); \
    KRD(GL,3); GAPB(o[1]=__builtin_amdgcn_mfma_f32_32x32x16_bf16(PAF(2),VFR(6),o[1],0,0,0), C1,4); \
    GAPB(o[0]=__builtin_amdgcn_mfma_f32_32x32x16_bf16(PAF(3),VFR(3),o[0],0,0,0), C1,8); \
    GAPB(o[1]=__builtin_amdgcn_mfma_f32_32x32x16_bf16(PAF(3),VFR(7),o[1],0,0,0), C1,12); \
    }while(0)
  int t=1;
  for(;t+5<NT;t+=2){
    STEP(pB0,pB1,pA0,pA1,t,true,true,true);     WAIT_BAR(2); RESC(); ROT();
    STEP(pA0,pA1,pB0,pB1,t+1,true,true,true);   WAIT_BAR(2); RESC(); ROT();
  }
  #define ENDW(tt) do{ if((tt)+3<NT){WAIT_BAR(2);} else if((tt)+2<NT){WAIT_BAR(1);} else {WAIT_BAR(0);} }while(0)
  for(;t+1<NT;t+=2){
    STEP(pB0,pB1,pA0,pA1,t,(t+3<NT),(t+1<NT),(t+1<NT));       ENDW(t);   RESC(); ROT();
    STEP(pA0,pA1,pB0,pB1,t+1,(t+4<NT),(t+2<NT),(t+2<NT));     ENDW(t+1); RESC(); ROT();
  }
  STEP(pB0,pB1,pA0,pA1,NT-1,false,false,false); RESC();
  { float sacc=pB0[0]+pB0[1]; _Pragma("unroll") for(int r=2;r<16;++r)sacc+=pB0[r]; _Pragma("unroll") for(int r=0;r<16;++r)sacc+=pB1[r]; l_reg+=sacc;
    pw0=(u32x4){PKW(pB0,0),PKW(pB0,2),PKW(pB0,4),PKW(pB0,6)};pw1=(u32x4){PKW(pB0,8),PKW(pB0,10),PKW(pB0,12),PKW(pB0,14)};pw2=(u32x4){PKW(pB1,0),PKW(pB1,2),PKW(pB1,4),PKW(pB1,6)};pw3=(u32x4){PKW(pB1,8),PKW(pB1,10),PKW(pB1,12),PKW(pB1,14)};
    SBAR(); pv(o,vb0+sl_cur,PAF(0),PAF(1),PAF(2),PAF(3)); }
  #undef PKW
  #undef PAF
  #undef VFR
  #undef PIN
  #undef MX3
  #undef GAPA
  #undef GAPB
  #undef EX
  #undef VRD
  #undef KRD
  #undef STEP
  #undef ENDW
  {auto rr=__builtin_amdgcn_permlane32_swap(__float_as_uint(l_reg),__float_as_uint(l_reg),false,false);l_reg=__uint_as_float(rr[0])+__uint_as_float(rr[1]);}
  if(WINDOW)l_reg+=__builtin_amdgcn_exp2f(sinkl2-mhat);
  if(hi==0)wsf[32+r32]=l_reg;asm volatile("s_waitcnt lgkmcnt(0)":::"memory");
  float rli[16];
  #pragma unroll
  for(int r=0;r<16;++r)rli[r]=__builtin_amdgcn_rcpf(wsf[32+crow(r,hi)]);
  bf16*Ow=O+((long)u.qrow0+wid*QBLK)*DM+u.h*D;
  { bf16*stg=(bf16*)(shm+LDS_OST)+wid*2048;
    #pragma unroll
    for(int r=0;r<16;++r){const int orow=crow(r,hi);
      #pragma unroll
      for(int d0=0;d0<2;++d0)stg[orow*64+d0*32+r32]=__float2bfloat16(o[d0][r]*rli[r]);}
    asm volatile("s_waitcnt lgkmcnt(0)":::"memory");
    #pragma unroll
    for(int i=0;i<4;++i){const int row=i*8+(lane>>3),ch=lane&7; const u32x4 v=*(const u32x4*)(stg+row*64+ch*8); ATTN_STORE16(Ow+(long)row*DM+ch*8,v);} }
  asm volatile("s_waitcnt lgkmcnt(0)\n\ts_barrier":::"memory");
  #undef DMA_K
  #undef TROW
  #undef DMA_V
  #undef CMASK
  #undef START
  #undef RESC
  #undef ROT
}
constexpr int ATTN_LDS_BYTES=LDS_BYTES;
#undef SBAR
#undef WAIT_BAR
}

template <bool WINDOW>
__device__ __forceinline__ void phase_attn(const Params& P, int layer, char* lds) {
    unsigned char* const ws = ows(P);
    const attn_body::bf16* Q = (const attn_body::bf16*)(ws + WS_Q); const attn_body::bf16* Kb = (const attn_body::bf16*)(ws + WS_K); const attn_body::bf16* Vb = (const attn_body::bf16*)(ws + WS_V);
    attn_body::bf16* O = (attn_body::bf16*)(ws + WS_O);
    const float* sinkp = P.attn_sink + (layer >> 1) * NQH;
    float mfix = 0.f; bool fix = false;
    if (!WINDOW) { const int lane = otid() & 63; float gq = fabsf(P.q_norm_g[(layer >> 1) * 64 + lane]), gk = fabsf(P.k_norm_g[(layer >> 1) * 64 + lane]);
#pragma unroll
        for (int o = 1; o < 64; o <<= 1) { gq = fmaxf(gq, __shfl_xor(gq, o)); gk = fmaxf(gk, __shfl_xor(gk, o)); }
        mfix = __builtin_amdgcn_readfirstlane(8.f * LOG2E * 1.01f * gq * gk + 0.05f); fix = mfix < 40.f; }
    for (int v = blockIdx.x; v < 256; v += gridDim.x) {
        const int xcd = v & 7, cu = v >> 3; const int b = xcd >> 2, kvh = xcd & 3;
        for (int i = 0; i < 9; ++i) {
            attn_body::AttnUnit u; u.kvrow0 = b * RB; u.lo = 0; u.t0 = 0; u.kt0 = (b * 4 + kvh) * 260;
            if (i < 8) { const int n = i * 32 + cu; u.h = kvh * 4 + (n >> 6); const int qb = n & 63; u.t0 = qb * 256; u.qrow0 = b * RB + CTXL + u.t0;
                if (WINDOW) { int lo = u.t0 - 128; if (lo < 0) lo = 0; int hi = u.t0 + 384; if (hi > SEQ) hi = SEQ; u.lo = lo; u.nt = 4 + (hi - lo) / 64; } else u.nt = RB / 64; }
            else { if (cu >= 4 || layer == DEPTH - 1) break; u.h = kvh * 4 + cu; u.qrow0 = b * RB; u.nt = 4; }
            const float sk = WINDOW ? sinkp[u.h] * LOG2E : 0.f;
            if (WINDOW) attn_body::attn_unit<8, true, false>(u, Q, Kb, Vb, O, lds, sk, 0.f);
            else if (fix) attn_body::attn_unit<8, false, true>(u, Q, Kb, Vb, O, lds, 0.f, mfix);
            else attn_body::attn_unit<8, false, false>(u, Q, Kb, Vb, O, lds, 0.f, 0.f);
        }
    }
}

__device__ __forceinline__ int block_excl_scan(int v, LAS int* sm, int& total) {
    const int tid = otid(), lane = tid & 63, wave = tid >> 6;
    int inc = v;
#pragma unroll
    for (int o = 1; o < 64; o <<= 1) { const int t = __shfl_up(inc, o); if (lane >= o) inc += t; }
    __syncthreads();
    if (lane == 63) sm[wave] = inc;
    __syncthreads();
    int base = 0, tot = 0;
#pragma unroll
    for (int w = 0; w < 8; ++w) { const int s = sm[w]; if (w < wave) base += s; tot += s; }
    total = tot;
    return base + inc - v;
}
__device__ __forceinline__ void phase_select(const Params& P, LAS unsigned char* lds, bool last) {
    unsigned char* const ws = ows(P);
    const int tid = otid();
    LAS int* hist = (LAS int*)lds;
    LAS int* tot = hist + 32 * 257;
    LAS int* sm = tot + 256;
    LAS unsigned* bc = (LAS unsigned*)(sm + 16);
    const float* AFFL = (const float*)(ws + WS_AFF); const float* AFFC = AFFL + (size_t)NB * NE * SEQ;
    int* SELI = (int*)(ws + WS_SELI); float* SELG = (float*)(ws + WS_SELG); int* INVT = (int*)(ws + WS_INVT);
    for (int pid = blockIdx.x; pid < (last ? 32 : 64); pid += gridDim.x) {
        const bool isctx = pid >= 32; const int be = pid & 31, b = be >> 4, e = be & 15;
        const int n = isctx ? CTXL : SEQ, kcap = isctx ? CAP_C : CAP_L;
        const float* aff = isctx ? AFFC + (size_t)be * CTXL : AFFL + (size_t)be * SEQ;
        const int cnt = isctx ? (tid < CTXL ? 1 : 0) : 32; const int i0 = isctx ? tid : tid * 32;
        unsigned key[32];
        if (isctx) { key[0] = cnt ? __builtin_bit_cast(unsigned, aff[i0]) : 0u;
#pragma unroll
            for (int i = 1; i < 32; ++i) key[i] = 0u; }
        else {
#pragma unroll
            for (int i = 0; i < 32; i += 4) { const u32x4 t = *(const u32x4*)(aff + i0 + i); key[i] = t.x; key[i + 1] = t.y; key[i + 2] = t.z; key[i + 3] = t.w; } }
        unsigned prefix = 0u, mask = 0u; int krem = kcap;
        for (int pass = 0; pass < 4; ++pass) {
            const int shift = 24 - 8 * pass;
            __syncthreads();
            for (int i = tid; i < 32 * 257; i += NT) hist[i] = 0;
            __syncthreads();
            LAS int* myh = hist + (tid & 31) * 257;
#pragma unroll
            for (int i = 0; i < 32; ++i) if (i < cnt && (key[i] & mask) == prefix) __hip_atomic_fetch_add(&myh[(key[i] >> shift) & 255u], 1, __ATOMIC_RELAXED, __HIP_MEMORY_SCOPE_WORKGROUP);
            __syncthreads();
            if (tid < 256) { int s = 0;
#pragma unroll 8
                for (int c = 0; c < 32; ++c) s += hist[c * 257 + tid];
                tot[tid] = s; }
            __syncthreads();
            if (tid < 64) {
                int c[4]; int s = 0;
#pragma unroll
                for (int j = 0; j < 4; ++j) { c[j] = tot[255 - (4 * tid + j)]; s += c[j]; }
                int inc = s;
#pragma unroll
                for (int o = 1; o < 64; o <<= 1) { const int t = __shfl_up(inc, o); if (tid >= o) inc += t; }
                int above = inc - s;
                if (above < krem && inc >= krem) { int d = 255 - 4 * tid;
#pragma unroll
                    for (int j = 0; j < 3; ++j) if (above + c[j] < krem) { above += c[j]; --d; } else break;
                    bc[0] = prefix | ((unsigned)d << shift); bc[1] = (unsigned)(krem - above); }
            }
            __syncthreads();
            prefix = bc[0]; krem = (int)bc[1]; mask |= 255u << shift;
        }
        const unsigned T = prefix;
        int ceq = 0;
#pragma unroll
        for (int i = 0; i < 32; ++i) if (i < cnt && key[i] == T) ++ceq;
        int tot; const int eqb = block_excl_scan(ceq, sm, tot);
        unsigned selm = 0u; int csel = 0, er = eqb;
#pragma unroll
        for (int i = 0; i < 32; ++i) if (i < cnt) { bool s = key[i] > T; if (key[i] == T) { s = er < krem; ++er; } if (s) { selm |= 1u << i; ++csel; } }
        int tots; int pos = block_excl_scan(csel, sm, tots);
        const int sbase = isctx ? NSLOT_L + e * 256 + b * CAP_C : (b * NE + e) * CAP_L;
        const int rbase = b * RB + (isctx ? 0 : CTXL);
        int invv[32];
#pragma unroll
        for (int i = 0; i < 32; ++i) { invv[i] = -1; if (i < cnt) { const int r = rbase + i0 + i;
            if ((selm >> i) & 1u) { const int inv = sbase + pos; invv[i] = inv; SELI[inv] = r; SELG[inv] = __builtin_bit_cast(float, key[i]); ++pos; } } }
        if (isctx) { if (cnt) INVT[(size_t)e * R + rbase + i0] = invv[0]; }
        else { typedef int i32x4 __attribute__((ext_vector_type(4))); i32x4* dst = (i32x4*)(INVT + (size_t)e * R + rbase + i0);
#pragma unroll
            for (int i = 0; i < 8; ++i) dst[i] = (i32x4){invv[4 * i], invv[4 * i + 1], invv[4 * i + 2], invv[4 * i + 3]}; }
        if (isctx && b == 0 && tid < 192) { SELI[NSLOT_L + e * 256 + 64 + tid] = 0; SELG[NSLOT_L + e * 256 + 64 + tid] = 0.f; }
    }
}


__device__ __forceinline__ float reduce16(float (&v)[16], int lane) {
#pragma unroll
    for (int i = 0; i < 8; ++i) { const bool up = lane & 1; const float keep = up ? v[i + 8] : v[i], send = up ? v[i] : v[i + 8]; v[i] = keep + __shfl_xor(send, 1); }
#pragma unroll
    for (int i = 0; i < 4; ++i) { const bool up = lane & 2; const float keep = up ? v[i + 4] : v[i], send = up ? v[i] : v[i + 4]; v[i] = keep + __shfl_xor(send, 2); }
#pragma unroll
    for (int i = 0; i < 2; ++i) { const bool up = lane & 4; const float keep = up ? v[i + 2] : v[i], send = up ? v[i] : v[i + 2]; v[i] = keep + __shfl_xor(send, 4); }
    { const bool up = lane & 8; const float keep = up ? v[1] : v[0], send = up ? v[0] : v[1]; v[0] = keep + __shfl_xor(send, 8); }
    v[0] += __shfl_xor(v[0], 16); v[0] += __shfl_xor(v[0], 32);
    return v[0];
}
__device__ __forceinline__ float softmax16(float s) {
    float mx = s;
#pragma unroll
    for (int o = 1; o < 16; o <<= 1) mx = fmaxf(mx, __shfl_xor(mx, o));
    const float ex = expf(s - mx); float den = ex;
#pragma unroll
    for (int o = 1; o < 16; o <<= 1) den += __shfl_xor(den, o);
    return ex / den;
}
__device__ __forceinline__ void phase_norm2_router(const Params& P, int layer, LAS unsigned char* lds) {
    unsigned char* const ws = ows(P);
    const int tid = otid(), lane = tid & 63, wave = tid >> 6;
    const int gw = blockIdx.x * 8 + wave, NGW = gridDim.x * 8;
    LAS float* wT = (LAS float*)lds;
    { const f32x4* wr4 = (const f32x4*)(P.w_router + (size_t)layer * D * NE);
      for (int i = tid; i < D * NE / 4; i += NT) { const f32x4 w = wr4[i]; const int k = i >> 2, e0 = (i & 3) * 4; wT[(e0 + 0) * 1024 + k] = w.x; wT[(e0 + 1) * 1024 + k] = w.y; wT[(e0 + 2) * 1024 + k] = w.z; wT[(e0 + 3) * 1024 + k] = w.w; } }
    __syncthreads();
    bf16_t* XR = (bf16_t*)(ws + WS_XR); bf16_t* H = (bf16_t*)(ws + WS_H);
    const float* MOD = (const float*)(ws + WS_MOD) + (size_t)layer * 3 * 6144;
    const float* gain = P.norm_ffn_g + (size_t)layer * D;
    const float* OPART = (const float*)(ws + WS_XSEL);
    float* AFFL = (float*)(ws + WS_AFF); float* AFFC = AFFL + (size_t)NB * NE * SEQ;
    const int erev = ((lane & 1) << 3) | ((lane & 2) << 1) | ((lane & 4) >> 1) | ((lane & 8) >> 3);
    for (int pr = gw; pr < R / 2; pr += NGW) {
        const int r0 = 2 * pr; const int b = r0 / RB, j = r0 - b * RB; const int mv = j < CTXL ? 2 : b;
        if (layer == DEPTH - 1 && j < CTXL) continue;
        const float* sh = MOD + (size_t)mv * 6144 + 3072; const float* sc = sh + 1024;
        u32x2* xr = (u32x2*)(XR + (size_t)r0 * D) + lane;
        f32x4 v0[4], v1[4]; float ss0 = 0.f, ss1 = 0.f;
#pragma unroll
        for (int q = 0; q < 4; ++q) { const u32x2 a = xr[64 * q], b2 = xr[256 + 64 * q];
            v0[q] = (f32x4){__builtin_bit_cast(float, a.x << 16), __builtin_bit_cast(float, a.x & 0xffff0000u), __builtin_bit_cast(float, a.y << 16), __builtin_bit_cast(float, a.y & 0xffff0000u)};
            v1[q] = (f32x4){__builtin_bit_cast(float, b2.x << 16), __builtin_bit_cast(float, b2.x & 0xffff0000u), __builtin_bit_cast(float, b2.y << 16), __builtin_bit_cast(float, b2.y & 0xffff0000u)}; }
        if (j < CTXL) {
#pragma unroll
            for (int p = 0; p < 3; ++p) { const f32x4* pp = (const f32x4*)(OPART + ((size_t)p * 512 + (size_t)b * CTXL + j) * D) + lane;
#pragma unroll
                for (int q = 0; q < 4; ++q) { v0[q] += pp[64 * q]; v1[q] += pp[256 + 64 * q]; } }
#pragma unroll
            for (int q = 0; q < 4; ++q) { xr[64 * q] = (u32x2){pk2(v0[q].x, v0[q].y), pk2(v0[q].z, v0[q].w)}; xr[256 + 64 * q] = (u32x2){pk2(v1[q].x, v1[q].y), pk2(v1[q].z, v1[q].w)}; } }
#pragma unroll
        for (int q = 0; q < 4; ++q) { ss0 += (v0[q].x * v0[q].x + v0[q].y * v0[q].y) + (v0[q].z * v0[q].z + v0[q].w * v0[q].w); ss1 += (v1[q].x * v1[q].x + v1[q].y * v1[q].y) + (v1[q].z * v1[q].z + v1[q].w * v1[q].w); }
        const float rstd0 = 1.0f / sqrtf(wave_sum(ss0) * (1.f / D) + EPS), rstd1 = 1.0f / sqrtf(wave_sum(ss1) * (1.f / D) + EPS);
        unsigned long long* o8 = (unsigned long long*)(H + (size_t)r0 * D) + lane;
#pragma unroll
        for (int q = 0; q < 4; ++q) {
            const int c0 = 4 * lane + 256 * q;
            const f32x4 g4 = *(const f32x4*)(gain + c0), sc4 = *(const f32x4*)(sc + c0), sh4 = *(const f32x4*)(sh + c0);
            const f32x4 gm = g4 * (sc4 + 1.f);
            v0[q] = v0[q] * rstd0 * gm + sh4; v1[q] = v1[q] * rstd1 * gm + sh4;
            o8[64 * q] = (unsigned long long)pk2(v0[q].x, v0[q].y) | ((unsigned long long)pk2(v0[q].z, v0[q].w) << 32);
            o8[256 + 64 * q] = (unsigned long long)pk2(v1[q].x, v1[q].y) | ((unsigned long long)pk2(v1[q].z, v1[q].w) << 32);
        }
        float a0[16], a1[16];
#pragma unroll
        for (int e = 0; e < 16; ++e) {
            float s0 = 0.f, s1 = 0.f;
#pragma unroll
            for (int q = 0; q < 4; ++q) { const f32x4 w = *(const LAS f32x4*)(wT + e * 1024 + 4 * lane + 256 * q);
                s0 += (v0[q].x * w.x + v0[q].y * w.y) + (v0[q].z * w.z + v0[q].w * w.w); s1 += (v1[q].x * w.x + v1[q].y * w.y) + (v1[q].z * w.z + v1[q].w * w.w); }
            a0[e] = s0; a1[e] = s1;
            if (e & 1) asm volatile("" ::: "memory");
        }
        const float p0 = softmax16(reduce16(a0, lane)), p1 = softmax16(reduce16(a1, lane));
        if (lane < 16) { typedef float f32x2 __attribute__((ext_vector_type(2)));
            float* dst = j < CTXL ? AFFC + ((size_t)b * NE + erev) * CTXL + j : AFFL + ((size_t)b * NE + erev) * SEQ + (j - CTXL);
            *(f32x2*)dst = (f32x2){p0, p1}; }
    }
}

template <bool LAST>
__device__ __forceinline__ void phase_combine_norm(const Params& P, int layer) {
    unsigned char* const ws = ows(P);
    const int tid = otid(), lane = tid & 63, wave = tid >> 6; const int gw = blockIdx.x * 8 + wave, NGW = gridDim.x * 8;
    bf16_t* XR = (bf16_t*)(ws + WS_XR); const bf16_t* Y = (const bf16_t*)(ws + WS_Y); const int* INVT = (const int*)(ws + WS_INVT); bf16_t* H = (bf16_t*)(ws + WS_H);
    const float* MOD = (const float*)(ws + WS_MOD) + (size_t)layer * 3 * 6144;
    const float* gain = LAST ? P.final_norm_g : P.norm_mix_g + (size_t)(layer + 1) * D;
    int sv = (gw < R && lane < 16) ? INVT[(size_t)lane * R + gw] : -1;
    for (int r = gw; r < R; r += NGW) {
        const int b = r / RB, j = r - b * RB; const int mv = j < CTXL ? 2 : b;
        const int svc = sv; sv = (r + NGW < R && lane < 16) ? INVT[(size_t)lane * R + r + NGW] : -1;
        if (LAST && j < CTXL) continue;
        u32x2* xr = (u32x2*)(XR + (size_t)r * D) + lane;
        f32x4 x[4], acc[4];
#pragma unroll
        for (int q = 0; q < 4; ++q) { const u32x2 a = xr[64 * q]; x[q] = (f32x4){__builtin_bit_cast(float, a.x << 16), __builtin_bit_cast(float, a.x & 0xffff0000u), __builtin_bit_cast(float, a.y << 16), __builtin_bit_cast(float, a.y & 0xffff0000u)}; acc[q] = (f32x4){0.f, 0.f, 0.f, 0.f}; }
#pragma unroll
        for (int e = 0; e < NE; ++e) { const int s = __builtin_amdgcn_readlane(svc, e);
            if (s >= 0) {
                if (!LAST && s >= NSLOT_L) {
#pragma unroll
                    for (int p = 0; p < 4; ++p) { const u32x2* y = (const u32x2*)(Y + (size_t)(pg8::YP_ROW0 + 4096 * p + (s - NSLOT_L)) * D) + lane;
#pragma unroll
                        for (int q = 0; q < 4; ++q) { const u32x2 w = y[64 * q]; acc[q] += (f32x4){__builtin_bit_cast(float, w.x << 16), __builtin_bit_cast(float, w.x & 0xffff0000u), __builtin_bit_cast(float, w.y << 16), __builtin_bit_cast(float, w.y & 0xffff0000u)}; } } }
                else { const u32x2* y = (const u32x2*)(Y + (size_t)s * D) + lane;
#pragma unroll
                    for (int q = 0; q < 4; ++q) { const u32x2 w = y[64 * q]; acc[q] += (f32x4){__builtin_bit_cast(float, w.x << 16), __builtin_bit_cast(float, w.x & 0xffff0000u), __builtin_bit_cast(float, w.y << 16), __builtin_bit_cast(float, w.y & 0xffff0000u)}; } } } }
        const float* g2 = MOD + (size_t)mv * 6144 + 5120;
        float ss = 0.f;
#pragma unroll
        for (int q = 0; q < 4; ++q) { const f32x4 g4 = *(const f32x4*)(g2 + 4 * lane + 256 * q); x[q] = x[q] + g4 * acc[q]; if (!LAST) xr[64 * q] = (u32x2){pk2(x[q].x, x[q].y), pk2(x[q].z, x[q].w)};
            ss += (x[q].x * x[q].x + x[q].y * x[q].y) + (x[q].z * x[q].z + x[q].w * x[q].w); }
        const float rstd = 1.0f / sqrtf(wave_sum(ss) * (1.f / D) + EPS);
        if (LAST) { f32x4* o = (f32x4*)(P.out + ((size_t)b * SEQ + (j - CTXL)) * D) + lane;
#pragma unroll
            for (int q = 0; q < 4; ++q) { const f32x4 g4 = *(const f32x4*)(gain + 4 * lane + 256 * q); o[64 * q] = x[q] * rstd * g4; } }
        else { const float* sh = MOD + 3 * 6144 + (size_t)mv * 6144; const float* sc = sh + 1024;
            unsigned long long* o8 = (unsigned long long*)(H + (size_t)r * D) + lane;
#pragma unroll
            for (int q = 0; q < 4; ++q) { const int c0 = 4 * lane + 256 * q; const f32x4 g4 = *(const f32x4*)(gain + c0), sc4 = *(const f32x4*)(sc + c0), sh4 = *(const f32x4*)(sh + c0);
                const f32x4 h = x[q] * rstd * g4 * (sc4 + 1.f) + sh4;
                o8[64 * q] = (unsigned long long)pk2(h.x, h.y) | ((unsigned long long)pk2(h.z, h.w) << 32); } }
    }
}

#define XB_TMO      128
#define XB_XCNT(j)  (256  + 64 * (j))
#define XB_XSUB(j)  (1280 + 64 * (j))
#define XB_XGEN(j)  (2304 + 64 * (j))
#define XB_TOP      3328
#define XB_TOPGEN   3392
#define XCD_BAR_WORDS 3456
#define XB_SPIN_CAP (1u << 18)

__device__ __forceinline__ unsigned xb_ld(unsigned* p)              { return __hip_atomic_load(p, __ATOMIC_RELAXED, __HIP_MEMORY_SCOPE_AGENT); }
__device__ __forceinline__ unsigned xb_add(unsigned* p, unsigned v) { return __hip_atomic_fetch_add(p, v, __ATOMIC_RELAXED, __HIP_MEMORY_SCOPE_AGENT); }
__device__ __forceinline__ unsigned xb_xcc_id() { return (unsigned)__builtin_amdgcn_s_getreg((3 << 11) | 20) & 0xFu; }
#define XB_SPIN(cond, bar) do { unsigned _sp = 0; while (cond) { __builtin_amdgcn_s_sleep(1); \
    if ((++_sp & 255u) == 0u) { if (xb_ld(&(bar)[XB_TMO])) break; if (_sp > XB_SPIN_CAP) { atomicAdd(&(bar)[XB_TMO], 1u); break; } } } } while (0)

struct XcdBarrier {
    unsigned* bar; unsigned x;
    volatile LAS unsigned* st;
};

__device__ __forceinline__ XcdBarrier xcd_barrier_post(unsigned* bar, volatile LAS unsigned* st) {
    XcdBarrier b; b.bar = bar; b.x = xb_xcc_id(); b.st = st;
    if (threadIdx.x == 0) (void)xb_add(&bar[XB_XCNT(b.x)], 1u);
    return b;
}
__device__ __forceinline__ void xcd_barrier_complete(unsigned* bar, unsigned x, unsigned& nloc, unsigned& nx) {
    const unsigned G = gridDim.x * gridDim.y * gridDim.z;
    unsigned sum, cnt, mine, sp = 0u;
    for (;;) {
        sum = 0u; cnt = 0u; mine = 0u;
#pragma unroll
        for (unsigned j = 0; j < 16; ++j) { const unsigned c = xb_ld(&bar[XB_XCNT(j)]); sum += c; cnt += (c > 0u) ? 1u : 0u; mine = (j == x) ? c : mine; }
        if (sum == G) break;
        __builtin_amdgcn_s_sleep(1);
        if ((++sp & 255u) == 0u) { if (xb_ld(&bar[XB_TMO])) break; if (sp > XB_SPIN_CAP) { atomicAdd(&bar[XB_TMO], 1u); break; } }
    }
    nloc = mine > 0u ? mine : 1u; nx = cnt > 0u ? cnt : 1u;
}

__device__ __forceinline__ void xcd_barrier(const XcdBarrier& b) {
    asm volatile("s_waitcnt vmcnt(0)" ::: "memory");
    __syncthreads();
    if (threadIdx.x == 0) {
        unsigned* bar = b.bar; unsigned bx_ = b.x;
        asm volatile("" : "+s"(bar), "+s"(bx_));
        __builtin_amdgcn_s_waitcnt(0);
        unsigned nloc = b.st[0], nx = b.st[1];
        if (nloc == 0u) { xcd_barrier_complete(bar, bx_, nloc, nx); b.st[0] = nloc; b.st[1] = nx; }
        const unsigned old = xb_add(&bar[XB_XSUB(bx_)], 1u);
        const unsigned gen = old / nloc;
        if (old + 1u == (gen + 1u) * nloc) {
            __builtin_amdgcn_fence(__ATOMIC_RELEASE, "agent");
            asm volatile("s_waitcnt vmcnt(0)" ::: "memory");
            const unsigned og = xb_add(&bar[XB_TOP], 1u);
            const unsigned tg = og / nx;
            if (og + 1u == (tg + 1u) * nx) xb_add(&bar[XB_TOPGEN], 1u);
            else XB_SPIN(xb_ld(&bar[XB_TOPGEN]) == tg, bar);
            __builtin_amdgcn_fence(__ATOMIC_ACQUIRE, "agent");
            xb_add(&bar[XB_XGEN(bx_)], 1u);
            asm volatile("s_waitcnt vmcnt(0)" ::: "memory");
        } else {
            XB_SPIN(xb_ld(&bar[XB_XGEN(bx_)]) == gen, bar);
            __builtin_amdgcn_fence(__ATOMIC_ACQUIRE, "agent");
            asm volatile("s_waitcnt vmcnt(0)" ::: "memory");
        }
    }
    __syncthreads();
}


constexpr int LDS_RING = 131072;
constexpr int LDS_CTL_OFF = LDS_RING;
constexpr int LDS_BYTES = LDS_RING + 16384;
constexpr int CW_BAR = 4096;
constexpr size_t CTL_ZERO_BYTES = 64 * 1024;

template <int l>
__device__ __forceinline__ void layer_phases(const Params& P, LAS unsigned char* lds, char* lds_raw, const XcdBarrier& bar) {
    constexpr bool last = l == DEPTH - 1;
    phase_qkv(P, l, lds);
    xcd_barrier(bar);
    if (l & 1) phase_attn<true>(P, l, lds_raw); else phase_attn<false>(P, l, lds_raw);
    xcd_barrier(bar);
    phase_oproj(P, l, lds);
    xcd_barrier(bar);
    phase_norm2_router(P, l, lds);
    xcd_barrier(bar);
    phase_select(P, lds, last);
    xcd_barrier(bar);
    phase_gateup(P, l, lds);
    xcd_barrier(bar);
    phase_down(P, l, lds);
    xcd_barrier(bar);
    phase_combine_norm<last>(P, l);
    if (!last) xcd_barrier(bar);
}

__global__ void __launch_bounds__(512, 2) fwd_kernel(Params P) {
    extern __shared__ __attribute__((aligned(16))) unsigned char lds_raw[];
    LAS unsigned char* lds = (LAS unsigned char*)lds_raw;
    volatile LAS unsigned* xbw = (volatile LAS unsigned*)(lds + LDS_CTL_OFF);
    if (threadIdx.x < 4) xbw[threadIdx.x] = 0u;
    __syncthreads();
    XcdBarrier bar = xcd_barrier_post((unsigned*)(P.ws + WS_CTL) + CW_BAR, xbw);

    phase_weights(P, lds);
    __syncthreads();
    phase_mod(P, lds);
    phase_rope_init(P);
    xcd_barrier(bar);
    phase_norm1_l0(P);
    xcd_barrier(bar);
    layer_phases<0>(P, lds, (char*)lds_raw, bar);
    layer_phases<1>(P, lds, (char*)lds_raw, bar);
    layer_phases<2>(P, lds, (char*)lds_raw, bar);
    layer_phases<3>(P, lds, (char*)lds_raw, bar);
}

extern "C" void kernel_launch(void* const* d_in, const int* in_sizes, int n_in, void* d_out, int out_size, void* d_ws, size_t ws_size, hipStream_t stream) {
    static int grid = 0;
    if (grid == 0) {
        if (n_in != 18 || ws_size < WS_END || out_size != NB * SEQ * D) { fprintf(stderr, "kernel_launch: unexpected problem: n_in %d ws %zu (need %zu) out %d; nothing launched\n", n_in, ws_size, (size_t)WS_END, out_size); grid = -1; return; }
        int dev = 0, cus = 0, per_cu = 0;
        if (hipGetDevice(&dev) != hipSuccess || hipDeviceGetAttribute(&cus, hipDeviceAttributeMultiprocessorCount, dev) != hipSuccess) { fprintf(stderr, "kernel_launch: device query failed\n"); grid = -1; return; }
        if (hipFuncSetAttribute((const void*)fwd_kernel, hipFuncAttributeMaxDynamicSharedMemorySize, LDS_BYTES) != hipSuccess) { fprintf(stderr, "kernel_launch: hipFuncSetAttribute failed\n"); grid = -1; return; }
        if (hipOccupancyMaxActiveBlocksPerMultiprocessor(&per_cu, (const void*)fwd_kernel, 512, LDS_BYTES) != hipSuccess || per_cu < 1) { fprintf(stderr, "kernel_launch: occupancy query reports %d workgroups per CU\n", per_cu); }
        (void)hipGetLastError();
        grid = cus;
    }
    if (grid < 0) return;
    Params P{};
    P.x = (const float*)d_in[0]; P.c = (const float*)d_in[1]; P.ctx = (const float*)d_in[2]; P.c_ctx = (const float*)d_in[3]; P.w_mod = (const float*)d_in[4]; P.b_mod = (const float*)d_in[5];
    P.norm_mix_g = (const float*)d_in[6]; P.norm_ffn_g = (const float*)d_in[7]; P.w_qkv = (const float*)d_in[8]; P.w_o = (const float*)d_in[9]; P.q_norm_g = (const float*)d_in[10]; P.k_norm_g = (const float*)d_in[11];
    P.attn_sink = (const float*)d_in[12]; P.w_router = (const float*)d_in[13]; P.w_gate = (const float*)d_in[14]; P.w_up = (const float*)d_in[15]; P.w_down = (const float*)d_in[16]; P.final_norm_g = (const float*)d_in[17];
    P.out = (float*)d_out; P.ws = (unsigned char*)d_ws;
    if (hipMemsetAsync((char*)d_ws + WS_CTL, 0, CTL_ZERO_BYTES, stream) != hipSuccess) { fprintf(stderr, "kernel_launch: memset failed\n"); return; }
    hipLaunchKernelGGL(fwd_kernel, dim3(grid), dim3(512), LDS_BYTES, stream, P);
    const hipError_t le = hipPeekAtLastError();
    if (le != hipSuccess) fprintf(stderr, "kernel_launch: launch failed: %s (grid %d)\n", hipGetErrorName(le), grid);
}
```

```cpp
#include <hip/hip_runtime.h>
#include <hip/hip_bf16.h>
#include <cmath>
#include <cstdio>
#include <cstdint>

#define LAS __attribute__((address_space(3)))
typedef unsigned short bf16_t;
typedef float f32x4 __attribute__((ext_vector_type(4)));
typedef unsigned u32x4 __attribute__((ext_vector_type(4)));
typedef unsigned u32x2 __attribute__((ext_vector_type(2)));

namespace cfg {
constexpr int D = 1024, NB = 2, SEQ = 16384, DEPTH = 4, CTXL = 256, HD = 64, NQH = 16, NKVH = 4, QKVW = 1536;
constexpr int NE = 16, DE = 2048, CAP_L = 2048, CAP_C = 32;
constexpr int RB = CTXL + SEQ;
constexpr int R = NB * RB;
constexpr int NSLOT_L = NB * NE * CAP_L;
constexpr int NSLOT = NSLOT_L + NE * 256;
constexpr float EPS = 1e-6f;
constexpr float C2 = 0.125f * 1.4426950408889634f;
constexpr float LOG2E = 1.4426950408889634f;
constexpr int NT = 512;
}
using namespace cfg;

constexpr size_t MiB = 1u << 20;
constexpr size_t WS_CTL   = 0;
constexpr size_t WS_MOD   = 1 * MiB;
constexpr size_t WS_ROPE  = WS_MOD + 512 * 1024;
constexpr size_t WS_WQKV  = 2 * MiB;
constexpr size_t WS_WO    = WS_WQKV + 12 * MiB;
constexpr size_t WS_WGU   = WS_WO + 8 * MiB;
constexpr size_t WS_WD    = WS_WGU + 512 * MiB;
constexpr size_t WS_XR    = WS_WD + 256 * MiB;
constexpr size_t WS_H     = WS_XR + 130 * MiB;
constexpr size_t WS_Q     = WS_H + 65 * MiB;
constexpr size_t WS_K     = WS_Q + 65 * MiB;
constexpr size_t WS_V     = WS_K + 17 * MiB;
constexpr size_t WS_O     = WS_V + 17 * MiB;
constexpr size_t WS_AFF   = WS_O + 65 * MiB;
constexpr size_t WS_SELI  = WS_AFF + 3 * MiB;
constexpr size_t WS_SELG  = WS_SELI + 512 * 1024;
constexpr size_t WS_INVT  = WS_SELG + 512 * 1024;
constexpr size_t WS_XSEL  = WS_INVT + 3 * MiB;
constexpr size_t WS_ACT   = WS_XSEL + 136 * MiB;
constexpr size_t WS_Y     = WS_ACT + 272 * MiB;
constexpr size_t WS_END   = WS_Y + 272 * MiB;

struct Params {
    const float *x, *c, *ctx, *c_ctx, *w_mod, *b_mod, *norm_mix_g, *norm_ffn_g, *w_qkv, *w_o, *q_norm_g, *k_norm_g, *attn_sink, *w_router, *w_gate, *w_up, *w_down, *final_norm_g;
    float* out; unsigned char* ws;
};

__device__ __forceinline__ unsigned f2bf(float f) { unsigned u = __builtin_bit_cast(unsigned, f); return (u + 0x7fffu + ((u >> 16) & 1u)) >> 16; }
__device__ __forceinline__ unsigned pk2(float lo, float hi) { return f2bf(lo) | (f2bf(hi) << 16); }
__device__ __forceinline__ float bf2f(unsigned short h) { return __builtin_bit_cast(float, (unsigned)h << 16); }
__device__ __forceinline__ float wave_sum(float v) {
#pragma unroll
    for (int o = 1; o < 64; o <<= 1) v += __shfl_xor(v, o);
    return v;
}
__device__ __forceinline__ int otid() { int t = threadIdx.x; asm volatile("" : "+v"(t)); return t; }
__device__ __forceinline__ unsigned char* ows(const Params& P) {
    __attribute__((address_space(1))) unsigned char* g = (__attribute__((address_space(1))) unsigned char*)P.ws; asm volatile("" : "+s"(g)); return (unsigned char*)g; }
__device__ __forceinline__ float silu_f(float v) { return v / (1.f + expf(-v)); }
__device__ __forceinline__ int mod_vec_of_row(int r) { const int b = r / RB, j = r - b * RB; return j < CTXL ? 2 : b; }

__device__ __forceinline__ size_t wtile_off(int n, int k, int K) {
    const int r = n & 127, c = k & 63; const int st = (r >> 4) * 2 + (c >> 5), ob = (r & 15) * 64 + (c & 31) * 2;
    return ((size_t)(n >> 7) * (K >> 6) + (k >> 6)) * 8192 + (size_t)((st * 1024 + (ob ^ (((ob >> 9) & 1) << 5))) >> 1);
}
template <bool KPERM = false, class RowMap>
__device__ __forceinline__ void transpose_item(const float* W, int K, int N, bf16_t* WT, const RowMap& rowmap, int item, int lane, float scale = 1.f) {
    const int nblk = N / 64, kb = item / nblk, nb = item % nblk, k0 = 64 * kb, n = 64 * nb + lane;
    const float* src = W + (size_t)k0 * N + n; const int row = rowmap(n);
#pragma unroll
    for (int half = 0; half < 2; ++half) {
        float v[32];
#pragma unroll
        for (int j = 0; j < 32; ++j) v[j] = src[(size_t)(32 * half + j) * N] * scale;
#pragma unroll
        for (int kc = 0; kc < 4; ++kc) { const int ka = k0 + 32 * half + 8 * kc;
            u32x4 o; o.x = pk2(v[8 * kc], v[8 * kc + 1]); o.y = pk2(v[8 * kc + 2], v[8 * kc + 3]); o.z = pk2(v[8 * kc + 4], v[8 * kc + 5]); o.w = pk2(v[8 * kc + 6], v[8 * kc + 7]);
            if (KPERM) { const int kb_ = ka + 4;
                const int pa = (ka & ~31) + 8 * ((ka >> 2) & 3) + 4 * ((ka >> 4) & 1), pb = (kb_ & ~31) + 8 * ((kb_ >> 2) & 3) + 4 * ((kb_ >> 4) & 1);
                *(u32x2*)(WT + wtile_off(row, pa, K)) = (u32x2){o.x, o.y}; *(u32x2*)(WT + wtile_off(row, pb, K)) = (u32x2){o.z, o.w}; }
            else *(u32x4*)(WT + wtile_off(row, ka, K)) = o; }
    }
}

__device__ __forceinline__ void phase_weights(const Params& P, LAS unsigned char* lds) {
    unsigned char* const ws = ows(P);
    const int tid = otid(), lane = tid & 63, wave = tid >> 6;
    const int gw = blockIdx.x * 8 + wave, NGW = gridDim.x * 8;
    constexpr int I_QKV = 16 * 24, I_O = 16 * 16, I_G = 16 * 32, I_D = 32 * 16;
    constexpr int PER_LAYER = I_QKV + I_O + NE * (2 * I_G + I_D);
    for (int it = gw; it < DEPTH * PER_LAYER; it += NGW) {
        const int l = it / PER_LAYER; int r = it % PER_LAYER;
        if (r < I_QKV) { bf16_t* dst = (bf16_t*)(ws + WS_WQKV) + (size_t)l * QKVW * D;
            transpose_item(P.w_qkv + (size_t)l * D * QKVW, D, QKVW, dst, [](int n) { const int hh = n >> 6; return 256 * (hh >> 2) + 128 * ((n >> 5) & 1) + 32 * (hh & 3) + (n & 31); }, r, lane); continue; }
        r -= I_QKV;
        if (r < I_O) { bf16_t* dst = (bf16_t*)(ws + WS_WO) + (size_t)l * D * D;
            transpose_item<true>(P.w_o + (size_t)l * D * D, D, D, dst, [](int n) { const int c = n & 31; return (n & ~31) + 16 * ((c >> 2) & 1) + 4 * (c >> 3) + (c & 3); }, r, lane); continue; }
        r -= I_O;
        const int e = r / (2 * I_G + I_D); r = r % (2 * I_G + I_D);
        const size_t le = (size_t)l * NE + e;
        if (r < I_G) { bf16_t* dst = (bf16_t*)(ws + WS_WGU) + le * (size_t)(2 * DE) * D;
            transpose_item(P.w_gate + le * (size_t)D * DE, D, DE, dst, [](int f) { return 256 * (f >> 7) + 128 * ((f >> 2) & 1) + 32 * ((f >> 5) & 3) + 4 * ((f >> 3) & 3) + (f & 3); }, r, lane, -1.4426950408889634f); continue; }
        r -= I_G;
        if (r < I_G) { bf16_t* dst = (bf16_t*)(ws + WS_WGU) + le * (size_t)(2 * DE) * D;
            transpose_item(P.w_up + le * (size_t)D * DE, D, DE, dst, [](int f) { return 256 * (f >> 7) + 128 * ((f >> 2) & 1) + 32 * ((f >> 5) & 3) + 16 + 4 * ((f >> 3) & 3) + (f & 3); }, r, lane, -0.6931471805599453f); continue; }
        r -= I_G;
        { bf16_t* dst = (bf16_t*)(ws + WS_WD) + le * (size_t)D * DE;
            transpose_item(P.w_down + le * (size_t)DE * D, DE, D, dst, [](int n) { const int c = n & 31; return (n & ~31) + 16 * ((c >> 2) & 1) + 4 * (c >> 3) + (c & 3); }, r, lane); }
    }
}

__device__ __forceinline__ void phase_mod(const Params& P, LAS unsigned char* lds) {
    unsigned char* const ws = ows(P);
    const int tid = otid(), lane = tid & 63, wave = tid >> 6;
    LAS float* sc = (LAS float*)lds;
    LAS float* red = sc + 3 * 1024;
    for (int i = tid; i < 3 * D; i += NT) { const int v = i / D, k = i % D; const float cv = v < 2 ? P.c[v * D + k] : P.c_ctx[k]; sc[i] = silu_f(cv); }
    __syncthreads();
    float* MOD = (float*)(ws + WS_MOD);
    for (int it = blockIdx.x; it < DEPTH * 96; it += gridDim.x) {
        const int l = it / 96, col = (it % 96) * 64 + lane;
        const float* W = P.w_mod + (size_t)l * D * 6144 + col;
        float a0 = 0.f, a1 = 0.f, a2 = 0.f;
#pragma unroll 4
        for (int k = wave; k < D; k += 8) { const float w = W[(size_t)k * 6144]; a0 += sc[k] * w; a1 += sc[D + k] * w; a2 += sc[2 * D + k] * w; }
        red[(wave * 3 + 0) * 64 + lane] = a0; red[(wave * 3 + 1) * 64 + lane] = a1; red[(wave * 3 + 2) * 64 + lane] = a2;
        __syncthreads();
        if (wave < 3) { float s = 0.f;
#pragma unroll
            for (int w = 0; w < 8; ++w) s += red[(w * 3 + wave) * 64 + lane];
            MOD[((size_t)l * 3 + wave) * 6144 + col] = s + P.b_mod[(size_t)l * 6144 + col]; }
        __syncthreads();
    }
}

__device__ __forceinline__ void phase_rope_init(const Params& P) {
    unsigned char* const ws = ows(P);
    float* T = (float*)(ws + WS_ROPE);
    for (int i = blockIdx.x * NT + otid(); i < 256 * 16; i += gridDim.x * NT) {
        const int p = i >> 4, f = i & 15;
        const float inv = (float)(1.0 / pow(10000.0, (double)f / 16.0));
        const float ang = (float)p * inv;
        T[2 * i] = (float)cos((double)ang); T[2 * i + 1] = (float)sin((double)ang);
    }
}


__device__ __forceinline__ void phase_norm1_l0(const Params& P) {
    unsigned char* const ws = ows(P);
    const int tid = otid(), lane = tid & 63, wave = tid >> 6;
    const int gw = blockIdx.x * 8 + wave, NGW = gridDim.x * 8;
    bf16_t* H = (bf16_t*)(ws + WS_H); const float* MOD = (const float*)(ws + WS_MOD); const float* gain = P.norm_mix_g;
    for (int r = gw; r < R; r += NGW) {
        const int b = r / RB, j = r - b * RB; const int mv = j < CTXL ? 2 : b;
        const float* sh = MOD + (size_t)mv * 6144; const float* sc = sh + 1024;
        const f32x4* xr = (const f32x4*)(j < CTXL ? P.ctx + ((size_t)b * CTXL + j) * D : P.x + ((size_t)b * SEQ + (j - CTXL)) * D) + lane;
        f32x4 v[4]; float ss = 0.f;
#pragma unroll
        for (int q = 0; q < 4; ++q) { v[q] = xr[64 * q]; ss += (v[q].x * v[q].x + v[q].y * v[q].y) + (v[q].z * v[q].z + v[q].w * v[q].w); }
        const float rstd = 1.0f / sqrtf(wave_sum(ss) * (1.f / D) + EPS);
        unsigned long long* o8 = (unsigned long long*)(H + (size_t)r * D) + lane;
#pragma unroll
        for (int q = 0; q < 4; ++q) { const int c0 = 4 * lane + 256 * q;
            const f32x4 g4 = *(const f32x4*)(gain + c0), sc4 = *(const f32x4*)(sc + c0), sh4 = *(const f32x4*)(sh + c0);
            const f32x4 h = v[q] * rstd * g4 * (sc4 + 1.f) + sh4;
            o8[64 * q] = (unsigned long long)pk2(h.x, h.y) | ((unsigned long long)pk2(h.z, h.w) << 32); }
    }
}


namespace pg8 {
#define PG8_LAS __attribute__((address_space(3)))
typedef unsigned short bf16_t;
typedef short bf16x8 __attribute__((ext_vector_type(8)));
typedef float f32x4 __attribute__((ext_vector_type(4)));
typedef unsigned u32x4 __attribute__((ext_vector_type(4)));
constexpr int BM = 256, BK = 64, HALF = 128, HTB = HALF * BK * 2  , STAGE_BYTES = 8 * HTB, NXCD = 8, WGM = 8;

__host__ __device__ __forceinline__ int lds_byte(int r, int c) { const int st = (r >> 4) * 2 + (c >> 5), rr = r & 15, cc = c & 31, ob = rr * 64 + cc * 2; return st * 1024 + (ob ^ (((ob >> 9) & 1) << 5)); }
__host__ __device__ __forceinline__ void stage_rc(int b, int& R, int& C) { const int st = b / 1024, sb = b % 1024, swz = sb ^ (((sb >> 9) & 1) << 5); R = (st >> 1) * 16 + swz / 64; C = (st & 1) * 32 + (swz % 64) / 2; }
__host__ __device__ __forceinline__ int perm32(int rho) { const int n = rho >> 4, i = rho & 15; return 8 * (i >> 2) + 4 * n + (i & 3); }

struct Unit { int pm, pn; int par = 0; int kt0 = 0, nkt = 0, kq = -1; };
struct Gemm { const bf16_t* A; const bf16_t* Bt; int M, N, K; const int* gidx; };


__device__ __forceinline__ unsigned cvt_pk_bf16(float lo, float hi) { unsigned r; asm volatile("v_cvt_pk_bf16_f32 %0, %1, %2" : "=v"(r) : "v"(lo), "v"(hi)); return r; }
typedef unsigned u32x2 __attribute__((ext_vector_type(2)));

struct EpiQKV {
    static constexpr bool PERM = false, AFTER_DRAIN = false, PRE = false;
    unsigned char* ws; const float* rope; const float* qg; const float* kg; int do_norm; const PG8_LAS float* ropel;
    __device__ __forceinline__ void operator()(const f32x4 (&acc)[2][2][4][2], const Unit& u, int wr_, int wc_, int fr_, int fq_) const {
        int wr = wr_, wc = wc_, fr = fr_, fq = fq_; asm volatile("" : "+s"(wr), "+s"(wc), "+v"(fr), "+v"(fq));
        const int type = u.pn < 4 ? 0 : (u.pn == 4 ? 1 : 2);
        const int pb = u.pm / 65, pj = u.pm - pb * 65;
        const bool lat = pj != 0, nrm = do_norm && type < 2;
        const size_t dbyte = type == 0 ? ::WS_Q + (size_t)(u.pn * 4 + wc) * 128 : (type == 1 ? ::WS_K : ::WS_V) + (size_t)wc * 128;
        bf16_t* dst = (bf16_t*)(ws + dbyte);
        const int ldd = type == 0 ? 1024 : 256;
        f32x4 gv[2][2];
#pragma unroll
        for (int bj = 0; bj < 2; ++bj)
#pragma unroll
            for (int n = 0; n < 2; ++n) { const f32x4 a = *(const f32x4*)(qg + 32 * bj + 16 * n + 4 * fq), b = *(const f32x4*)(kg + 32 * bj + 16 * n + 4 * fq);
                gv[bj][n] = nrm ? (type == 0 ? a : b) : (f32x4){1.f, 1.f, 1.f, 1.f}; }
        const float osc = type == 0 ? cfg::C2 : 1.f;
        const bool dorope = lat && type < 2;
#pragma unroll
        for (int ai = 0; ai < 2; ++ai) {
            f32x4 rr0 = (f32x4){1.f, 0.f, 1.f, 0.f}, rr1 = rr0;
            if (dorope) { const int prow = (pj - 1) * 4 + 2 * ai + wr; const f32x4* cs = (const f32x4*)(rope + (size_t)(prow * 16 + 4 * fq) * 2); rr0 = cs[0]; rr1 = cs[1]; }
#pragma unroll
            for (int mp = 0; mp < 2; ++mp) {
            f32x4 rc0[2], rc1[2];
#pragma unroll
            for (int mm = 0; mm < 2; ++mm) { rc0[mm] = (f32x4){1.f, 0.f, 1.f, 0.f}; rc1[mm] = rc0[mm]; }
            if (dorope) {
#pragma unroll
                for (int mm = 0; mm < 2; ++mm) { const PG8_LAS f32x4* cc = (const PG8_LAS f32x4*)(ropel + ((16 * (2 * mp + mm) + fr) * 16 + 4 * fq) * 2); rc0[mm] = cc[0]; rc1[mm] = cc[1]; }
            }
#pragma unroll
            for (int mm = 0; mm < 2; ++mm) {
                const int m = 2 * mp + mm;
                const int rt = ai * HALF + wr * 64 + m * 16 + fr;
                f32x4 v[2][2];
#pragma unroll
                for (int bj = 0; bj < 2; ++bj)
#pragma unroll
                    for (int n = 0; n < 2; ++n) v[bj][n] = acc[ai][bj][m][n];
                if (nrm) {
                    float ss = 0.f;
#pragma unroll
                    for (int bj = 0; bj < 2; ++bj)
#pragma unroll
                        for (int n = 0; n < 2; ++n) { const f32x4 x = v[bj][n]; ss += (x[0] * x[0] + x[1] * x[1]) + (x[2] * x[2] + x[3] * x[3]); }
                    ss += __shfl_xor(ss, 16); ss += __shfl_xor(ss, 32);
                    const float rstd = 1.0f / sqrtf(ss * (1.f / 64.f) + cfg::EPS);
#pragma unroll
                    for (int bj = 0; bj < 2; ++bj)
#pragma unroll
                        for (int n = 0; n < 2; ++n) v[bj][n] = v[bj][n] * rstd * gv[bj][n];
                }
                if (dorope) {
#pragma unroll
                    for (int bj = 0; bj < 2; ++bj) {
                        const f32x4 A = bj == 0 ? rr0 : rc0[mm], B = bj == 0 ? rr1 : rc1[mm];
                        const f32x4 c = (f32x4){A[0], A[2], B[0], B[2]}, s = (f32x4){A[1], A[3], B[1], B[3]};
                        const f32x4 x1 = v[bj][0], x2 = v[bj][1];
                        v[bj][0] = x1 * c - x2 * s; v[bj][1] = x2 * c + x1 * s;
                    }
                }
                const size_t tile_ = (size_t)((pb * 4 + wc) * 260 + pj * 4 + (rt >> 6));
                bf16_t* rowp = type == 1 ? (bf16_t*)(ws + ::WS_K) + (tile_ * 8 + fq) * 512 + (rt & 63) * 8
                             : type == 2 ? (bf16_t*)(ws + ::WS_V) + tile_ * 4096 + (rt & 63) * 32 + 8 * fq
                                         : dst + ((size_t)u.pm * BM + rt) * ldd + 8 * fq;
                const int sbj = type == 0 ? 32 : 2048;
#pragma unroll
                for (int bj = 0; bj < 2; ++bj) { const f32x4 o0 = v[bj][0] * osc, o1 = v[bj][1] * osc; u32x4 w; w.x = cvt_pk_bf16(o0[0], o0[1]); w.y = cvt_pk_bf16(o0[2], o0[3]); w.z = cvt_pk_bf16(o1[0], o1[1]); w.w = cvt_pk_bf16(o1[2], o1[3]);
                    *(u32x4*)(rowp + sbj * bj) = w; }
            }
            asm volatile("" ::: "memory");
            }
        }
    }
};
struct EpiResid {
    static constexpr bool PERM = false, AFTER_DRAIN = false, PRE = false;
    bf16_t* XR; const float* modl; const float* in_x; const float* in_ctx; int first;
    float* part = nullptr;
    __device__ __forceinline__ void operator()(const f32x4 (&acc)[2][2][4][2], const Unit& u, int wr_, int wc_, int fr_, int fq_) const {
        int wr = wr_, wc = wc_, fr = fr_, fq = fq_; asm volatile("" : "+s"(wr), "+s"(wc), "+v"(fr), "+v"(fq));
        const int pb = u.pm / 65, pj = u.pm - pb * 65; const int mv = pj == 0 ? 2 : pb;
        const int col0 = u.pn * BM + wc * 32 + 8 * fq;
        const float* g1 = modl + (size_t)mv * 6144 + 2048 + col0;
        const float* rin = pj == 0 ? in_ctx + (size_t)pb * 256 * 1024 : in_x + ((size_t)pb * 16384 + (size_t)(pj - 1) * 256) * 1024;
        f32x4 gv[2][2];
#pragma unroll
        for (int bj = 0; bj < 2; ++bj)
#pragma unroll
            for (int n = 0; n < 2; ++n) gv[bj][n] = *(const f32x4*)(g1 + bj * HALF + n * 4);
        if (u.kq > 0) {
            float* pb0 = part + ((size_t)(u.kq - 1) * 512 + (size_t)pb * 256) * 1024 + col0;
#pragma unroll
            for (int ai = 0; ai < 2; ++ai)
#pragma unroll
                for (int m = 0; m < 4; ++m) { float* rowp = pb0 + (size_t)(ai * HALF + wr * 64 + m * 16 + fr) * 1024;
#pragma unroll
                    for (int bj = 0; bj < 2; ++bj)
#pragma unroll
                        for (int n = 0; n < 2; ++n) *(f32x4*)(rowp + bj * HALF + n * 4) = gv[bj][n] * acc[ai][bj][m][n]; }
            return; }
#pragma unroll
        for (int ai = 0; ai < 2; ++ai)
#pragma unroll
            for (int mp = 0; mp < 2; ++mp) {
                f32x4 xv[2][2][2];
#pragma unroll
                for (int mm = 0; mm < 2; ++mm) { const size_t ro = (size_t)(ai * HALF + wr * 64 + (2 * mp + mm) * 16 + fr) * 1024 + col0;
                    if (first) { const float* rowp = rin + ro;
#pragma unroll
                        for (int bj = 0; bj < 2; ++bj)
#pragma unroll
                            for (int n = 0; n < 2; ++n) xv[mm][bj][n] = *(const f32x4*)(rowp + bj * HALF + n * 4); }
                    else { const bf16_t* rowp = XR + (size_t)u.pm * BM * 1024 + ro;
#pragma unroll
                        for (int bj = 0; bj < 2; ++bj) { const u32x4 w = *(const u32x4*)(rowp + bj * HALF);
                            xv[mm][bj][0] = (f32x4){__builtin_bit_cast(float, w.x << 16), __builtin_bit_cast(float, w.x & 0xffff0000u), __builtin_bit_cast(float, w.y << 16), __builtin_bit_cast(float, w.y & 0xffff0000u)};
                            xv[mm][bj][1] = (f32x4){__builtin_bit_cast(float, w.z << 16), __builtin_bit_cast(float, w.z & 0xffff0000u), __builtin_bit_cast(float, w.w << 16), __builtin_bit_cast(float, w.w & 0xffff0000u)}; } } }
#pragma unroll
                for (int mm = 0; mm < 2; ++mm) { bf16_t* rowp = XR + ((size_t)u.pm * BM + ai * HALF + wr * 64 + (2 * mp + mm) * 16 + fr) * 1024 + col0;
#pragma unroll
                    for (int bj = 0; bj < 2; ++bj) { const f32x4 o0 = xv[mm][bj][0] + gv[bj][0] * acc[ai][bj][2 * mp + mm][0], o1 = xv[mm][bj][1] + gv[bj][1] * acc[ai][bj][2 * mp + mm][1];
                        u32x4 w; w.x = cvt_pk_bf16(o0[0], o0[1]); w.y = cvt_pk_bf16(o0[2], o0[3]); w.z = cvt_pk_bf16(o1[0], o1[1]); w.w = cvt_pk_bf16(o1[2], o1[3]);
                        *(u32x4*)(rowp + bj * HALF) = w; } }
                asm volatile("" ::: "memory");
            }
    }
};
struct EpiSwiGLU {
    static constexpr bool PERM = false, AFTER_DRAIN = false, PRE = false;
    bf16_t* ACT; int ntn;
    __device__ __forceinline__ void operator()(const f32x4 (&acc)[2][2][4][2], const Unit& u, int wr_, int wc_, int fr_, int fq_) const {
        int wr = wr_, wc = wc_, fr = fr_, fq = fq_; asm volatile("" : "+s"(wr), "+s"(wc), "+v"(fr), "+v"(fq));
        const int pnl = u.pn % ntn; const int f0 = 128 * pnl + 32 * wc + 8 * fq;
#pragma unroll
        for (int ai = 0; ai < 2; ++ai)
#pragma unroll
            for (int m = 0; m < 4; ++m) { bf16_t* rowp = ACT + ((size_t)u.pm * BM + ai * HALF + wr * 64 + m * 16 + fr) * 2048 + f0;
                u32x4 w;
#pragma unroll
                for (int bj = 0; bj < 2; ++bj) { const f32x4 g = acc[ai][bj][m][0], up = acc[ai][bj][m][1]; f32x4 a;
#pragma unroll
                    for (int q = 0; q < 4; ++q) a[q] = (g[q] * up[q]) * __builtin_amdgcn_rcpf(1.f + __builtin_amdgcn_exp2f(g[q]));
                    if (bj == 0) { w.x = cvt_pk_bf16(a[0], a[1]); w.y = cvt_pk_bf16(a[2], a[3]); } else { w.z = cvt_pk_bf16(a[0], a[1]); w.w = cvt_pk_bf16(a[2], a[3]); } }
                *(u32x4*)rowp = w; }
    }
};
constexpr int YP_ROW0 = NSLOT;
struct EpiDown {
    static constexpr bool PERM = false, AFTER_DRAIN = false, PRE = true;
    bf16_t* Y; const float* selg; int ntn; PG8_LAS float* gl;
    __device__ __forceinline__ void pre(const Unit& u, int wid, int lane) const { if (wid < 4) __builtin_amdgcn_global_load_lds((const unsigned*)(selg + (size_t)u.pm * BM + wid * 64 + lane), (PG8_LAS unsigned*)(gl + u.par * 256 + wid * 64), 4, 0, 0); }
    __device__ __forceinline__ void operator()(const f32x4 (&acc)[2][2][4][2], const Unit& u, int wr_, int wc_, int fr_, int fq_) const {
        int wr = wr_, wc = wc_, fr = fr_, fq = fq_; asm volatile("" : "+s"(wr), "+s"(wc), "+v"(fr), "+v"(fq));
        const int pnl = u.pn % ntn; const int col0 = pnl * BM + wc * 32 + 8 * fq;
        const size_t rowb = u.kq < 0 ? (size_t)u.pm * BM : (size_t)(YP_ROW0 + 4096 * u.kq) + (size_t)(u.pm - 256) * BM;
        float gts[2][4];
#pragma unroll
        for (int ai = 0; ai < 2; ++ai)
#pragma unroll
            for (int m = 0; m < 4; ++m) gts[ai][m] = gl[u.par * 256 + ai * HALF + wr * 64 + m * 16 + fr];
#pragma unroll
        for (int ai = 0; ai < 2; ++ai)
#pragma unroll
            for (int m = 0; m < 4; ++m) { const size_t row = rowb + ai * HALF + wr * 64 + m * 16 + fr; const float gt = gts[ai][m]; bf16_t* rowp = Y + row * 1024 + col0;
#pragma unroll
                for (int bj = 0; bj < 2; ++bj) { const f32x4 o0 = acc[ai][bj][m][0] * gt, o1 = acc[ai][bj][m][1] * gt; u32x4 w; w.x = cvt_pk_bf16(o0[0], o0[1]); w.y = cvt_pk_bf16(o0[2], o0[3]); w.z = cvt_pk_bf16(o1[0], o1[1]); w.w = cvt_pk_bf16(o1[2], o1[3]);
                    *(u32x4*)(rowp + bj * HALF) = w; } }
    }
};
struct MoeOrder {
    int nMe, nN, nwg, G, c;
    __device__ void init(int nMe_, int nN_, int G_, int c_) { nMe = nMe_; nN = nN_; nwg = 16 * nMe * nN; G = G_; c = c_; }
    __device__ bool next(int i, Unit& u) const {
        const int L = i * G + c; if (L >= nwg) return false;
        int wgid = L; { const int q = nwg / NXCD, r = nwg % NXCD, xcd = wgid % NXCD, off = wgid / NXCD; wgid = (xcd < r ? xcd * (q + 1) : r * (q + 1) + (xcd - r) * q) + off; }
        const int per = nMe * nN, e = wgid / per, idx = wgid - e * per;
        const int nig = WGM * nN, gid = idx / nig, fm = gid * WGM, gsz = (nMe - fm) < WGM ? (nMe - fm) : WGM;
        const int pml = fm + ((idx % nig) % gsz), pnl = (idx % nig) / gsz;
        u.pm = pml < 8 ? e * 8 + pml : (pml < 16 ? (16 + e) * 8 + (pml - 8) : 256 + e);
        u.pn = e * nN + pnl; return true;
    }
    __device__ __forceinline__ void a_ready(const Unit&) const {}
    __device__ __forceinline__ void done(const Unit&) const {}
};
struct MoeSplitOrder {
    MoeOrder lat; int G, c;
    __device__ void init(int G_, int c_) { lat.init(16, 4, G_, c_); G = G_; c = c_; }
    __device__ bool next(int i, Unit& u) const {
        Unit v; v.pm = 0; v.pn = 0; const bool isl = lat.next(i, v);
        const int Lq = i * G + c - lat.nwg; if (!isl && Lq >= 256) return false;
        const int xcd = Lq & (NXCD - 1), off = Lq >> 3, e = 2 * xcd + (off >> 4), kq = off & 3;
        u.pm = isl ? v.pm : 256 + e; u.pn = isl ? v.pn : e * 4 + ((off >> 2) & 3); u.kq = isl ? -1 : kq; u.kt0 = isl ? 0 : 8 * kq; u.nkt = isl ? 32 : 8; return true;
    }
    __device__ __forceinline__ void a_ready(const Unit&) const {}
    __device__ __forceinline__ void done(const Unit&) const {}
};
struct MoeCtxLastOrder {
    MoeOrder lat; int G, c;
    __device__ void init(int G_, int c_) { lat.init(16, 16, G_, c_); G = G_; c = c_; }
    __device__ bool next(int i, Unit& u) const {
        Unit v; v.pm = 0; v.pn = 0; const bool isl = lat.next(i, v);
        const int Lq = i * G + c - lat.nwg; if (!isl && Lq >= 256) return false;
        const int xcd = Lq & (NXCD - 1), off = Lq >> 3, e = 2 * xcd + (off >> 4);
        u.pm = isl ? v.pm : 256 + e; u.pn = isl ? v.pn : e * 16 + (off & 15); return true;
    }
    __device__ __forceinline__ void a_ready(const Unit&) const {}
    __device__ __forceinline__ void done(const Unit&) const {}
};
struct DenseOrder {
    int nM, nN, nwg, G, c, skipctx;
    __device__ void init(int M, int N, int G_, int c_, int skipctx_ = 0) { nM = M / BM; nN = N / BM; nwg = nM * nN; G = G_; c = c_; skipctx = skipctx_; }
    __device__ bool next(int i, Unit& u) const {
        const int L = i * G + c; if (L >= nwg) return false;
        int wgid = L; { const int q = nwg / NXCD, r = nwg % NXCD, xcd = wgid % NXCD, off = wgid / NXCD; wgid = (xcd < r ? xcd * (q + 1) : r * (q + 1) + (xcd - r) * q) + off; }
        const int nig = WGM * nN, gid = wgid / nig, fm = gid * WGM, gsz = (nM - fm) < WGM ? (nM - fm) : WGM;
        u.pm = fm + ((wgid % nig) % gsz); u.pn = (wgid % nig) / gsz; if (skipctx) u.pm += 1 + (u.pm >= 64 ? 1 : 0); return true;
    }
    __device__ __forceinline__ void a_ready(const Unit&) const {}
    __device__ __forceinline__ void done(const Unit&) const {}
};
struct DenseSplitOrder {
    DenseOrder lat; int G, c;
    __device__ void init(int G_, int c_) { lat.init(NB * SEQ, D, G_, c_, 1); G = G_; c = c_; }
    __device__ bool next(int i, Unit& u) const {
        Unit v; v.pm = 0; v.pn = 0; const bool isl = lat.next(i, v);
        const int Lq = i * G + c - lat.nwg; if (!isl && Lq >= 32) return false;
        const int xcd = Lq & (NXCD - 1), kq = (Lq >> 3) & 3;
        u.pm = isl ? v.pm : ((xcd >> 2) ? 65 : 0); u.pn = isl ? v.pn : (xcd & 3); u.kq = isl ? -1 : kq; u.kt0 = isl ? 0 : 4 * kq; u.nkt = isl ? 16 : 4; return true;
    }
    __device__ __forceinline__ void a_ready(const Unit&) const {}
    __device__ __forceinline__ void done(const Unit&) const {}
};

template <class Epi, class Sched, bool ALIGN_EPI = false, bool SP2 = false, bool GATHER = false, bool BTILED = true, bool SPLITK = false, bool THIN = false>
__device__ __forceinline__ void gemm_phase(PG8_LAS unsigned char* lds, const Gemm g, const Sched& S, const Epi& E) {
    const int tid = otid(), wid = __builtin_amdgcn_readfirstlane(tid >> 6), lane = tid & 63, wr = wid >> 2, wc = wid & 3, fr = lane & 15, fq = lane >> 4;
    const int K = g.K, nt = K / BK;
    static_assert(!GATHER || SP2, "GATHER is wired into the SP2 loop only");
    unsigned voffA[2], voffB[2], goC[2][2], goN[2][2]; int gR[2]; unsigned gC[2];
#pragma unroll
    for (int i = 0; i < 2; ++i) { int R, C; stage_rc(tid * 16 + i * 8192, R, C); const int Rb = Epi::PERM ? ((R & ~31) + perm32(R & 31)) : R;
        voffA[i] = (unsigned)(R * K + C) * 2u; voffB[i] = BTILED ? (unsigned)(tid * 16 + i * 8192) : (unsigned)(Rb * K + C) * 2u; gR[i] = R; gC[i] = (unsigned)C * 2u; }
    static_assert(!BTILED || !Epi::PERM, "BTILED: the weight copy is already in LDS image order (no perm32)");
    PG8_LAS int* gix = (PG8_LAS int*)(lds + STAGE_BYTES + 64);
    const size_t kstep = (size_t)(BK * 2);
    const size_t kstepB = BTILED ? (size_t)HTB : kstep;
    const size_t hstep = (size_t)HALF * K * 2;
    const size_t tstep = 2 * hstep;
    const unsigned ldsw = (unsigned)wid * 1024u;
    const int aoff = lds_byte(wr * 64 + fr, fq * 8), boff = lds_byte(wc * 32 + fr, fq * 8);
#define PG8_SA(b, h) (((b) * 2 + (h)) * HTB)
#define PG8_SB(b, h) ((4 + (b) * 2 + (h)) * HTB)
#define PG8_STAGE(bufoff, gbase, voff) do { _Pragma("unroll") for (int _i = 0; _i < 2; ++_i) \
        __builtin_amdgcn_global_load_lds((const unsigned*)((const char*)(gbase) + (voff)[_i]), (PG8_LAS unsigned*)(lds + (bufoff) + ldsw + _i * 8192), 16, 0, 0); } while (0)
#define PG8_STAGE_A(bufoff, ptr, kb, h, NX) do { if constexpr (GATHER) { const char* _gb = (const char*)g.A + (kb); const unsigned _v0 = (NX) ? goN[h][0] : goC[h][0], _v1 = (NX) ? goN[h][1] : goC[h][1]; \
        __builtin_amdgcn_global_load_lds((const unsigned*)(_gb + _v0), (PG8_LAS unsigned*)(lds + (bufoff) + ldsw), 16, 0, 0); __builtin_amdgcn_global_load_lds((const unsigned*)(_gb + _v1), (PG8_LAS unsigned*)(lds + (bufoff) + ldsw + 8192), 16, 0, 0); } \
    else { PG8_STAGE(bufoff, ptr, voffA); } } while (0)
#define PG8_LDA(dst, b, h) do { _Pragma("unroll") for (int m = 0; m < 4; ++m) _Pragma("unroll") for (int k = 0; k < 2; ++k) dst[m][k] = *(const PG8_LAS bf16x8*)(lds + PG8_SA(b, h) + aoff + m * 2048 + k * 1024); } while (0)
#define PG8_LDB(dst, b, h) do { _Pragma("unroll") for (int n = 0; n < 2; ++n) _Pragma("unroll") for (int k = 0; k < 2; ++k) dst[n][k] = *(const PG8_LAS bf16x8*)(lds + PG8_SB(b, h) + boff + n * 2048 + k * 1024); } while (0)
#define PG8_MMA(ai, bj, At, Bt) do { __builtin_amdgcn_s_setprio(1); _Pragma("unroll") for (int m = 0; m < 4; ++m) _Pragma("unroll") for (int n = 0; n < 2; ++n) _Pragma("unroll") for (int k = 0; k < 2; ++k) \
        acc[ai][bj][m][n] = __builtin_amdgcn_mfma_f32_16x16x32_bf16(Bt[n][k], At[m][k], acc[ai][bj][m][n], 0, 0, 0); __builtin_amdgcn_s_setprio(0); } while (0)
#define PG8_WAIT_V(n) asm volatile("s_waitcnt vmcnt(" #n ")" ::: "memory")
#define PG8_WAIT_L(n) asm volatile("s_waitcnt lgkmcnt(" #n ")" ::: "memory")
#define PG8_BAR __builtin_amdgcn_s_barrier()
#define PG8_SCHED __builtin_amdgcn_sched_barrier(0)
    Unit cur, nxt; int ui = 0;
    if (!S.next(0, cur)) return;
    cur.par = 0;
    f32x4 acc[2][2][4][2];
#pragma unroll
    for (int a = 0; a < 2; ++a)
#pragma unroll
        for (int b = 0; b < 2; ++b)
#pragma unroll
            for (int m = 0; m < 4; ++m)
#pragma unroll
                for (int n = 0; n < 2; ++n) acc[a][b][m][n] = (f32x4){0.f, 0.f, 0.f, 0.f};
    bf16x8 At[4][2], B0[2][2], B1[2][2];
    const char* cA = (const char*)g.A + (size_t)cur.pm * tstep; const char* cB = (const char*)g.Bt + (size_t)cur.pn * tstep;
    if constexpr (SPLITK) { cA += (size_t)cur.kt0 * kstep; cB += (size_t)cur.kt0 * kstepB; }
    if constexpr (GATHER) {
#pragma unroll
        for (int h = 0; h < 2; ++h)
#pragma unroll
            for (int i = 0; i < 2; ++i) { goC[h][i] = (unsigned)g.gidx[(size_t)cur.pm * BM + h * HALF + gR[i]] * (unsigned)(K * 2) + gC[i]; goN[h][i] = goC[h][i]; } }
    S.a_ready(cur);
    if constexpr (SP2) {
        PG8_STAGE(PG8_SB(0, 0), cB, voffB); PG8_STAGE(PG8_SB(0, 1), cB + hstep, voffB); PG8_STAGE_A(PG8_SA(0, 0), cA, 0, 0, false); PG8_STAGE_A(PG8_SA(0, 1), cA + hstep, 0, 1, false);
        if (wr == 1) PG8_BAR;
        PG8_WAIT_V(2); PG8_BAR;
        PG8_STAGE(PG8_SB(1, 0), cB + kstepB, voffB); PG8_STAGE_A(PG8_SA(1, 0), cA + kstep, kstep, 0, false); PG8_STAGE(PG8_SB(1, 1), cB + hstep + kstepB, voffB);
        PG8_WAIT_V(6); PG8_BAR;
    } else {
        PG8_STAGE(PG8_SB(0, 0), cB, voffB); PG8_STAGE(PG8_SA(0, 0), cA, voffA); PG8_STAGE(PG8_SB(0, 1), cB + hstep, voffB); PG8_STAGE(PG8_SA(0, 1), cA + hstep, voffA);
        if (wr == 1) PG8_BAR;
        PG8_WAIT_V(4); PG8_BAR;
        PG8_STAGE(PG8_SB(1, 0), cB + kstepB, voffB); PG8_STAGE(PG8_SA(1, 0), cA + kstep, voffA); PG8_STAGE(PG8_SB(1, 1), cB + hstep + kstepB, voffB);
        PG8_WAIT_V(6); PG8_BAR;
    }
    for (;;) {
        const bool has_next = S.next(ui + 1, nxt);
        nxt.par = (ui + 1) & 1;
        const char* nA = has_next ? (const char*)g.A + (size_t)nxt.pm * tstep + (SPLITK ? (size_t)nxt.kt0 * kstep : (size_t)0) : cA; const char* nB = has_next ? (const char*)g.Bt + (size_t)nxt.pn * tstep + (SPLITK ? (size_t)nxt.kt0 * kstepB : (size_t)0) : cB;
        const int ntc = SPLITK ? cur.nkt : nt;
        const bool thin = THIN && cur.pm >= 256;
        if constexpr (Epi::PRE) E.pre(cur, wid, lane);
        if constexpr (GATHER) { if (has_next && wid < 4) __builtin_amdgcn_global_load_lds((const unsigned*)(g.gidx + (size_t)nxt.pm * BM + wid * 64 + lane), (PG8_LAS unsigned*)(gix + ((ui + 1) & 1) * 256 + wid * 64), 4, 0, 0); }
        for (int t = 0; t < ntc; t += 2) {
            const bool last = (t == ntc - 2);
            const char* a1 = cA + (size_t)(t + 1) * kstep;
            const char* a2 = last ? nA : cA + (size_t)(t + 2) * kstep; const char* b2 = last ? nB : cB + (size_t)(t + 2) * kstepB;
            const char* a3 = a2 + kstep; const char* b3 = b2 + kstepB;
            if (last && has_next) S.a_ready(nxt);
            const size_t kb2 = last ? (size_t)0 : (size_t)(t + 2) * kstep;
            if constexpr (GATHER) { if (last && has_next) {
#pragma unroll
                for (int h = 0; h < 2; ++h)
#pragma unroll
                    for (int i = 0; i < 2; ++i) goN[h][i] = (unsigned)gix[((ui + 1) & 1) * 256 + h * HALF + gR[i]] * (unsigned)(K * 2) + gC[i]; } }
            if constexpr (SP2) {
            PG8_LDB(B0, 0, 0); PG8_LDB(B1, 0, 1); PG8_SCHED; PG8_LDA(At, 0, 0); PG8_STAGE_A(PG8_SA(1, 1), a1 + hstep, (size_t)(t + 1) * kstep, 1, false);
            PG8_WAIT_V(8); PG8_WAIT_L(0); PG8_BAR; PG8_MMA(0, 0, At, B0); PG8_MMA(0, 1, At, B1); PG8_BAR; PG8_SCHED;
            PG8_LDA(At, 0, 1); PG8_STAGE(PG8_SB(0, 0), b2, voffB); PG8_STAGE(PG8_SB(0, 1), b2 + hstep, voffB); PG8_STAGE_A(PG8_SA(0, 0), a2, kb2, 0, last);
            PG8_WAIT_V(8); PG8_WAIT_L(0); PG8_BAR; if (!thin) { PG8_MMA(1, 0, At, B0); PG8_MMA(1, 1, At, B1); } PG8_BAR; PG8_SCHED;
            PG8_LDB(B0, 1, 0); PG8_LDB(B1, 1, 1); PG8_SCHED; PG8_LDA(At, 1, 0); PG8_STAGE_A(PG8_SA(0, 1), a2 + hstep, kb2, 1, last);
            PG8_WAIT_V(8); PG8_WAIT_L(0); PG8_BAR; PG8_MMA(0, 0, At, B0); PG8_MMA(0, 1, At, B1); PG8_BAR; PG8_SCHED;
            PG8_LDA(At, 1, 1); PG8_STAGE(PG8_SB(1, 0), b3, voffB); PG8_STAGE(PG8_SB(1, 1), b3 + hstep, voffB); PG8_STAGE_A(PG8_SA(1, 0), a3, kb2 + kstep, 0, last);
            PG8_WAIT_V(8); PG8_WAIT_L(0); PG8_BAR; if (!thin) { PG8_MMA(1, 0, At, B0); PG8_MMA(1, 1, At, B1); } PG8_BAR; PG8_SCHED;
            } else {
            PG8_LDB(B0, 0, 0); PG8_SCHED; PG8_LDA(At, 0, 0); PG8_STAGE(PG8_SA(1, 1), a1 + hstep, voffA);
            PG8_WAIT_L(8); PG8_BAR; PG8_WAIT_L(0); PG8_MMA(0, 0, At, B0); PG8_BAR; PG8_SCHED;
            PG8_LDB(B1, 0, 1); PG8_STAGE(PG8_SB(0, 0), b2, voffB);
            PG8_BAR; PG8_WAIT_L(0); PG8_MMA(0, 1, At, B1); PG8_BAR;
            PG8_LDA(At, 0, 1); PG8_STAGE(PG8_SA(0, 0), a2, voffA);
            PG8_BAR; PG8_WAIT_L(0); PG8_MMA(1, 0, At, B0); PG8_BAR; PG8_SCHED;
            PG8_STAGE(PG8_SB(0, 1), b2 + hstep, voffB);
            PG8_WAIT_V(6); PG8_BAR; PG8_MMA(1, 1, At, B1); PG8_BAR;
            PG8_LDB(B0, 1, 0); PG8_SCHED; PG8_LDA(At, 1, 0); PG8_STAGE(PG8_SA(0, 1), a2 + hstep, voffA);
            PG8_WAIT_L(8); PG8_BAR; PG8_WAIT_L(0); PG8_MMA(0, 0, At, B0); PG8_BAR; PG8_SCHED;
            PG8_LDB(B1, 1, 1); PG8_STAGE(PG8_SB(1, 0), b3, voffB);
            PG8_BAR; PG8_WAIT_L(0); PG8_MMA(0, 1, At, B1); PG8_BAR;
            PG8_LDA(At, 1, 1); PG8_STAGE(PG8_SA(1, 0), a3, voffA);
            PG8_BAR; PG8_WAIT_L(0); PG8_MMA(1, 0, At, B0); PG8_BAR; PG8_SCHED;
            PG8_STAGE(PG8_SB(1, 1), b3 + hstep, voffB);
            PG8_WAIT_V(6); PG8_BAR; PG8_MMA(1, 1, At, B1); PG8_BAR;
            }
        }
        if constexpr (ALIGN_EPI) { if (wr == 0) PG8_BAR; }
        if constexpr (!Epi::AFTER_DRAIN) { E(acc, cur, wr, wc, fr, fq); S.done(cur); }
        if (!has_next) break;
#pragma unroll
        for (int a = 0; a < 2; ++a)
#pragma unroll
            for (int b = 0; b < 2; ++b)
#pragma unroll
                for (int m = 0; m < 4; ++m)
#pragma unroll
                    for (int n = 0; n < 2; ++n) acc[a][b][m][n] = (f32x4){0.f, 0.f, 0.f, 0.f};
        cur = nxt; cA = nA; cB = nB; ++ui;
        if constexpr (GATHER) {
#pragma unroll
            for (int h = 0; h < 2; ++h)
#pragma unroll
                for (int i = 0; i < 2; ++i) goC[h][i] = goN[h][i]; }
        if constexpr (ALIGN_EPI) { if (wr == 1) PG8_BAR; }
    }
    PG8_WAIT_V(0);
    if constexpr (!ALIGN_EPI) { if (wr == 0) PG8_BAR; }
    PG8_BAR;
    if constexpr (Epi::AFTER_DRAIN) { E.fused(acc, cur, wr, wc, fr, fq, lds, wid, lane); S.done(cur); }
#undef PG8_SA
#undef PG8_SB
#undef PG8_STAGE
#undef PG8_STAGE_A
#undef PG8_LDA
#undef PG8_LDB
#undef PG8_MMA
#undef PG8_WAIT_V
#undef PG8_WAIT_L
#undef PG8_BAR
#undef PG8_SCHED
}
}


__device__ __forceinline__ void phase_qkv(const Params& P, int layer, LAS unsigned char* lds) {
    unsigned char* const ws = ows(P);
    pg8::Gemm g{(const bf16_t*)(ws + WS_H), (const bf16_t*)(ws + WS_WQKV) + (size_t)layer * QKVW * D, R, QKVW, D};
    pg8::DenseOrder S; S.init(R, QKVW, (int)gridDim.x, (int)blockIdx.x);
    LAS float* ropel = (LAS float*)(lds + pg8::STAGE_BYTES + 4608);
    { const int tid = otid(); ((LAS f32x4*)ropel)[tid] = ((const f32x4*)(ws + WS_ROPE))[tid]; __syncthreads(); }
    pg8::EpiQKV E{ws, (const float*)(ws + WS_ROPE), P.q_norm_g + (layer >> 1) * 64, P.k_norm_g + (layer >> 1) * 64, (layer & 1) == 0 ? 1 : 0, ropel};
    pg8::gemm_phase<pg8::EpiQKV, pg8::DenseOrder, true, true>(lds, g, S, E);
}
__device__ __forceinline__ void phase_oproj(const Params& P, int layer, LAS unsigned char* lds) {
    unsigned char* const ws = ows(P);
    pg8::Gemm g{(const bf16_t*)(ws + WS_O), (const bf16_t*)(ws + WS_WO) + (size_t)layer * D * D, R, D, D};
    pg8::EpiResid E{(bf16_t*)(ws + WS_XR), (const float*)(ws + WS_MOD) + (size_t)layer * 3 * 6144, P.x, P.ctx, layer == 0 ? 1 : 0, (float*)(ws + WS_XSEL)};
    if (layer == DEPTH - 1) { pg8::DenseOrder S; S.init(NB * SEQ, D, (int)gridDim.x, (int)blockIdx.x, 1); pg8::gemm_phase<pg8::EpiResid, pg8::DenseOrder, true, true>(lds, g, S, E); }
    else { pg8::DenseSplitOrder S; S.init((int)gridDim.x, (int)blockIdx.x); pg8::gemm_phase<pg8::EpiResid, pg8::DenseSplitOrder, true, true, false, true, true>(lds, g, S, E); }
}
__device__ __forceinline__ void phase_gateup(const Params& P, int layer, LAS unsigned char* lds) {
    unsigned char* const ws = ows(P);
    pg8::Gemm g{(const bf16_t*)(ws + WS_H), (const bf16_t*)(ws + WS_WGU) + (size_t)layer * NE * (2 * DE) * D, NSLOT, 2 * DE, D, (const int*)(ws + WS_SELI)};
    pg8::EpiSwiGLU E{(bf16_t*)(ws + WS_ACT), 16};
    if (layer == DEPTH - 1) { pg8::MoeOrder S; S.init(16, 16, (int)gridDim.x, (int)blockIdx.x); pg8::gemm_phase<pg8::EpiSwiGLU, pg8::MoeOrder, true, true, true>(lds, g, S, E); }
    else { pg8::MoeCtxLastOrder S; S.init((int)gridDim.x, (int)blockIdx.x); pg8::gemm_phase<pg8::EpiSwiGLU, pg8::MoeCtxLastOrder, true, true, true, true, false, true>(lds, g, S, E); }
}
__device__ __forceinline__ void phase_down(const Params& P, int layer, LAS unsigned char* lds) {
    unsigned char* const ws = ows(P);
    pg8::Gemm g{(const bf16_t*)(ws + WS_ACT), (const bf16_t*)(ws + WS_WD) + (size_t)layer * NE * D * DE, NSLOT, D, DE};
    pg8::EpiDown E{(bf16_t*)(ws + WS_Y), (const float*)(ws + WS_SELG), 4, (LAS float*)(lds + pg8::STAGE_BYTES + 2112)};
    if (layer == DEPTH - 1) { pg8::MoeOrder S; S.init(16, 4, (int)gridDim.x, (int)blockIdx.x); pg8::gemm_phase<pg8::EpiDown, pg8::MoeOrder, true, true>(lds, g, S, E); }
    else { pg8::MoeSplitOrder S; S.init((int)gridDim.x, (int)blockIdx.x); pg8::gemm_phase<pg8::EpiDown, pg8::MoeSplitOrder, true, true, false, true, true, true>(lds, g, S, E); }
}
namespace attn_body {
using bf16=__hip_bfloat16;
using bf16x8=__attribute__((ext_vector_type(8)))short;
using s16x4=__attribute__((ext_vector_type(4)))short;
using f32x16=__attribute__((ext_vector_type(16)))float;
using u32x4=__attribute__((ext_vector_type(4)))unsigned;
constexpr int D=64,DM=1024,KP=256;
constexpr int NW=8,QBLK=32,QB=QBLK*NW,KVBLK=64;
__device__ __forceinline__ int crow(int r,int hi){return (r&3)+8*(r>>2)+4*hi;}
#define SBAR() __builtin_amdgcn_sched_barrier(0)
__device__ __forceinline__ void wmask(f32x16&p0,f32x16&p1,int dk0,int hi){
  const float NEG=-INFINITY; const int kb=dk0+4*hi;
  #pragma unroll
  for(int r=0;r<16;++r){const int dk=kb+(r&3)+8*(r>>2); if(dk<-128||dk>128)p0[r]=NEG; if(dk+32<-128||dk+32>128)p1[r]=NEG;}
}

constexpr int NSLOT=3, SLOTB=8192;
constexpr int LDS_K=0, LDS_V=NSLOT*SLOTB, LDS_WS=2*NSLOT*SLOTB, LDS_OST=LDS_WS+NW*64*4, LDS_BYTES=LDS_OST+NW*4096;
constexpr float C2=0.125f*1.4426950408889634f;
__device__ __forceinline__ void glds16(const void*gsrc,unsigned lds_dst){unsigned keep;
  asm volatile("s_mov_b32 %0, m0\n\ts_mov_b32 m0, %2\n\ts_nop 0\n\tglobal_load_lds_dwordx4 %1, off\n\ts_mov_b32 m0, %0":"=&s"(keep):"v"(gsrc),"s"(lds_dst):"memory");}
__device__ __forceinline__ float max3f(float a,float b,float c){float r;asm("v_max3_f32 %0, %1, %2, %3":"=v"(r):"v"(a),"v"(b),"v"(c));return r;}
__device__ __forceinline__ float max2f(float a,float b){float r;asm("v_max_f32_e32 %0, %1, %2":"=v"(r):"v"(a),"v"(b));return r;}
__device__ __forceinline__ float fadd_s(float a,float b){float r;asm("v_add_f32_e32 %0, %1, %2":"=v"(r):"v"(a),"v"(b));return r;}
__device__ __forceinline__ float fsub_s(float a,float b){float r;asm("v_sub_f32_e32 %0, %1, %2":"=v"(r):"v"(a),"v"(b));return r;}
typedef float f32x2_t __attribute__((ext_vector_type(2))); typedef __bf16 bf16x2_t __attribute__((ext_vector_type(2)));
__device__ __forceinline__ unsigned cvtpk_s(float lo,float hi){f32x2_t v={lo,hi};bf16x2_t b=__builtin_convertvector(v,bf16x2_t);return __builtin_bit_cast(unsigned,b);}
#define WAIT_BAR(N) asm volatile("s_waitcnt vmcnt(" #N ") lgkmcnt(0)\n\ts_barrier":::"memory")

__device__ __forceinline__ void qkt(f32x16&p0,f32x16&p1,const char*Kslot,const bf16x8*qr,const f32x16&negm,int r32,int hi){
  const char*kb=Kslot+hi*1024+r32*16;
  #pragma unroll
  for(int d0=0;d0<4;++d0){
    const bf16x8 b0=*reinterpret_cast<const bf16x8*>(kb+d0*2048);
    const bf16x8 b1=*reinterpret_cast<const bf16x8*>(kb+d0*2048+512);
    if(d0==0){p0=__builtin_amdgcn_mfma_f32_32x32x16_bf16(b0,qr[0],negm,0,0,0);p1=__builtin_amdgcn_mfma_f32_32x32x16_bf16(b1,qr[0],negm,0,0,0);}
    else{p0=__builtin_amdgcn_mfma_f32_32x32x16_bf16(b0,qr[d0],p0,0,0,0);p1=__builtin_amdgcn_mfma_f32_32x32x16_bf16(b1,qr[d0],p1,0,0,0);}}
}
typedef __attribute__((address_space(3))) const char* lds_cptr;
typedef short v4i16_t __attribute__((ext_vector_type(4)));
__device__ __forceinline__ void kload8(bf16x8*kf,lds_cptr kp){
  kf[0]=*(const __attribute__((address_space(3))) bf16x8*)(kp);      kf[1]=*(const __attribute__((address_space(3))) bf16x8*)(kp+512);
  kf[2]=*(const __attribute__((address_space(3))) bf16x8*)(kp+2048); kf[3]=*(const __attribute__((address_space(3))) bf16x8*)(kp+2560);
  kf[4]=*(const __attribute__((address_space(3))) bf16x8*)(kp+4096); kf[5]=*(const __attribute__((address_space(3))) bf16x8*)(kp+4608);
  kf[6]=*(const __attribute__((address_space(3))) bf16x8*)(kp+6144); kf[7]=*(const __attribute__((address_space(3))) bf16x8*)(kp+6656);
}
__device__ __forceinline__ void kload2(bf16x8*kf,lds_cptr kp,int j){ kf[2*j]=*(const __attribute__((address_space(3))) bf16x8*)(kp+j*2048); kf[2*j+1]=*(const __attribute__((address_space(3))) bf16x8*)(kp+j*2048+512); }
__device__ __forceinline__ s16x4 vtr(lds_cptr p){ return __builtin_bit_cast(s16x4,__builtin_amdgcn_ds_read_tr16_b64_v4i16((__attribute__((address_space(3))) v4i16_t*)p)); }
__device__ __forceinline__ float rowmax(const f32x16&p0,const f32x16&p1){
  float a=max3f(p0[0],p0[1],p1[0]),b=max3f(p0[2],p0[3],p1[1]);a=max3f(a,p1[2],p1[3]);
  #pragma unroll
  for(int r=4;r<16;r+=4){a=max3f(a,p0[r],p0[r+1]);b=max3f(b,p0[r+2],p0[r+3]);a=max3f(a,p1[r],p1[r+1]);b=max3f(b,p1[r+2],p1[r+3]);}
  const float m=max2f(a,b);
  auto rr=__builtin_amdgcn_permlane32_swap(__float_as_uint(m),__float_as_uint(m),false,false);
  return max2f(__uint_as_float(rr[0]),__uint_as_float(rr[1]));
}
__device__ __forceinline__ void pv(f32x16*o,int vb,bf16x8 pa0,bf16x8 pa1,bf16x8 pa2,bf16x8 pa3){
  #pragma unroll
  for(int d0=0;d0<2;++d0){s16x4 lo[4],hi[4];
    #pragma unroll
    for(int ks=0;ks<4;++ks){
      asm volatile("ds_read_b64_tr_b16 %0,%1 offset:%c2":"=&v"(lo[ks]):"v"(vb),"i"(d0*4096+ks*1024):"memory");
      asm volatile("ds_read_b64_tr_b16 %0,%1 offset:%c2":"=&v"(hi[ks]):"v"(vb),"i"(d0*4096+ks*1024+512):"memory");}
    asm volatile("s_waitcnt lgkmcnt(0)":::"memory");SBAR();
    #define PK(k) (bf16x8){lo[k][0],lo[k][1],lo[k][2],lo[k][3],hi[k][0],hi[k][1],hi[k][2],hi[k][3]}
    o[d0]=__builtin_amdgcn_mfma_f32_32x32x16_bf16(pa0,PK(0),o[d0],0,0,0);
    o[d0]=__builtin_amdgcn_mfma_f32_32x32x16_bf16(pa1,PK(1),o[d0],0,0,0);
    o[d0]=__builtin_amdgcn_mfma_f32_32x32x16_bf16(pa2,PK(2),o[d0],0,0,0);
    o[d0]=__builtin_amdgcn_mfma_f32_32x32x16_bf16(pa3,PK(3),o[d0],0,0,0);
    #undef PK
  }
}

#ifndef ATTN_STORE16
#define ATTN_STORE16(p,v) (*(u32x4*)(p)=(v))
#endif
struct AttnUnit { int qrow0, kvrow0, h, nt, lo, t0, kt0; };
template<int THRL,bool WINDOW,bool FIXREF> __device__ __forceinline__ void attn_unit(const AttnUnit u,const bf16*Q,const bf16*__restrict__ K,const bf16*__restrict__ V,bf16*O,char*shm,float sinkl2,float mfix){
  const int tid=otid(),lane=tid&63,r32=lane&31,hi=lane>>5; const int wid=__builtin_amdgcn_readfirstlane(tid>>6);
  const bf16*Qw=Q+((long)u.qrow0+wid*QBLK)*DM+u.h*D;
  const bf16*Kh=K+(long)u.kt0*4096,*Vh=V+(long)u.kt0*4096;
  const unsigned lds0=(unsigned)(uintptr_t)shm;
  float*wsf=(float*)(shm+LDS_WS)+wid*64;
  const bf16*ksrc=Kh+wid*512+lane*8;
  const bf16*vsrc=Vh+(wid>>2)*2048+(16*(wid&3)+(lane>>2))*32+(lane&3)*8;
  const unsigned kdst=lds0+LDS_K+wid*1024, vdst=lds0+LDS_V+wid*1024;
  #define TROW(t) (KVBLK*(t)+((WINDOW&&(t)>=4)?u.lo:0))
  #define DMA_K(t,slot) glds16(ksrc+(long)(TROW(t)>>6)*4096,(unsigned)__builtin_amdgcn_readfirstlane(kdst+(slot)))
  #define DMA_V(t,slot) glds16(vsrc+(long)(TROW(t)>>6)*4096,(unsigned)__builtin_amdgcn_readfirstlane(vdst+(slot)))
  const int vb0=(int)(lds0+LDS_V)+((lane>>4)&1)*32+(lane&3)*8+(4*hi+((lane&15)>>2))*64;
  const char*Kbase=shm+LDS_K; bf16x8 kf[8];
  const lds_cptr shm3=(lds_cptr)shm; const lds_cptr kp0=shm3+LDS_K+hi*1024+r32*16; const lds_cptr vp0=shm3+LDS_V+((lane>>4)&1)*32+(lane&3)*8+(4*hi+((lane&15)>>2))*64;
  const int NT=u.nt;
  DMA_K(0,0);DMA_V(0,0);DMA_K(1,SLOTB);
  bf16x8 qr[4];
  #pragma unroll
  for(int d0=0;d0<4;++d0)qr[d0]=*reinterpret_cast<const bf16x8*>(&Qw[(long)r32*DM+d0*16+hi*8]);
  float mhat=FIXREF?mfix:0.f,l_reg=0.f;f32x16 o[2];o[0]=f32x16{};o[1]=f32x16{};f32x16 negm=f32x16{};
  if(FIXREF){_Pragma("unroll") for(int r=0;r<16;++r)negm[r]=-mfix;} asm volatile("":"+v"(negm));
  const int qrel=wid*QBLK+r32;
  #define CMASK(P0,P1,t) do{ if(WINDOW){ if((t)>=4){ const int kq_=u.lo+KVBLK*((t)-4)-u.t0-wid*QBLK;     \
      if(kq_<31-128||kq_+63>128) wmask(P0,P1,kq_-r32,hi); } } }while(0)
  bool resc=false;
  #define START(P0,P1) do{ resc=false; \
    if constexpr(!FIXREF){ const float rm=rowmax(P0,P1); const float dl=rm; mhat=fadd_s(mhat,dl); \
      _Pragma("unroll") for(int r=0;r<16;++r){P0[r]=fsub_s(P0[r],dl);P1[r]=fsub_s(P1[r],dl);} \
      _Pragma("unroll") for(int r=0;r<16;++r)negm[r]=-mhat; asm volatile("":"+v"(negm)); } \
    _Pragma("unroll") for(int r=0;r<16;++r)P0[r]=__builtin_amdgcn_exp2f(P0[r]); }while(0)
  #define RESC() do{ if(!FIXREF&&resc){ asm volatile("s_waitcnt lgkmcnt(0)":::"memory"); \
      _Pragma("unroll") for(int d_=0;d_<2;++d_) _Pragma("unroll") for(int r=0;r<16;++r)o[d_][r]*=wsf[crow(r,hi)]; } }while(0)
  f32x16 pA0,pA1,pB0,pB1;
  int sl_prev=0,sl_cur=0,sl_next=SLOTB;
  #define ROT() do{sl_prev=sl_cur;sl_cur=sl_next;sl_next=(sl_next==(NSLOT-1)*SLOTB)?0:sl_next+SLOTB;}while(0)
  DMA_K(2,2*SLOTB);
  WAIT_BAR(3);
  qkt(pA0,pA1,Kbase,qr,negm,r32,hi);asm volatile("s_nop 15\n\ts_nop 7":"+v"(pA0),"+v"(pA1));CMASK(pA0,pA1,0);
  START(pA0,pA1);
  _Pragma("unroll") for(int r=0;r<16;++r)pA1[r]=__builtin_amdgcn_exp2f(pA1[r]);
  WAIT_BAR(0);
  DMA_K(3,0);DMA_V(1,SLOTB);
  ROT();
  kload8(kf,kp0+sl_cur);
  WAIT_BAR(2);
  s16x4 vlo[8],vhi[8]; u32x4 pw0,pw1,pw2,pw3;
  #define PKW(P,B) cvtpk_s(P[B],P[B+1])
  #define PAF(k) __builtin_bit_cast(bf16x8,pw##k)
  #define VFR(i) (bf16x8){vlo[i][0],vlo[i][1],vlo[i][2],vlo[i][3],vhi[i][0],vhi[i][1],vhi[i][2],vhi[i][3]}
  #define PIN(x) asm volatile("":"+v"(x))
  #define MX3(a,b,c) __builtin_fmaxf(__builtin_fmaxf((a),(b)),(c))
  #define GAPA(MF,A0,A1,A2,A3,W0,W1,PW) do{ MF; sacc+=A0; sacc+=A1; sacc+=A2; sacc+=A3; PIN(sacc); W0; W1; PIN(PW); SBAR(); }while(0)
  #define EX(v) __builtin_amdgcn_exp2f(v)
  #define GAPB(MF,X,B) do{ MF; X[B]=EX(X[B]); X[B+1]=EX(X[B+1]); X[B+2]=EX(X[B+2]); X[B+3]=EX(X[B+3]); PIN(X); SBAR(); }while(0)
  #define VRD(i) do{ vlo[i]=vtr(vp_+(((i)>>2)*4096+((i)&3)*1024)); vhi[i]=vtr(vp_+(((i)>>2)*4096+((i)&3)*1024+512)); }while(0)
  #define KRD(G,j) do{ if(G){ kload2(kf,kp0+sl_next,j); SBAR(); } }while(0)
  #define STEP(C0,C1,P0,P1,t,GK,GV,GL) do{ SBAR(); \
    const lds_cptr vp_=vp0+sl_prev; \
    VRD(0); SBAR(); float sacc=(P0[0]+P0[1]); \
    GAPA(C0=__builtin_amdgcn_mfma_f32_32x32x16_bf16(kf[0],qr[0],negm,0,0,0), P0[2],P0[3],P0[4],P0[5],     pw0[0]=PKW(P0,0), pw0[1]=PKW(P0,2), pw0); \
    VRD(4); SBAR(); GAPA(C1=__builtin_amdgcn_mfma_f32_32x32x16_bf16(kf[1],qr[0],negm,0,0,0), P0[6],P0[7],P0[8],P0[9],     pw0[2]=PKW(P0,4), pw0[3]=PKW(P0,6), pw0); \
    VRD(1); SBAR(); GAPA(C0=__builtin_amdgcn_mfma_f32_32x32x16_bf16(kf[2],qr[1],C0,0,0,0),   P0[10],P0[11],P0[12],P0[13], pw1[0]=PKW(P0,8), pw1[1]=PKW(P0,10), pw1); \
    VRD(5); SBAR(); GAPA(C1=__builtin_amdgcn_mfma_f32_32x32x16_bf16(kf[3],qr[1],C1,0,0,0),   P0[14],P0[15],P1[0],P1[1],   pw1[2]=PKW(P0,12),pw1[3]=PKW(P0,14), pw1); \
    VRD(2); SBAR(); GAPA(C0=__builtin_amdgcn_mfma_f32_32x32x16_bf16(kf[4],qr[2],C0,0,0,0),   P1[2],P1[3],P1[4],P1[5],     pw2[0]=PKW(P1,0), pw2[1]=PKW(P1,2), pw2); \
    VRD(6); SBAR(); GAPA(C1=__builtin_amdgcn_mfma_f32_32x32x16_bf16(kf[5],qr[2],C1,0,0,0),   P1[6],P1[7],P1[8],P1[9],     pw2[2]=PKW(P1,4), pw2[3]=PKW(P1,6), pw2); \
    VRD(3); SBAR(); GAPA(C0=__builtin_amdgcn_mfma_f32_32x32x16_bf16(kf[6],qr[3],C0,0,0,0),   P1[10],P1[11],P1[12],P1[13], pw3[0]=PKW(P1,8), pw3[1]=PKW(P1,10), pw3); \
    VRD(7); SBAR(); GAPA(C1=__builtin_amdgcn_mfma_f32_32x32x16_bf16(kf[7],qr[3],C1,0,0,0),   P1[14],P1[15],0.f,0.f,       pw3[2]=PKW(P1,12),pw3[3]=PKW(P1,14), pw3); \
    l_reg+=sacc; \
    if(GK){DMA_K((t)+3,sl_cur);} if(GV){DMA_V((t)+1,sl_next);} \
    CMASK(C0,C1,t); \
    if constexpr(!FIXREF){ float a=MX3(C0[0],C0[1],C1[0]),b=MX3(C0[2],C0[3],C1[1]); a=MX3(a,C1[2],C1[3]); \
      _Pragma("unroll") for(int r=4;r<16;r+=4){a=MX3(a,C0[r],C0[r+1]);b=MX3(b,C0[r+2],C0[r+3]);a=MX3(a,C1[r],C1[r+1]);b=MX3(b,C1[r+2],C1[r+3]);} \
      float rm=__builtin_fmaxf(a,b); { auto rr=__builtin_amdgcn_permlane32_swap(__float_as_uint(rm),__float_as_uint(rm),false,false); rm=__builtin_fmaxf(__uint_as_float(rr[0]),__uint_as_float(rr[1])); } \
      resc=false; \
      if(__builtin_expect(__any(rm>(float)THRL),0)){ const float dl=__builtin_fmaxf(rm,0.f); mhat+=dl; \
        _Pragma("unroll") for(int r=0;r<16;++r){C0[r]-=dl;C1[r]-=dl;} \
        _Pragma("unroll") for(int r=0;r<16;++r)negm[r]=-mhat; asm volatile("":"+v"(negm)); \
        const float f=__builtin_amdgcn_exp2f(-dl); l_reg*=f; if(hi==0)wsf[r32]=f; resc=true; } } \
    SBAR(); \
      \
    o[0]=__builtin_amdgcn_mfma_f32_32x32x16_bf16(PAF(0),VFR(0),o[0],0,0,0); C0[0]=EX(C0[0]); C0[1]=EX(C0[1]); C0[2]=EX(C0[2]); C0[3]=EX(C0[3]); C0[4]=EX(C0[4]); PIN(C0); PIN(C1); SBAR(); \
    o[1]=__builtin_amdgcn_mfma_f32_32x32x16_bf16(PAF(0),VFR(4),o[1],0,0,0); C0[5]=EX(C0[5]); C0[6]=EX(C0[6]); C0[7]=EX(C0[7]); C0[8]=EX(C0[8]); C0[9]=EX(C0[9]); PIN(C0); PIN(C1); SBAR(); \
    KRD(GL,0); o[0]=__builtin_amdgcn_mfma_f32_32x32x16_bf16(PAF(1),VFR(1),o[0],0,0,0); C0[10]=EX(C0[10]); C0[11]=EX(C0[11]); C0[12]=EX(C0[12]); PIN(C0); PIN(C1); SBAR(); \
    KRD(GL,1); o[1]=__builtin_amdgcn_mfma_f32_32x32x16_bf16(PAF(1),VFR(5),o[1],0,0,0); C0[13]=EX(C0[13]); C0[14]=EX(C0[14]); C0[15]=EX(C0[15]); PIN(C0); PIN(C1); SBAR(); \
    KRD(GL,2); o[0]=__builtin_amdgcn_mfma_f32_32x32x16_bf16(PAF(2),VFR(2),o[0],0,0,0); C1[0]=EX(C1[0]); C1[1]=EX(C1[1]); C1[2]=EX(C1[2]); PIN(C0); PIN(C1); SBAR(); \
    KRD(GL,3); o[1]=__builtin_amdgcn_mfma_f32_32x32x16_bf16(PAF(2),VFR(6),o[1],0,0,0); C1[3]=EX(C1[3]); C1[4]=EX(C1[4]); C1[5]=EX(C1[5]); PIN(C0); PIN(C1); SBAR(); \
    o[0]=__builtin_amdgcn_mfma_f32_32x32x16_bf16(PAF(3),VFR(3),o[0],0,0,0); C1[6]=EX(C1[6]); C1[7]=EX(C1[7]); C1[8]=EX(C1[8]); C1[9]=EX(C1[9]); C1[10]=EX(C1[10]); PIN(C0); PIN(C1); SBAR(); \
    o[1]=__builtin_amdgcn_mfma_f32_32x32x16_bf16(PAF(3),VFR(7),o[1],0,0,0); C1[11]=EX(C1[11]); C1[12]=EX(C1[12]); C1[13]=EX(C1[13]); C1[14]=EX(C1[14]); C1[15]=EX(C1[15]); PIN(C0); PIN(C1); SBAR(); \
    }while(0)
  int t=1;
  for(;t+5<NT;t+=2){
    STEP(pB0,pB1,pA0,pA1,t,true,true,true);     WAIT_BAR(2); RESC(); ROT();
    STEP(pA0,pA1,pB0,pB1,t+1,true,true,true);   WAIT_BAR(2); RESC(); ROT();
  }
  #define ENDW(tt) do{ if((tt)+3<NT){WAIT_BAR(2);} else if((tt)+2<NT){WAIT_BAR(1);} else {WAIT_BAR(0);} }while(0)
  for(;t+1<NT;t+=2){
    STEP(pB0,pB1,pA0,pA1,t,(t+3<NT),(t+1<NT),(t+1<NT));       ENDW(t);   RESC(); ROT();
    STEP(pA0,pA1,pB0,pB1,t+1,(t+4<NT),(t+2<NT),(t+2<NT));     ENDW(t+1); RESC(); ROT();
  }
  STEP(pB0,pB1,pA0,pA1,NT-1,false,false,false); RESC();
  { float sacc=pB0[0]+pB0[1]; _Pragma("unroll") for(int r=2;r<16;++r)sacc+=pB0[r]; _Pragma("unroll") for(int r=0;r<16;++r)sacc+=pB1[r]; l_reg+=sacc;
    pw0=(u32x4){PKW(pB0,0),PKW(pB0,2),PKW(pB0,4),PKW(pB0,6)};pw1=(u32x4){PKW(pB0,8),PKW(pB0,10),PKW(pB0,12),PKW(pB0,14)};pw2=(u32x4){PKW(pB1,0),PKW(pB1,2),PKW(pB1,4),PKW(pB1,6)};pw3=(u32x4){PKW(pB1,8),PKW(pB1,10),PKW(pB1,12),PKW(pB1,14)};
    SBAR(); pv(o,vb0+sl_cur,PAF(0),PAF(1),PAF(2),PAF(3)); }
  #undef PKW
  #undef PAF
  #undef VFR
  #undef PIN
  #undef MX3
  #undef GAPA
  #undef GAPB
  #undef EX
  #undef VRD
  #undef KRD
  #undef STEP
  #undef ENDW
  {auto rr=__builtin_amdgcn_permlane32_swap(__float_as_uint(l_reg),__float_as_uint(l_reg),false,false);l_reg=__uint_as_float(rr[0])+__uint_as_float(rr[1]);}
  if(WINDOW)l_reg+=__builtin_amdgcn_exp2f(sinkl2-mhat);
  if(hi==0)wsf[32+r32]=l_reg;asm volatile("s_waitcnt lgkmcnt(0)":::"memory");
  float rli[16];
  #pragma unroll
  for(int r=0;r<16;++r)rli[r]=__builtin_amdgcn_rcpf(wsf[32+crow(r,hi)]);
  bf16*Ow=O+((long)u.qrow0+wid*QBLK)*DM+u.h*D;
  { bf16*stg=(bf16*)(shm+LDS_OST)+wid*2048;
    #pragma unroll
    for(int r=0;r<16;++r){const int orow=crow(r,hi);
      #pragma unroll
      for(int d0=0;d0<2;++d0)stg[orow*64+d0*32+r32]=__float2bfloat16(o[d0][r]*rli[r]);}
    asm volatile("s_waitcnt lgkmcnt(0)":::"memory");
    #pragma unroll
    for(int i=0;i<4;++i){const int row=i*8+(lane>>3),ch=lane&7; const u32x4 v=*(const u32x4*)(stg+row*64+ch*8); ATTN_STORE16(Ow+(long)row*DM+ch*8,v);} }
  asm volatile("s_waitcnt lgkmcnt(0)\n\ts_barrier":::"memory");
  #undef DMA_K
  #undef TROW
  #undef DMA_V
  #undef CMASK
  #undef START
  #undef RESC
  #undef ROT
}
constexpr int ATTN_LDS_BYTES=LDS_BYTES;
#undef SBAR
#undef WAIT_BAR
}

template <bool WINDOW>
__device__ __forceinline__ void phase_attn(const Params& P, int layer, char* lds) {
    unsigned char* const ws = ows(P);
    const attn_body::bf16* Q = (const attn_body::bf16*)(ws + WS_Q); const attn_body::bf16* Kb = (const attn_body::bf16*)(ws + WS_K); const attn_body::bf16* Vb = (const attn_body::bf16*)(ws + WS_V);
    attn_body::bf16* O = (attn_body::bf16*)(ws + WS_O);
    const float* sinkp = P.attn_sink + (layer >> 1) * NQH;
    float mfix = 0.f; bool fix = false;
    if (!WINDOW) { const int lane = otid() & 63; float gq = fabsf(P.q_norm_g[(layer >> 1) * 64 + lane]), gk = fabsf(P.k_norm_g[(layer >> 1) * 64 + lane]);
#pragma unroll
        for (int o = 1; o < 64; o <<= 1) { gq = fmaxf(gq, __shfl_xor(gq, o)); gk = fmaxf(gk, __shfl_xor(gk, o)); }
        mfix = __builtin_amdgcn_readfirstlane(8.f * LOG2E * 1.01f * gq * gk + 0.05f); fix = mfix < 40.f; }
    for (int v = blockIdx.x; v < 256; v += gridDim.x) {
        const int xcd = v & 7, cu = v >> 3; const int b = xcd >> 2, kvh = xcd & 3;
        for (int i = 0; i < 9; ++i) {
            attn_body::AttnUnit u; u.kvrow0 = b * RB; u.lo = 0; u.t0 = 0; u.kt0 = (b * 4 + kvh) * 260;
            if (i < 8) { const int n = i * 32 + cu; u.h = kvh * 4 + (n >> 6); const int qb = n & 63; u.t0 = qb * 256; u.qrow0 = b * RB + CTXL + u.t0;
                if (WINDOW) { int lo = u.t0 - 128; if (lo < 0) lo = 0; int hi = u.t0 + 384; if (hi > SEQ) hi = SEQ; u.lo = lo; u.nt = 4 + (hi - lo) / 64; } else u.nt = RB / 64; }
            else { if (cu >= 4 || layer == DEPTH - 1) break; u.h = kvh * 4 + cu; u.qrow0 = b * RB; u.nt = 4; }
            const float sk = WINDOW ? sinkp[u.h] * LOG2E : 0.f;
            if (WINDOW) attn_body::attn_unit<8, true, false>(u, Q, Kb, Vb, O, lds, sk, 0.f);
            else if (fix) attn_body::attn_unit<8, false, true>(u, Q, Kb, Vb, O, lds, 0.f, mfix);
            else attn_body::attn_unit<8, false, false>(u, Q, Kb, Vb, O, lds, 0.f, 0.f);
        }
    }
}

__device__ __forceinline__ int block_excl_scan(int v, LAS int* sm, int& total) {
    const int tid = otid(), lane = tid & 63, wave = tid >> 6;
    int inc = v;
#pragma unroll
    for (int o = 1; o < 64; o <<= 1) { const int t = __shfl_up(inc, o); if (lane >= o) inc += t; }
    __syncthreads();
    if (lane == 63) sm[wave] = inc;
    __syncthreads();
    int base = 0, tot = 0;
#pragma unroll
    for (int w = 0; w < 8; ++w) { const int s = sm[w]; if (w < wave) base += s; tot += s; }
    total = tot;
    return base + inc - v;
}
__device__ __forceinline__ void phase_select(const Params& P, LAS unsigned char* lds, bool last) {
    unsigned char* const ws = ows(P);
    const int tid = otid();
    LAS int* hist = (LAS int*)lds;
    LAS int* tot = hist + 32 * 257;
    LAS int* sm = tot + 256;
    LAS unsigned* bc = (LAS unsigned*)(sm + 16);
    const float* AFFL = (const float*)(ws + WS_AFF); const float* AFFC = AFFL + (size_t)NB * NE * SEQ;
    int* SELI = (int*)(ws + WS_SELI); float* SELG = (float*)(ws + WS_SELG); int* INVT = (int*)(ws + WS_INVT);
    for (int pid = blockIdx.x; pid < (last ? 32 : 64); pid += gridDim.x) {
        const bool isctx = pid >= 32; const int be = pid & 31, b = be >> 4, e = be & 15;
        const int n = isctx ? CTXL : SEQ, kcap = isctx ? CAP_C : CAP_L;
        const float* aff = isctx ? AFFC + (size_t)be * CTXL : AFFL + (size_t)be * SEQ;
        const int cnt = isctx ? (tid < CTXL ? 1 : 0) : 32; const int i0 = isctx ? tid : tid * 32;
        unsigned key[32];
        if (isctx) { key[0] = cnt ? __builtin_bit_cast(unsigned, aff[i0]) : 0u;
#pragma unroll
            for (int i = 1; i < 32; ++i) key[i] = 0u; }
        else {
#pragma unroll
            for (int i = 0; i < 32; i += 4) { const u32x4 t = *(const u32x4*)(aff + i0 + i); key[i] = t.x; key[i + 1] = t.y; key[i + 2] = t.z; key[i + 3] = t.w; } }
        unsigned prefix = 0u, mask = 0u; int krem = kcap;
        for (int pass = 0; pass < 4; ++pass) {
            const int shift = 24 - 8 * pass;
            __syncthreads();
            for (int i = tid; i < 32 * 257; i += NT) hist[i] = 0;
            __syncthreads();
            LAS int* myh = hist + (tid & 31) * 257;
#pragma unroll
            for (int i = 0; i < 32; ++i) if (i < cnt && (key[i] & mask) == prefix) __hip_atomic_fetch_add(&myh[(key[i] >> shift) & 255u], 1, __ATOMIC_RELAXED, __HIP_MEMORY_SCOPE_WORKGROUP);
            __syncthreads();
            if (tid < 256) { int s = 0;
#pragma unroll 8
                for (int c = 0; c < 32; ++c) s += hist[c * 257 + tid];
                tot[tid] = s; }
            __syncthreads();
            if (tid < 64) {
                int c[4]; int s = 0;
#pragma unroll
                for (int j = 0; j < 4; ++j) { c[j] = tot[255 - (4 * tid + j)]; s += c[j]; }
                int inc = s;
#pragma unroll
                for (int o = 1; o < 64; o <<= 1) { const int t = __shfl_up(inc, o); if (tid >= o) inc += t; }
                int above = inc - s;
                if (above < krem && inc >= krem) { int d = 255 - 4 * tid;
#pragma unroll
                    for (int j = 0; j < 3; ++j) if (above + c[j] < krem) { above += c[j]; --d; } else break;
                    bc[0] = prefix | ((unsigned)d << shift); bc[1] = (unsigned)(krem - above); }
            }
            __syncthreads();
            prefix = bc[0]; krem = (int)bc[1]; mask |= 255u << shift;
        }
        const unsigned T = prefix;
        int ceq = 0;
#pragma unroll
        for (int i = 0; i < 32; ++i) if (i < cnt && key[i] == T) ++ceq;
        int tot; const int eqb = block_excl_scan(ceq, sm, tot);
        unsigned selm = 0u; int csel = 0, er = eqb;
#pragma unroll
        for (int i = 0; i < 32; ++i) if (i < cnt) { bool s = key[i] > T; if (key[i] == T) { s = er < krem; ++er; } if (s) { selm |= 1u << i; ++csel; } }
        int tots; int pos = block_excl_scan(csel, sm, tots);
        const int sbase = isctx ? NSLOT_L + e * 256 + b * CAP_C : (b * NE + e) * CAP_L;
        const int rbase = b * RB + (isctx ? 0 : CTXL);
        int invv[32];
#pragma unroll
        for (int i = 0; i < 32; ++i) { invv[i] = -1; if (i < cnt) { const int r = rbase + i0 + i;
            if ((selm >> i) & 1u) { const int inv = sbase + pos; invv[i] = inv; SELI[inv] = r; SELG[inv] = __builtin_bit_cast(float, key[i]); ++pos; } } }
        if (isctx) { if (cnt) INVT[(size_t)e * R + rbase + i0] = invv[0]; }
        else { typedef int i32x4 __attribute__((ext_vector_type(4))); i32x4* dst = (i32x4*)(INVT + (size_t)e * R + rbase + i0);
#pragma unroll
            for (int i = 0; i < 8; ++i) dst[i] = (i32x4){invv[4 * i], invv[4 * i + 1], invv[4 * i + 2], invv[4 * i + 3]}; }
        if (isctx && b == 0 && tid < 192) { SELI[NSLOT_L + e * 256 + 64 + tid] = 0; SELG[NSLOT_L + e * 256 + 64 + tid] = 0.f; }
    }
}


__device__ __forceinline__ float reduce16(float (&v)[16], int lane) {
#pragma unroll
    for (int i = 0; i < 8; ++i) { const bool up = lane & 1; const float keep = up ? v[i + 8] : v[i], send = up ? v[i] : v[i + 8]; v[i] = keep + __shfl_xor(send, 1); }
#pragma unroll
    for (int i = 0; i < 4; ++i) { const bool up = lane & 2; const float keep = up ? v[i + 4] : v[i], send = up ? v[i] : v[i + 4]; v[i] = keep + __shfl_xor(send, 2); }
#pragma unroll
    for (int i = 0; i < 2; ++i) { const bool up = lane & 4; const float keep = up ? v[i + 2] : v[i], send = up ? v[i] : v[i + 2]; v[i] = keep + __shfl_xor(send, 4); }
    { const bool up = lane & 8; const float keep = up ? v[1] : v[0], send = up ? v[0] : v[1]; v[0] = keep + __shfl_xor(send, 8); }
    v[0] += __shfl_xor(v[0], 16); v[0] += __shfl_xor(v[0], 32);
    return v[0];
}
__device__ __forceinline__ float softmax16(float s) {
    float mx = s;
#pragma unroll
    for (int o = 1; o < 16; o <<= 1) mx = fmaxf(mx, __shfl_xor(mx, o));
    const float ex = expf(s - mx); float den = ex;
#pragma unroll
    for (int o = 1; o < 16; o <<= 1) den += __shfl_xor(den, o);
    return ex / den;
}
__device__ __forceinline__ void phase_norm2_router(const Params& P, int layer, LAS unsigned char* lds) {
    unsigned char* const ws = ows(P);
    const int tid = otid(), lane = tid & 63, wave = tid >> 6;
    const int gw = blockIdx.x * 8 + wave, NGW = gridDim.x * 8;
    LAS float* wT = (LAS float*)lds;
    { const f32x4* wr4 = (const f32x4*)(P.w_router + (size_t)layer * D * NE);
      for (int i = tid; i < D * NE / 4; i += NT) { const f32x4 w = wr4[i]; const int k = i >> 2, e0 = (i & 3) * 4; wT[(e0 + 0) * 1024 + k] = w.x; wT[(e0 + 1) * 1024 + k] = w.y; wT[(e0 + 2) * 1024 + k] = w.z; wT[(e0 + 3) * 1024 + k] = w.w; } }
    __syncthreads();
    bf16_t* XR = (bf16_t*)(ws + WS_XR); bf16_t* H = (bf16_t*)(ws + WS_H);
    const float* MOD = (const float*)(ws + WS_MOD) + (size_t)layer * 3 * 6144;
    const float* gain = P.norm_ffn_g + (size_t)layer * D;
    const float* OPART = (const float*)(ws + WS_XSEL);
    float* AFFL = (float*)(ws + WS_AFF); float* AFFC = AFFL + (size_t)NB * NE * SEQ;
    const int erev = ((lane & 1) << 3) | ((lane & 2) << 1) | ((lane & 4) >> 1) | ((lane & 8) >> 3);
    for (int pr = gw; pr < R / 2; pr += NGW) {
        const int r0 = 2 * pr; const int b = r0 / RB, j = r0 - b * RB; const int mv = j < CTXL ? 2 : b;
        if (layer == DEPTH - 1 && j < CTXL) continue;
        const float* sh = MOD + (size_t)mv * 6144 + 3072; const float* sc = sh + 1024;
        u32x2* xr = (u32x2*)(XR + (size_t)r0 * D) + lane;
        f32x4 v0[4], v1[4]; float ss0 = 0.f, ss1 = 0.f;
#pragma unroll
        for (int q = 0; q < 4; ++q) { const u32x2 a = xr[64 * q], b2 = xr[256 + 64 * q];
            v0[q] = (f32x4){__builtin_bit_cast(float, a.x << 16), __builtin_bit_cast(float, a.x & 0xffff0000u), __builtin_bit_cast(float, a.y << 16), __builtin_bit_cast(float, a.y & 0xffff0000u)};
            v1[q] = (f32x4){__builtin_bit_cast(float, b2.x << 16), __builtin_bit_cast(float, b2.x & 0xffff0000u), __builtin_bit_cast(float, b2.y << 16), __builtin_bit_cast(float, b2.y & 0xffff0000u)}; }
        if (j < CTXL) {
#pragma unroll
            for (int p = 0; p < 3; ++p) { const f32x4* pp = (const f32x4*)(OPART + ((size_t)p * 512 + (size_t)b * CTXL + j) * D) + lane;
#pragma unroll
                for (int q = 0; q < 4; ++q) { v0[q] += pp[64 * q]; v1[q] += pp[256 + 64 * q]; } }
#pragma unroll
            for (int q = 0; q < 4; ++q) { xr[64 * q] = (u32x2){pk2(v0[q].x, v0[q].y), pk2(v0[q].z, v0[q].w)}; xr[256 + 64 * q] = (u32x2){pk2(v1[q].x, v1[q].y), pk2(v1[q].z, v1[q].w)}; } }
#pragma unroll
        for (int q = 0; q < 4; ++q) { ss0 += (v0[q].x * v0[q].x + v0[q].y * v0[q].y) + (v0[q].z * v0[q].z + v0[q].w * v0[q].w); ss1 += (v1[q].x * v1[q].x + v1[q].y * v1[q].y) + (v1[q].z * v1[q].z + v1[q].w * v1[q].w); }
        const float rstd0 = 1.0f / sqrtf(wave_sum(ss0) * (1.f / D) + EPS), rstd1 = 1.0f / sqrtf(wave_sum(ss1) * (1.f / D) + EPS);
        unsigned long long* o8 = (unsigned long long*)(H + (size_t)r0 * D) + lane;
#pragma unroll
        for (int q = 0; q < 4; ++q) {
            const int c0 = 4 * lane + 256 * q;
            const f32x4 g4 = *(const f32x4*)(gain + c0), sc4 = *(const f32x4*)(sc + c0), sh4 = *(const f32x4*)(sh + c0);
            const f32x4 gm = g4 * (sc4 + 1.f);
            v0[q] = v0[q] * rstd0 * gm + sh4; v1[q] = v1[q] * rstd1 * gm + sh4;
            o8[64 * q] = (unsigned long long)pk2(v0[q].x, v0[q].y) | ((unsigned long long)pk2(v0[q].z, v0[q].w) << 32);
            o8[256 + 64 * q] = (unsigned long long)pk2(v1[q].x, v1[q].y) | ((unsigned long long)pk2(v1[q].z, v1[q].w) << 32);
        }
        float a0[16], a1[16];
#pragma unroll
        for (int e = 0; e < 16; ++e) {
            float s0 = 0.f, s1 = 0.f;
#pragma unroll
            for (int q = 0; q < 4; ++q) { const f32x4 w = *(const LAS f32x4*)(wT + e * 1024 + 4 * lane + 256 * q);
                s0 += (v0[q].x * w.x + v0[q].y * w.y) + (v0[q].z * w.z + v0[q].w * w.w); s1 += (v1[q].x * w.x + v1[q].y * w.y) + (v1[q].z * w.z + v1[q].w * w.w); }
            a0[e] = s0; a1[e] = s1;
            if (e & 1) asm volatile("" ::: "memory");
        }
        const float p0 = softmax16(reduce16(a0, lane)), p1 = softmax16(reduce16(a1, lane));
        if (lane < 16) { typedef float f32x2 __attribute__((ext_vector_type(2)));
            float* dst = j < CTXL ? AFFC + ((size_t)b * NE + erev) * CTXL + j : AFFL + ((size_t)b * NE + erev) * SEQ + (j - CTXL);
            *(f32x2*)dst = (f32x2){p0, p1}; }
    }
}

template <bool LAST>
__device__ __forceinline__ void phase_combine_norm(const Params& P, int layer) {
    unsigned char* const ws = ows(P);
    const int tid = otid(), lane = tid & 63, wave = tid >> 6; const int gw = blockIdx.x * 8 + wave, NGW = gridDim.x * 8;
    bf16_t* XR = (bf16_t*)(ws + WS_XR); const bf16_t* Y = (const bf16_t*)(ws + WS_Y); const int* INVT = (const int*)(ws + WS_INVT); bf16_t* H = (bf16_t*)(ws + WS_H);
    const float* MOD = (const float*)(ws + WS_MOD) + (size_t)layer * 3 * 6144;
    const float* gain = LAST ? P.final_norm_g : P.norm_mix_g + (size_t)(layer + 1) * D;
    int sv = (gw < R && lane < 16) ? INVT[(size_t)lane * R + gw] : -1;
    for (int r = gw; r < R; r += NGW) {
        const int b = r / RB, j = r - b * RB; const int mv = j < CTXL ? 2 : b;
        const int svc = sv; sv = (r + NGW < R && lane < 16) ? INVT[(size_t)lane * R + r + NGW] : -1;
        if (LAST && j < CTXL) continue;
        u32x2* xr = (u32x2*)(XR + (size_t)r * D) + lane;
        f32x4 x[4], acc[4];
#pragma unroll
        for (int q = 0; q < 4; ++q) { const u32x2 a = xr[64 * q]; x[q] = (f32x4){__builtin_bit_cast(float, a.x << 16), __builtin_bit_cast(float, a.x & 0xffff0000u), __builtin_bit_cast(float, a.y << 16), __builtin_bit_cast(float, a.y & 0xffff0000u)}; acc[q] = (f32x4){0.f, 0.f, 0.f, 0.f}; }
#pragma unroll
        for (int e = 0; e < NE; ++e) { const int s = __builtin_amdgcn_readlane(svc, e);
            if (s >= 0) {
                if (!LAST && s >= NSLOT_L) {
#pragma unroll
                    for (int p = 0; p < 4; ++p) { const u32x2* y = (const u32x2*)(Y + (size_t)(pg8::YP_ROW0 + 4096 * p + (s - NSLOT_L)) * D) + lane;
#pragma unroll
                        for (int q = 0; q < 4; ++q) { const u32x2 w = y[64 * q]; acc[q] += (f32x4){__builtin_bit_cast(float, w.x << 16), __builtin_bit_cast(float, w.x & 0xffff0000u), __builtin_bit_cast(float, w.y << 16), __builtin_bit_cast(float, w.y & 0xffff0000u)}; } } }
                else { const u32x2* y = (const u32x2*)(Y + (size_t)s * D) + lane;
#pragma unroll
                    for (int q = 0; q < 4; ++q) { const u32x2 w = y[64 * q]; acc[q] += (f32x4){__builtin_bit_cast(float, w.x << 16), __builtin_bit_cast(float, w.x & 0xffff0000u), __builtin_bit_cast(float, w.y << 16), __builtin_bit_cast(float, w.y & 0xffff0000u)}; } } } }
        const float* g2 = MOD + (size_t)mv * 6144 + 5120;
        float ss = 0.f;
#pragma unroll
        for (int q = 0; q < 4; ++q) { const f32x4 g4 = *(const f32x4*)(g2 + 4 * lane + 256 * q); x[q] = x[q] + g4 * acc[q]; if (!LAST) xr[64 * q] = (u32x2){pk2(x[q].x, x[q].y), pk2(x[q].z, x[q].w)};
            ss += (x[q].x * x[q].x + x[q].y * x[q].y) + (x[q].z * x[q].z + x[q].w * x[q].w); }
        const float rstd = 1.0f / sqrtf(wave_sum(ss) * (1.f / D) + EPS);
        if (LAST) { f32x4* o = (f32x4*)(P.out + ((size_t)b * SEQ + (j - CTXL)) * D) + lane;
#pragma unroll
            for (int q = 0; q < 4; ++q) { const f32x4 g4 = *(const f32x4*)(gain + 4 * lane + 256 * q); o[64 * q] = x[q] * rstd * g4; } }
        else { const float* sh = MOD + 3 * 6144 + (size_t)mv * 6144; const float* sc = sh + 1024;
            unsigned long long* o8 = (unsigned long long*)(H + (size_t)r * D) + lane;
#pragma unroll
            for (int q = 0; q < 4; ++q) { const int c0 = 4 * lane + 256 * q; const f32x4 g4 = *(const f32x4*)(gain + c0), sc4 = *(const f32x4*)(sc + c0), sh4 = *(const f32x4*)(sh + c0);
                const f32x4 h = x[q] * rstd * g4 * (sc4 + 1.f) + sh4;
                o8[64 * q] = (unsigned long long)pk2(h.x, h.y) | ((unsigned long long)pk2(h.z, h.w) << 32); } }
    }
}

#define XB_TMO      128
#define XB_XCNT(j)  (256  + 64 * (j))
#define XB_XSUB(j)  (1280 + 64 * (j))
#define XB_XGEN(j)  (2304 + 64 * (j))
#define XB_TOP      3328
#define XB_TOPGEN   3392
#define XCD_BAR_WORDS 3456
#define XB_SPIN_CAP (1u << 18)

__device__ __forceinline__ unsigned xb_ld(unsigned* p)              { return __hip_atomic_load(p, __ATOMIC_RELAXED, __HIP_MEMORY_SCOPE_AGENT); }
__device__ __forceinline__ unsigned xb_add(unsigned* p, unsigned v) { return __hip_atomic_fetch_add(p, v, __ATOMIC_RELAXED, __HIP_MEMORY_SCOPE_AGENT); }
__device__ __forceinline__ unsigned xb_xcc_id() { return (unsigned)__builtin_amdgcn_s_getreg((3 << 11) | 20) & 0xFu; }
#define XB_SPIN(cond, bar) do { unsigned _sp = 0; while (cond) { __builtin_amdgcn_s_sleep(1); \
    if ((++_sp & 255u) == 0u) { if (xb_ld(&(bar)[XB_TMO])) break; if (_sp > XB_SPIN_CAP) { atomicAdd(&(bar)[XB_TMO], 1u); break; } } } } while (0)

struct XcdBarrier {
    unsigned* bar; unsigned x;
    volatile LAS unsigned* st;
};

__device__ __forceinline__ XcdBarrier xcd_barrier_post(unsigned* bar, volatile LAS unsigned* st) {
    XcdBarrier b; b.bar = bar; b.x = xb_xcc_id(); b.st = st;
    if (threadIdx.x == 0) (void)xb_add(&bar[XB_XCNT(b.x)], 1u);
    return b;
}
__device__ __forceinline__ void xcd_barrier_complete(unsigned* bar, unsigned x, unsigned& nloc, unsigned& nx) {
    const unsigned G = gridDim.x * gridDim.y * gridDim.z;
    unsigned sum, cnt, mine, sp = 0u;
    for (;;) {
        sum = 0u; cnt = 0u; mine = 0u;
#pragma unroll
        for (unsigned j = 0; j < 16; ++j) { const unsigned c = xb_ld(&bar[XB_XCNT(j)]); sum += c; cnt += (c > 0u) ? 1u : 0u; mine = (j == x) ? c : mine; }
        if (sum == G) break;
        __builtin_amdgcn_s_sleep(1);
        if ((++sp & 255u) == 0u) { if (xb_ld(&bar[XB_TMO])) break; if (sp > XB_SPIN_CAP) { atomicAdd(&bar[XB_TMO], 1u); break; } }
    }
    nloc = mine > 0u ? mine : 1u; nx = cnt > 0u ? cnt : 1u;
}

__device__ __forceinline__ void xcd_barrier(const XcdBarrier& b) {
    asm volatile("s_waitcnt vmcnt(0)" ::: "memory");
    __syncthreads();
    if (threadIdx.x == 0) {
        unsigned* bar = b.bar; unsigned bx_ = b.x;
        asm volatile("" : "+s"(bar), "+s"(bx_));
        __builtin_amdgcn_s_waitcnt(0);
        unsigned nloc = b.st[0], nx = b.st[1];
        if (nloc == 0u) { xcd_barrier_complete(bar, bx_, nloc, nx); b.st[0] = nloc; b.st[1] = nx; }
        const unsigned old = xb_add(&bar[XB_XSUB(bx_)], 1u);
        const unsigned gen = old / nloc;
        if (old + 1u == (gen + 1u) * nloc) {
            __builtin_amdgcn_fence(__ATOMIC_RELEASE, "agent");
            asm volatile("s_waitcnt vmcnt(0)" ::: "memory");
            const unsigned og = xb_add(&bar[XB_TOP], 1u);
            const unsigned tg = og / nx;
            if (og + 1u == (tg + 1u) * nx) xb_add(&bar[XB_TOPGEN], 1u);
            else XB_SPIN(xb_ld(&bar[XB_TOPGEN]) == tg, bar);
            __builtin_amdgcn_fence(__ATOMIC_ACQUIRE, "agent");
            xb_add(&bar[XB_XGEN(bx_)], 1u);
            asm volatile("s_waitcnt vmcnt(0)" ::: "memory");
        } else {
            XB_SPIN(xb_ld(&bar[XB_XGEN(bx_)]) == gen, bar);
            __builtin_amdgcn_fence(__ATOMIC_ACQUIRE, "agent");
            asm volatile("s_waitcnt vmcnt(0)" ::: "memory");
        }
    }
    __syncthreads();
}


constexpr int LDS_RING = 131072;
constexpr int LDS_CTL_OFF = LDS_RING;
constexpr int LDS_BYTES = LDS_RING + 16384;
constexpr int CW_BAR = 4096;
constexpr size_t CTL_ZERO_BYTES = 64 * 1024;

template <int l>
__device__ __forceinline__ void layer_phases(const Params& P, LAS unsigned char* lds, char* lds_raw, const XcdBarrier& bar) {
    constexpr bool last = l == DEPTH - 1;
    phase_qkv(P, l, lds);
    xcd_barrier(bar);
    if (l & 1) phase_attn<true>(P, l, lds_raw); else phase_attn<false>(P, l, lds_raw);
    xcd_barrier(bar);
    phase_oproj(P, l, lds);
    xcd_barrier(bar);
    phase_norm2_router(P, l, lds);
    xcd_barrier(bar);
    phase_select(P, lds, last);
    xcd_barrier(bar);
    phase_gateup(P, l, lds);
    xcd_barrier(bar);
    phase_down(P, l, lds);
    xcd_barrier(bar);
    phase_combine_norm<last>(P, l);
    if (!last) xcd_barrier(bar);
}

__global__ void __launch_bounds__(512, 2) fwd_kernel(Params P) {
    extern __shared__ __attribute__((aligned(16))) unsigned char lds_raw[];
    LAS unsigned char* lds = (LAS unsigned char*)lds_raw;
    volatile LAS unsigned* xbw = (volatile LAS unsigned*)(lds + LDS_CTL_OFF);
    if (threadIdx.x < 4) xbw[threadIdx.x] = 0u;
    __syncthreads();
    XcdBarrier bar = xcd_barrier_post((unsigned*)(P.ws + WS_CTL) + CW_BAR, xbw);

    phase_weights(P, lds);
    __syncthreads();
    phase_mod(P, lds);
    phase_rope_init(P);
    xcd_barrier(bar);
    phase_norm1_l0(P);
    xcd_barrier(bar);
    layer_phases<0>(P, lds, (char*)lds_raw, bar);
    layer_phases<1>(P, lds, (char*)lds_raw, bar);
    layer_phases<2>(P, lds, (char*)lds_raw, bar);
    layer_phases<3>(P, lds, (char*)lds_raw, bar);
}

extern "C" void kernel_launch(void* const* d_in, const int* in_sizes, int n_in, void* d_out, int out_size, void* d_ws, size_t ws_size, hipStream_t stream) {
    static int grid = 0;
    if (grid == 0) {
        if (n_in != 18 || ws_size < WS_END || out_size != NB * SEQ * D) { fprintf(stderr, "kernel_launch: unexpected problem: n_in %d ws %zu (need %zu) out %d; nothing launched\n", n_in, ws_size, (size_t)WS_END, out_size); grid = -1; return; }
        int dev = 0, cus = 0, per_cu = 0;
        if (hipGetDevice(&dev) != hipSuccess || hipDeviceGetAttribute(&cus, hipDeviceAttributeMultiprocessorCount, dev) != hipSuccess) { fprintf(stderr, "kernel_launch: device query failed\n"); grid = -1; return; }
        if (hipFuncSetAttribute((const void*)fwd_kernel, hipFuncAttributeMaxDynamicSharedMemorySize, LDS_BYTES) != hipSuccess) { fprintf(stderr, "kernel_launch: hipFuncSetAttribute failed\n"); grid = -1; return; }
        if (hipOccupancyMaxActiveBlocksPerMultiprocessor(&per_cu, (const void*)fwd_kernel, 512, LDS_BYTES) != hipSuccess || per_cu < 1) { fprintf(stderr, "kernel_launch: occupancy query reports %d workgroups per CU\n", per_cu); }
        (void)hipGetLastError();
        grid = cus;
    }
    if (grid < 0) return;
    Params P{};
    P.x = (const float*)d_in[0]; P.c = (const float*)d_in[1]; P.ctx = (const float*)d_in[2]; P.c_ctx = (const float*)d_in[3]; P.w_mod = (const float*)d_in[4]; P.b_mod = (const float*)d_in[5];
    P.norm_mix_g = (const float*)d_in[6]; P.norm_ffn_g = (const float*)d_in[7]; P.w_qkv = (const float*)d_in[8]; P.w_o = (const float*)d_in[9]; P.q_norm_g = (const float*)d_in[10]; P.k_norm_g = (const float*)d_in[11];
    P.attn_sink = (const float*)d_in[12]; P.w_router = (const float*)d_in[13]; P.w_gate = (const float*)d_in[14]; P.w_up = (const float*)d_in[15]; P.w_down = (const float*)d_in[16]; P.final_norm_g = (const float*)d_in[17];
    P.out = (float*)d_out; P.ws = (unsigned char*)d_ws;
    if (hipMemsetAsync((char*)d_ws + WS_CTL, 0, CTL_ZERO_BYTES, stream) != hipSuccess) { fprintf(stderr, "kernel_launch: memset failed\n"); return; }
    hipLaunchKernelGGL(fwd_kernel, dim3(grid), dim3(512), LDS_BYTES, stream, P);
    const hipError_t le = hipPeekAtLastError();
    if (le != hipSuccess) fprintf(stderr, "kernel_launch: launch failed: %s (grid %d)\n", hipGetErrorName(le), grid);
}
```

```cpp
#include <hip/hip_runtime.h>
#include <hip/hip_bf16.h>
#include <cmath>
#include <cstdio>
#include <cstdint>

#define LAS __attribute__((address_space(3)))
typedef unsigned short bf16_t;
typedef float f32x4 __attribute__((ext_vector_type(4)));
typedef unsigned u32x4 __attribute__((ext_vector_type(4)));
typedef unsigned u32x2 __attribute__((ext_vector_type(2)));

namespace cfg {
constexpr int D = 1024, NB = 2, SEQ = 16384, DEPTH = 4, CTXL = 256, HD = 64, NQH = 16, NKVH = 4, QKVW = 1536;
constexpr int NE = 16, DE = 2048, CAP_L = 2048, CAP_C = 32;
constexpr int RB = CTXL + SEQ;
constexpr int R = NB * RB;
constexpr int NSLOT_L = NB * NE * CAP_L;
constexpr int NSLOT = NSLOT_L + NE * 256;
constexpr float EPS = 1e-6f;
constexpr float C2 = 0.125f * 1.4426950408889634f;
constexpr float LOG2E = 1.4426950408889634f;
constexpr int NT = 512;
}
using namespace cfg;

constexpr size_t MiB = 1u << 20;
constexpr size_t WS_CTL   = 0;
constexpr size_t WS_MOD   = 1 * MiB;
constexpr size_t WS_ROPE  = WS_MOD + 512 * 1024;
constexpr size_t WS_WQKV  = 2 * MiB;
constexpr size_t WS_WO    = WS_WQKV + 12 * MiB;
constexpr size_t WS_WGU   = WS_WO + 8 * MiB;
constexpr size_t WS_WD    = WS_WGU + 512 * MiB;
constexpr size_t WS_XR    = WS_WD + 256 * MiB;
constexpr size_t WS_H     = WS_XR + 130 * MiB;
constexpr size_t WS_Q     = WS_H + 65 * MiB;
constexpr size_t WS_K     = WS_Q + 65 * MiB;
constexpr size_t WS_V     = WS_K + 17 * MiB;
constexpr size_t WS_O     = WS_V + 17 * MiB;
constexpr size_t WS_AFF   = WS_O + 65 * MiB;
constexpr size_t WS_SELI  = WS_AFF + 3 * MiB;
constexpr size_t WS_SELG  = WS_SELI + 512 * 1024;
constexpr size_t WS_INVT  = WS_SELG + 512 * 1024;
constexpr size_t WS_XSEL  = WS_INVT + 3 * MiB;
constexpr size_t WS_ACT   = WS_XSEL + 136 * MiB;
constexpr size_t WS_Y     = WS_ACT + 272 * MiB;
constexpr size_t WS_END   = WS_Y + 272 * MiB;

struct Params {
    const float *x, *c, *ctx, *c_ctx, *w_mod, *b_mod, *norm_mix_g, *norm_ffn_g, *w_qkv, *w_o, *q_norm_g, *k_norm_g, *attn_sink, *w_router, *w_gate, *w_up, *w_down, *final_norm_g;
    float* out; unsigned char* ws;
};

__device__ __forceinline__ unsigned f2bf(float f) { unsigned u = __builtin_bit_cast(unsigned, f); return (u + 0x7fffu + ((u >> 16) & 1u)) >> 16; }
__device__ __forceinline__ unsigned pk2(float lo, float hi) { return f2bf(lo) | (f2bf(hi) << 16); }
__device__ __forceinline__ float bf2f(unsigned short h) { return __builtin_bit_cast(float, (unsigned)h << 16); }
__device__ __forceinline__ float wave_sum(float v) {
#pragma unroll
    for (int o = 1; o < 64; o <<= 1) v += __shfl_xor(v, o);
    return v;
}
__device__ __forceinline__ int otid() { int t = threadIdx.x; asm volatile("" : "+v"(t)); return t; }
__device__ __forceinline__ unsigned char* ows(const Params& P) {
    __attribute__((address_space(1))) unsigned char* g = (__attribute__((address_space(1))) unsigned char*)P.ws; asm volatile("" : "+s"(g)); return (unsigned char*)g; }
__device__ __forceinline__ float silu_f(float v) { return v / (1.f + expf(-v)); }
__device__ __forceinline__ int mod_vec_of_row(int r) { const int b = r / RB, j = r - b * RB; return j < CTXL ? 2 : b; }

__device__ __forceinline__ size_t wtile_off(int n, int k, int K) {
    const int r = n & 127, c = k & 63; const int st = (r >> 4) * 2 + (c >> 5), ob = (r & 15) * 64 + (c & 31) * 2;
    return ((size_t)(n >> 7) * (K >> 6) + (k >> 6)) * 8192 + (size_t)((st * 1024 + (ob ^ (((ob >> 9) & 1) << 5))) >> 1);
}
template <bool KPERM = false, class RowMap>
__device__ __forceinline__ void transpose_item(const float* W, int K, int N, bf16_t* WT, const RowMap& rowmap, int item, int lane, float scale = 1.f) {
    const int nblk = N / 64, kb = item / nblk, nb = item % nblk, k0 = 64 * kb, n = 64 * nb + lane;
    const float* src = W + (size_t)k0 * N + n; const int row = rowmap(n);
#pragma unroll
    for (int half = 0; half < 2; ++half) {
        float v[32];
#pragma unroll
        for (int j = 0; j < 32; ++j) v[j] = src[(size_t)(32 * half + j) * N] * scale;
#pragma unroll
        for (int kc = 0; kc < 4; ++kc) { const int ka = k0 + 32 * half + 8 * kc;
            u32x4 o; o.x = pk2(v[8 * kc], v[8 * kc + 1]); o.y = pk2(v[8 * kc + 2], v[8 * kc + 3]); o.z = pk2(v[8 * kc + 4], v[8 * kc + 5]); o.w = pk2(v[8 * kc + 6], v[8 * kc + 7]);
            if (KPERM) { const int kb_ = ka + 4;
                const int pa = (ka & ~31) + 8 * ((ka >> 2) & 3) + 4 * ((ka >> 4) & 1), pb = (kb_ & ~31) + 8 * ((kb_ >> 2) & 3) + 4 * ((kb_ >> 4) & 1);
                *(u32x2*)(WT + wtile_off(row, pa, K)) = (u32x2){o.x, o.y}; *(u32x2*)(WT + wtile_off(row, pb, K)) = (u32x2){o.z, o.w}; }
            else *(u32x4*)(WT + wtile_off(row, ka, K)) = o; }
    }
}

__device__ __forceinline__ void phase_weights(const Params& P, LAS unsigned char* lds) {
    unsigned char* const ws = ows(P);
    const int tid = otid(), lane = tid & 63, wave = tid >> 6;
    const int gw = blockIdx.x * 8 + wave, NGW = gridDim.x * 8;
    constexpr int I_QKV = 16 * 24, I_O = 16 * 16, I_G = 16 * 32, I_D = 32 * 16;
    constexpr int PER_LAYER = I_QKV + I_O + NE * (2 * I_G + I_D);
    for (int it = gw; it < DEPTH * PER_LAYER; it += NGW) {
        const int l = it / PER_LAYER; int r = it % PER_LAYER;
        if (r < I_QKV) { bf16_t* dst = (bf16_t*)(ws + WS_WQKV) + (size_t)l * QKVW * D;
            transpose_item(P.w_qkv + (size_t)l * D * QKVW, D, QKVW, dst, [](int n) { const int hh = n >> 6; return 256 * (hh >> 2) + 128 * ((n >> 5) & 1) + 32 * (hh & 3) + (n & 31); }, r, lane); continue; }
        r -= I_QKV;
        if (r < I_O) { bf16_t* dst = (bf16_t*)(ws + WS_WO) + (size_t)l * D * D;
            transpose_item<true>(P.w_o + (size_t)l * D * D, D, D, dst, [](int n) { const int c = n & 31; return (n & ~31) + 16 * ((c >> 2) & 1) + 4 * (c >> 3) + (c & 3); }, r, lane); continue; }
        r -= I_O;
        const int e = r / (2 * I_G + I_D); r = r % (2 * I_G + I_D);
        const size_t le = (size_t)l * NE + e;
        if (r < I_G) { bf16_t* dst = (bf16_t*)(ws + WS_WGU) + le * (size_t)(2 * DE) * D;
            transpose_item(P.w_gate + le * (size_t)D * DE, D, DE, dst, [](int f) { return 256 * (f >> 7) + 128 * ((f >> 2) & 1) + 32 * ((f >> 5) & 3) + 4 * ((f >> 3) & 3) + (f & 3); }, r, lane, -1.4426950408889634f); continue; }
        r -= I_G;
        if (r < I_G) { bf16_t* dst = (bf16_t*)(ws + WS_WGU) + le * (size_t)(2 * DE) * D;
            transpose_item(P.w_up + le * (size_t)D * DE, D, DE, dst, [](int f) { return 256 * (f >> 7) + 128 * ((f >> 2) & 1) + 32 * ((f >> 5) & 3) + 16 + 4 * ((f >> 3) & 3) + (f & 3); }, r, lane, -0.6931471805599453f); continue; }
        r -= I_G;
        { bf16_t* dst = (bf16_t*)(ws + WS_WD) + le * (size_t)D * DE;
            transpose_item(P.w_down + le * (size_t)DE * D, DE, D, dst, [](int n) { const int c = n & 31; return (n & ~31) + 16 * ((c >> 2) & 1) + 4 * (c >> 3) + (c & 3); }, r, lane); }
    }
}

__device__ __forceinline__ void phase_mod(const Params& P, LAS unsigned char* lds) {
    unsigned char* const ws = ows(P);
    const int tid = otid(), lane = tid & 63, wave = tid >> 6;
    LAS float* sc = (LAS float*)lds;
    LAS float* red = sc + 3 * 1024;
    for (int i = tid; i < 3 * D; i += NT) { const int v = i / D, k = i % D; const float cv = v < 2 ? P.c[v * D + k] : P.c_ctx[k]; sc[i] = silu_f(cv); }
    __syncthreads();
    float* MOD = (float*)(ws + WS_MOD);
    for (int it = blockIdx.x; it < DEPTH * 96; it += gridDim.x) {
        const int l = it / 96, col = (it % 96) * 64 + lane;
        const float* W = P.w_mod + (size_t)l * D * 6144 + col;
        float a0 = 0.f, a1 = 0.f, a2 = 0.f;
#pragma unroll 4
        for (int k = wave; k < D; k += 8) { const float w = W[(size_t)k * 6144]; a0 += sc[k] * w; a1 += sc[D + k] * w; a2 += sc[2 * D + k] * w; }
        red[(wave * 3 + 0) * 64 + lane] = a0; red[(wave * 3 + 1) * 64 + lane] = a1; red[(wave * 3 + 2) * 64 + lane] = a2;
        __syncthreads();
        if (wave < 3) { float s = 0.f;
#pragma unroll
            for (int w = 0; w < 8; ++w) s += red[(w * 3 + wave) * 64 + lane];
            MOD[((size_t)l * 3 + wave) * 6144 + col] = s + P.b_mod[(size_t)l * 6144 + col]; }
        __syncthreads();
    }
}

__device__ __forceinline__ void phase_rope_init(const Params& P) {
    unsigned char* const ws = ows(P);
    float* T = (float*)(ws + WS_ROPE);
    for (int i = blockIdx.x * NT + otid(); i < 256 * 16; i += gridDim.x * NT) {
        const int p = i >> 4, f = i & 15;
        const float inv = (float)(1.0 / pow(10000.0, (double)f / 16.0));
        const float ang = (float)p * inv;
        T[2 * i] = (float)cos((double)ang); T[2 * i + 1] = (float)sin((double)ang);
    }
}


__device__ __forceinline__ void phase_norm1_l0(const Params& P) {
    unsigned char* const ws = ows(P);
    const int tid = otid(), lane = tid & 63, wave = tid >> 6;
    const int gw = blockIdx.x * 8 + wave, NGW = gridDim.x * 8;
    bf16_t* H = (bf16_t*)(ws + WS_H); const float* MOD = (const float*)(ws + WS_MOD); const float* gain = P.norm_mix_g;
    for (int r = gw; r < R; r += NGW) {
        const int b = r / RB, j = r - b * RB; const int mv = j < CTXL ? 2 : b;
        const float* sh = MOD + (size_t)mv * 6144; const float* sc = sh + 1024;
        const f32x4* xr = (const f32x4*)(j < CTXL ? P.ctx + ((size_t)b * CTXL + j) * D : P.x + ((size_t)b * SEQ + (j - CTXL)) * D) + lane;
        f32x4 v[4]; float ss = 0.f;
#pragma unroll
        for (int q = 0; q < 4; ++q) { v[q] = xr[64 * q]; ss += (v[q].x * v[q].x + v[q].y * v[q].y) + (v[q].z * v[q].z + v[q].w * v[q].w); }
        const float rstd = 1.0f / sqrtf(wave_sum(ss) * (1.f / D) + EPS);
        unsigned long long* o8 = (unsigned long long*)(H + (size_t)r * D) + lane;
#pragma unroll
        for (int q = 0; q < 4; ++q) { const int c0 = 4 * lane + 256 * q;
            const f32x4 g4 = *(const f32x4*)(gain + c0), sc4 = *(const f32x4*)(sc + c0), sh4 = *(const f32x4*)(sh + c0);
            const f32x4 h = v[q] * rstd * g4 * (sc4 + 1.f) + sh4;
            o8[64 * q] = (unsigned long long)pk2(h.x, h.y) | ((unsigned long long)pk2(h.z, h.w) << 32); }
    }
}


namespace pg8 {
#define PG8_LAS __attribute__((address_space(3)))
typedef unsigned short bf16_t;
typedef short bf16x8 __attribute__((ext_vector_type(8)));
typedef float f32x4 __attribute__((ext_vector_type(4)));
typedef unsigned u32x4 __attribute__((ext_vector_type(4)));
constexpr int BM = 256, BK = 64, HALF = 128, HTB = HALF * BK * 2  , STAGE_BYTES = 8 * HTB, NXCD = 8, WGM = 8;

__host__ __device__ __forceinline__ int lds_byte(int r, int c) { const int st = (r >> 4) * 2 + (c >> 5), rr = r & 15, cc = c & 31, ob = rr * 64 + cc * 2; return st * 1024 + (ob ^ (((ob >> 9) & 1) << 5)); }
__host__ __device__ __forceinline__ void stage_rc(int b, int& R, int& C) { const int st = b / 1024, sb = b % 1024, swz = sb ^ (((sb >> 9) & 1) << 5); R = (st >> 1) * 16 + swz / 64; C = (st & 1) * 32 + (swz % 64) / 2; }
__host__ __device__ __forceinline__ int perm32(int rho) { const int n = rho >> 4, i = rho & 15; return 8 * (i >> 2) + 4 * n + (i & 3); }

struct Unit { int pm, pn; int par = 0; int kt0 = 0, nkt = 0, kq = -1; };
struct Gemm { const bf16_t* A; const bf16_t* Bt; int M, N, K; const int* gidx; };


__device__ __forceinline__ unsigned cvt_pk_bf16(float lo, float hi) { unsigned r; asm volatile("v_cvt_pk_bf16_f32 %0, %1, %2" : "=v"(r) : "v"(lo), "v"(hi)); return r; }
typedef unsigned u32x2 __attribute__((ext_vector_type(2)));

struct EpiQKV {
    static constexpr bool PERM = false, AFTER_DRAIN = false, PRE = false;
    unsigned char* ws; const float* rope; const float* qg; const float* kg; int do_norm; const PG8_LAS float* ropel;
    __device__ __forceinline__ void operator()(const f32x4 (&acc)[2][2][4][2], const Unit& u, int wr_, int wc_, int fr_, int fq_) const {
        int wr = wr_, wc = wc_, fr = fr_, fq = fq_; asm volatile("" : "+s"(wr), "+s"(wc), "+v"(fr), "+v"(fq));
        const int type = u.pn < 4 ? 0 : (u.pn == 4 ? 1 : 2);
        const int pb = u.pm / 65, pj = u.pm - pb * 65;
        const bool lat = pj != 0, nrm = do_norm && type < 2;
        const size_t dbyte = type == 0 ? ::WS_Q + (size_t)(u.pn * 4 + wc) * 128 : (type == 1 ? ::WS_K : ::WS_V) + (size_t)wc * 128;
        bf16_t* dst = (bf16_t*)(ws + dbyte);
        const int ldd = type == 0 ? 1024 : 256;
        f32x4 gv[2][2];
#pragma unroll
        for (int bj = 0; bj < 2; ++bj)
#pragma unroll
            for (int n = 0; n < 2; ++n) { const f32x4 a = *(const f32x4*)(qg + 32 * bj + 16 * n + 4 * fq), b = *(const f32x4*)(kg + 32 * bj + 16 * n + 4 * fq);
                gv[bj][n] = nrm ? (type == 0 ? a : b) : (f32x4){1.f, 1.f, 1.f, 1.f}; }
        const float osc = type == 0 ? cfg::C2 : 1.f;
        const bool dorope = lat && type < 2;
#pragma unroll
        for (int ai = 0; ai < 2; ++ai) {
            f32x4 rr0 = (f32x4){1.f, 0.f, 1.f, 0.f}, rr1 = rr0;
            if (dorope) { const int prow = (pj - 1) * 4 + 2 * ai + wr; const f32x4* cs = (const f32x4*)(rope + (size_t)(prow * 16 + 4 * fq) * 2); rr0 = cs[0]; rr1 = cs[1]; }
#pragma unroll
            for (int mp = 0; mp < 2; ++mp) {
            f32x4 rc0[2], rc1[2];
#pragma unroll
            for (int mm = 0; mm < 2; ++mm) { rc0[mm] = (f32x4){1.f, 0.f, 1.f, 0.f}; rc1[mm] = rc0[mm]; }
            if (dorope) {
#pragma unroll
                for (int mm = 0; mm < 2; ++mm) { const PG8_LAS f32x4* cc = (const PG8_LAS f32x4*)(ropel + ((16 * (2 * mp + mm) + fr) * 16 + 4 * fq) * 2); rc0[mm] = cc[0]; rc1[mm] = cc[1]; }
            }
#pragma unroll
            for (int mm = 0; mm < 2; ++mm) {
                const int m = 2 * mp + mm;
                const int rt = ai * HALF + wr * 64 + m * 16 + fr;
                f32x4 v[2][2];
#pragma unroll
                for (int bj = 0; bj < 2; ++bj)
#pragma unroll
                    for (int n = 0; n < 2; ++n) v[bj][n] = acc[ai][bj][m][n];
                if (nrm) {
                    float ss = 0.f;
#pragma unroll
                    for (int bj = 0; bj < 2; ++bj)
#pragma unroll
                        for (int n = 0; n < 2; ++n) { const f32x4 x = v[bj][n]; ss += (x[0] * x[0] + x[1] * x[1]) + (x[2] * x[2] + x[3] * x[3]); }
                    ss += __shfl_xor(ss, 16); ss += __shfl_xor(ss, 32);
                    const float rstd = 1.0f / sqrtf(ss * (1.f / 64.f) + cfg::EPS);
#pragma unroll
                    for (int bj = 0; bj < 2; ++bj)
#pragma unroll
                        for (int n = 0; n < 2; ++n) v[bj][n] = v[bj][n] * rstd * gv[bj][n];
                }
                if (dorope) {
#pragma unroll
                    for (int bj = 0; bj < 2; ++bj) {
                        const f32x4 A = bj == 0 ? rr0 : rc0[mm], B = bj == 0 ? rr1 : rc1[mm];
                        const f32x4 c = (f32x4){A[0], A[2], B[0], B[2]}, s = (f32x4){A[1], A[3], B[1], B[3]};
                        const f32x4 x1 = v[bj][0], x2 = v[bj][1];
                        v[bj][0] = x1 * c - x2 * s; v[bj][1] = x2 * c + x1 * s;
                    }
                }
                const size_t tile_ = (size_t)((pb * 4 + wc) * 260 + pj * 4 + (rt >> 6));
                bf16_t* rowp = type == 1 ? (bf16_t*)(ws + ::WS_K) + (tile_ * 8 + fq) * 512 + (rt & 63) * 8
                             : type == 2 ? (bf16_t*)(ws + ::WS_V) + tile_ * 4096 + (rt & 63) * 32 + 8 * fq
                                         : dst + ((size_t)u.pm * BM + rt) * ldd + 8 * fq;
                const int sbj = type == 0 ? 32 : 2048;
#pragma unroll
                for (int bj = 0; bj < 2; ++bj) { const f32x4 o0 = v[bj][0] * osc, o1 = v[bj][1] * osc; u32x4 w; w.x = cvt_pk_bf16(o0[0], o0[1]); w.y = cvt_pk_bf16(o0[2], o0[3]); w.z = cvt_pk_bf16(o1[0], o1[1]); w.w = cvt_pk_bf16(o1[2], o1[3]);
                    *(u32x4*)(rowp + sbj * bj) = w; }
            }
            asm volatile("" ::: "memory");
            }
        }
    }
};
struct EpiResid {
    static constexpr bool PERM = false, AFTER_DRAIN = false, PRE = false;
    bf16_t* XR; const float* modl; const float* in_x; const float* in_ctx; int first;
    float* part = nullptr;
    __device__ __forceinline__ void operator()(const f32x4 (&acc)[2][2][4][2], const Unit& u, int wr_, int wc_, int fr_, int fq_) const {
        int wr = wr_, wc = wc_, fr = fr_, fq = fq_; asm volatile("" : "+s"(wr), "+s"(wc), "+v"(fr), "+v"(fq));
        const int pb = u.pm / 65, pj = u.pm - pb * 65; const int mv = pj == 0 ? 2 : pb;
        const int col0 = u.pn * BM + wc * 32 + 8 * fq;
        const float* g1 = modl + (size_t)mv * 6144 + 2048 + col0;
        const float* rin = pj == 0 ? in_ctx + (size_t)pb * 256 * 1024 : in_x + ((size_t)pb * 16384 + (size_t)(pj - 1) * 256) * 1024;
        f32x4 gv[2][2];
#pragma unroll
        for (int bj = 0; bj < 2; ++bj)
#pragma unroll
            for (int n = 0; n < 2; ++n) gv[bj][n] = *(const f32x4*)(g1 + bj * HALF + n * 4);
        if (u.kq > 0) {
            float* pb0 = part + ((size_t)(u.kq - 1) * 512 + (size_t)pb * 256) * 1024 + col0;
#pragma unroll
            for (int ai = 0; ai < 2; ++ai)
#pragma unroll
                for (int m = 0; m < 4; ++m) { float* rowp = pb0 + (size_t)(ai * HALF + wr * 64 + m * 16 + fr) * 1024;
#pragma unroll
                    for (int bj = 0; bj < 2; ++bj)
#pragma unroll
                        for (int n = 0; n < 2; ++n) *(f32x4*)(rowp + bj * HALF + n * 4) = gv[bj][n] * acc[ai][bj][m][n]; }
            return; }
#pragma unroll
        for (int ai = 0; ai < 2; ++ai)
#pragma unroll
            for (int mp = 0; mp < 2; ++mp) {
                f32x4 xv[2][2][2];
#pragma unroll
                for (int mm = 0; mm < 2; ++mm) { const size_t ro = (size_t)(ai * HALF + wr * 64 + (2 * mp + mm) * 16 + fr) * 1024 + col0;
                    if (first) { const float* rowp = rin + ro;
#pragma unroll
                        for (int bj = 0; bj < 2; ++bj)
#pragma unroll
                            for (int n = 0; n < 2; ++n) xv[mm][bj][n] = *(const f32x4*)(rowp + bj * HALF + n * 4); }
                    else { const bf16_t* rowp = XR + (size_t)u.pm * BM * 1024 + ro;
#pragma unroll
                        for (int bj = 0; bj < 2; ++bj) { const u32x4 w = *(const u32x4*)(rowp + bj * HALF);
                            xv[mm][bj][0] = (f32x4){__builtin_bit_cast(float, w.x << 16), __builtin_bit_cast(float, w.x & 0xffff0000u), __builtin_bit_cast(float, w.y << 16), __builtin_bit_cast(float, w.y & 0xffff0000u)};
                            xv[mm][bj][1] = (f32x4){__builtin_bit_cast(float, w.z << 16), __builtin_bit_cast(float, w.z & 0xffff0000u), __builtin_bit_cast(float, w.w << 16), __builtin_bit_cast(float, w.w & 0xffff0000u)}; } } }
#pragma unroll
                for (int mm = 0; mm < 2; ++mm) { bf16_t* rowp = XR + ((size_t)u.pm * BM + ai * HALF + wr * 64 + (2 * mp + mm) * 16 + fr) * 1024 + col0;
#pragma unroll
                    for (int bj = 0; bj < 2; ++bj) { const f32x4 o0 = xv[mm][bj][0] + gv[bj][0] * acc[ai][bj][2 * mp + mm][0], o1 = xv[mm][bj][1] + gv[bj][1] * acc[ai][bj][2 * mp + mm][1];
                        u32x4 w; w.x = cvt_pk_bf16(o0[0], o0[1]); w.y = cvt_pk_bf16(o0[2], o0[3]); w.z = cvt_pk_bf16(o1[0], o1[1]); w.w = cvt_pk_bf16(o1[2], o1[3]);
                        *(u32x4*)(rowp + bj * HALF) = w; } }
                asm volatile("" ::: "memory");
            }
    }
};
struct EpiSwiGLU {
    static constexpr bool PERM = false, AFTER_DRAIN = false, PRE = false;
    bf16_t* ACT; int ntn;
    __device__ __forceinline__ void operator()(const f32x4 (&acc)[2][2][4][2], const Unit& u, int wr_, int wc_, int fr_, int fq_) const {
        int wr = wr_, wc = wc_, fr = fr_, fq = fq_; asm volatile("" : "+s"(wr), "+s"(wc), "+v"(fr), "+v"(fq));
        const int pnl = u.pn % ntn; const int f0 = 128 * pnl + 32 * wc + 8 * fq;
#pragma unroll
        for (int ai = 0; ai < 2; ++ai)
#pragma unroll
            for (int m = 0; m < 4; ++m) { bf16_t* rowp = ACT + ((size_t)u.pm * BM + ai * HALF + wr * 64 + m * 16 + fr) * 2048 + f0;
                u32x4 w;
#pragma unroll
                for (int bj = 0; bj < 2; ++bj) { const f32x4 g = acc[ai][bj][m][0], up = acc[ai][bj][m][1]; f32x4 a;
#pragma unroll
                    for (int q = 0; q < 4; ++q) a[q] = (g[q] * up[q]) * __builtin_amdgcn_rcpf(1.f + __builtin_amdgcn_exp2f(g[q]));
                    if (bj == 0) { w.x = cvt_pk_bf16(a[0], a[1]); w.y = cvt_pk_bf16(a[2], a[3]); } else { w.z = cvt_pk_bf16(a[0], a[1]); w.w = cvt_pk_bf16(a[2], a[3]); } }
                *(u32x4*)rowp = w; }
    }
};
constexpr int YP_ROW0 = NSLOT;
struct EpiDown {
    static constexpr bool PERM = false, AFTER_DRAIN = false, PRE = true;
    bf16_t* Y; const float* selg; int ntn; PG8_LAS float* gl;
    __device__ __forceinline__ void pre(const Unit& u, int wid, int lane) const { if (wid < 4) __builtin_amdgcn_global_load_lds((const unsigned*)(selg + (size_t)u.pm * BM + wid * 64 + lane), (PG8_LAS unsigned*)(gl + u.par * 256 + wid * 64), 4, 0, 0); }
    __device__ __forceinline__ void operator()(const f32x4 (&acc)[2][2][4][2], const Unit& u, int wr_, int wc_, int fr_, int fq_) const {
        int wr = wr_, wc = wc_, fr = fr_, fq = fq_; asm volatile("" : "+s"(wr), "+s"(wc), "+v"(fr), "+v"(fq));
        const int pnl = u.pn % ntn; const int col0 = pnl * BM + wc * 32 + 8 * fq;
        const size_t rowb = u.kq < 0 ? (size_t)u.pm * BM : (size_t)(YP_ROW0 + 4096 * u.kq) + (size_t)(u.pm - 256) * BM;
        float gts[2][4];
#pragma unroll
        for (int ai = 0; ai < 2; ++ai)
#pragma unroll
            for (int m = 0; m < 4; ++m) gts[ai][m] = gl[u.par * 256 + ai * HALF + wr * 64 + m * 16 + fr];
#pragma unroll
        for (int ai = 0; ai < 2; ++ai)
#pragma unroll
            for (int m = 0; m < 4; ++m) { const size_t row = rowb + ai * HALF + wr * 64 + m * 16 + fr; const float gt = gts[ai][m]; bf16_t* rowp = Y + row * 1024 + col0;
#pragma unroll
                for (int bj = 0; bj < 2; ++bj) { const f32x4 o0 = acc[ai][bj][m][0] * gt, o1 = acc[ai][bj][m][1] * gt; u32x4 w; w.x = cvt_pk_bf16(o0[0], o0[1]); w.y = cvt_pk_bf16(o0[2], o0[3]); w.z = cvt_pk_bf16(o1[0], o1[1]); w.w = cvt_pk_bf16(o1[2], o1[3]);
                    *(u32x4*)(rowp + bj * HALF) = w; } }
    }
};
struct MoeOrder {
    int nMe, nN, nwg, G, c;
    __device__ void init(int nMe_, int nN_, int G_, int c_) { nMe = nMe_; nN = nN_; nwg = 16 * nMe * nN; G = G_; c = c_; }
    __device__ bool next(int i, Unit& u) const {
        const int L = i * G + c; if (L >= nwg) return false;
        int wgid = L; { const int q = nwg / NXCD, r = nwg % NXCD, xcd = wgid % NXCD, off = wgid / NXCD; wgid = (xcd < r ? xcd * (q + 1) : r * (q + 1) + (xcd - r) * q) + off; }
        const int per = nMe * nN, e = wgid / per, idx = wgid - e * per;
        const int nig = WGM * nN, gid = idx / nig, fm = gid * WGM, gsz = (nMe - fm) < WGM ? (nMe - fm) : WGM;
        const int pml = fm + ((idx % nig) % gsz), pnl = (idx % nig) / gsz;
        u.pm = pml < 8 ? e * 8 + pml : (pml < 16 ? (16 + e) * 8 + (pml - 8) : 256 + e);
        u.pn = e * nN + pnl; return true;
    }
    __device__ __forceinline__ void a_ready(const Unit&) const {}
    __device__ __forceinline__ void done(const Unit&) const {}
};
struct MoeSplitOrder {
    MoeOrder lat; int G, c;
    __device__ void init(int G_, int c_) { lat.init(16, 4, G_, c_); G = G_; c = c_; }
    __device__ bool next(int i, Unit& u) const {
        Unit v; v.pm = 0; v.pn = 0; const bool isl = lat.next(i, v);
        const int Lq = i * G + c - lat.nwg; if (!isl && Lq >= 256) return false;
        const int xcd = Lq & (NXCD - 1), off = Lq >> 3, e = 2 * xcd + (off >> 4), kq = off & 3;
        u.pm = isl ? v.pm : 256 + e; u.pn = isl ? v.pn : e * 4 + ((off >> 2) & 3); u.kq = isl ? -1 : kq; u.kt0 = isl ? 0 : 8 * kq; u.nkt = isl ? 32 : 8; return true;
    }
    __device__ __forceinline__ void a_ready(const Unit&) const {}
    __device__ __forceinline__ void done(const Unit&) const {}
};
struct MoeCtxLastOrder {
    MoeOrder lat; int G, c;
    __device__ void init(int G_, int c_) { lat.init(16, 16, G_, c_); G = G_; c = c_; }
    __device__ bool next(int i, Unit& u) const {
        Unit v; v.pm = 0; v.pn = 0; const bool isl = lat.next(i, v);
        const int Lq = i * G + c - lat.nwg; if (!isl && Lq >= 256) return false;
        const int xcd = Lq & (NXCD - 1), off = Lq >> 3, e = 2 * xcd + (off >> 4);
        u.pm = isl ? v.pm : 256 + e; u.pn = isl ? v.pn : e * 16 + (off & 15); return true;
    }
    __device__ __forceinline__ void a_ready(const Unit&) const {}
    __device__ __forceinline__ void done(const Unit&) const {}
};
struct DenseOrder {
    int nM, nN, nwg, G, c, skipctx;
    __device__ void init(int M, int N, int G_, int c_, int skipctx_ = 0) { nM = M / BM; nN = N / BM; nwg = nM * nN; G = G_; c = c_; skipctx = skipctx_; }
    __device__ bool next(int i, Unit& u) const {
        const int L = i * G + c; if (L >= nwg) return false;
        int wgid = L; { const int q = nwg / NXCD, r = nwg % NXCD, xcd = wgid % NXCD, off = wgid / NXCD; wgid = (xcd < r ? xcd * (q + 1) : r * (q + 1) + (xcd - r) * q) + off; }
        const int nig = WGM * nN, gid = wgid / nig, fm = gid * WGM, gsz = (nM - fm) < WGM ? (nM - fm) : WGM;
        u.pm = fm + ((wgid % nig) % gsz); u.pn = (wgid % nig) / gsz; if (skipctx) u.pm += 1 + (u.pm >= 64 ? 1 : 0); return true;
    }
    __device__ __forceinline__ void a_ready(const Unit&) const {}
    __device__ __forceinline__ void done(const Unit&) const {}
};
struct DenseSplitOrder {
    DenseOrder lat; int G, c;
    __device__ void init(int G_, int c_) { lat.init(NB * SEQ, D, G_, c_, 1); G = G_; c = c_; }
    __device__ bool next(int i, Unit& u) const {
        Unit v; v.pm = 0; v.pn = 0; const bool isl = lat.next(i, v);
        const int Lq = i * G + c - lat.nwg; if (!isl && Lq >= 32) return false;
        const int xcd = Lq & (NXCD - 1), kq = (Lq >> 3) & 3;
        u.pm = isl ? v.pm : ((xcd >> 2) ? 65 : 0); u.pn = isl ? v.pn : (xcd & 3); u.kq = isl ? -1 : kq; u.kt0 = isl ? 0 : 4 * kq; u.nkt = isl ? 16 : 4; return true;
    }
    __device__ __forceinline__ void a_ready(const Unit&) const {}
    __device__ __forceinline__ void done(const Unit&) const {}
};

template <class Epi, class Sched, bool ALIGN_EPI = false, bool SP2 = false, bool GATHER = false, bool BTILED = true, bool SPLITK = false, bool THIN = false>
__device__ __forceinline__ void gemm_phase(PG8_LAS unsigned char* lds, const Gemm g, const Sched& S, const Epi& E) {
    const int tid = otid(), wid = __builtin_amdgcn_readfirstlane(tid >> 6), lane = tid & 63, wr = wid >> 2, wc = wid & 3, fr = lane & 15, fq = lane >> 4;
    const int K = g.K, nt = K / BK;
    static_assert(!GATHER || SP2, "GATHER is wired into the SP2 loop only");
    unsigned voffA[2], voffB[2], goC[2][2], goN[2][2]; int gR[2]; unsigned gC[2];
#pragma unroll
    for (int i = 0; i < 2; ++i) { int R, C; stage_rc(tid * 16 + i * 8192, R, C); const int Rb = Epi::PERM ? ((R & ~31) + perm32(R & 31)) : R;
        voffA[i] = (unsigned)(R * K + C) * 2u; voffB[i] = BTILED ? (unsigned)(tid * 16 + i * 8192) : (unsigned)(Rb * K + C) * 2u; gR[i] = R; gC[i] = (unsigned)C * 2u; }
    static_assert(!BTILED || !Epi::PERM, "BTILED: the weight copy is already in LDS image order (no perm32)");
    PG8_LAS int* gix = (PG8_LAS int*)(lds + STAGE_BYTES + 64);
    const size_t kstep = (size_t)(BK * 2);
    const size_t kstepB = BTILED ? (size_t)HTB : kstep;
    const size_t hstep = (size_t)HALF * K * 2;
    const size_t tstep = 2 * hstep;
    const unsigned ldsw = (unsigned)wid * 1024u;
    const int aoff = lds_byte(wr * 64 + fr, fq * 8), boff = lds_byte(wc * 32 + fr, fq * 8);
#define PG8_SA(b, h) (((b) * 2 + (h)) * HTB)
#define PG8_SB(b, h) ((4 + (b) * 2 + (h)) * HTB)
#define PG8_STAGE(bufoff, gbase, voff) do { _Pragma("unroll") for (int _i = 0; _i < 2; ++_i) \
        __builtin_amdgcn_global_load_lds((const unsigned*)((const char*)(gbase) + (voff)[_i]), (PG8_LAS unsigned*)(lds + (bufoff) + ldsw + _i * 8192), 16, 0, 0); } while (0)
#define PG8_STAGE_A(bufoff, ptr, kb, h, NX) do { if constexpr (GATHER) { const char* _gb = (const char*)g.A + (kb); const unsigned _v0 = (NX) ? goN[h][0] : goC[h][0], _v1 = (NX) ? goN[h][1] : goC[h][1]; \
        __builtin_amdgcn_global_load_lds((const unsigned*)(_gb + _v0), (PG8_LAS unsigned*)(lds + (bufoff) + ldsw), 16, 0, 0); __builtin_amdgcn_global_load_lds((const unsigned*)(_gb + _v1), (PG8_LAS unsigned*)(lds + (bufoff) + ldsw + 8192), 16, 0, 0); } \
    else { PG8_STAGE(bufoff, ptr, voffA); } } while (0)
#define PG8_LDA(dst, b, h) do { _Pragma("unroll") for (int m = 0; m < 4; ++m) _Pragma("unroll") for (int k = 0; k < 2; ++k) dst[m][k] = *(const PG8_LAS bf16x8*)(lds + PG8_SA(b, h) + aoff + m * 2048 + k * 1024); } while (0)
#define PG8_LDB(dst, b, h) do { _Pragma("unroll") for (int n = 0; n < 2; ++n) _Pragma("unroll") for (int k = 0; k < 2; ++k) dst[n][k] = *(const PG8_LAS bf16x8*)(lds + PG8_SB(b, h) + boff + n * 2048 + k * 1024); } while (0)
#define PG8_MMA(ai, bj, At, Bt) do { __builtin_amdgcn_s_setprio(1); _Pragma("unroll") for (int m = 0; m < 4; ++m) _Pragma("unroll") for (int n = 0; n < 2; ++n) _Pragma("unroll") for (int k = 0; k < 2; ++k) \
        acc[ai][bj][m][n] = __builtin_amdgcn_mfma_f32_16x16x32_bf16(Bt[n][k], At[m][k], acc[ai][bj][m][n], 0, 0, 0); __builtin_amdgcn_s_setprio(0); } while (0)
#define PG8_WAIT_V(n) asm volatile("s_waitcnt vmcnt(" #n ")" ::: "memory")
#define PG8_WAIT_L(n) asm volatile("s_waitcnt lgkmcnt(" #n ")" ::: "memory")
#define PG8_BAR __builtin_amdgcn_s_barrier()
#define PG8_SCHED __builtin_amdgcn_sched_barrier(0)
    Unit cur, nxt; int ui = 0;
    if (!S.next(0, cur)) return;
    cur.par = 0;
    f32x4 acc[2][2][4][2];
#pragma unroll
    for (int a = 0; a < 2; ++a)
#pragma unroll
        for (int b = 0; b < 2; ++b)
#pragma unroll
            for (int m = 0; m < 4; ++m)
#pragma unroll
                for (int n = 0; n < 2; ++n) acc[a][b][m][n] = (f32x4){0.f, 0.f, 0.f, 0.f};
    bf16x8 At[4][2], B0[2][2], B1[2][2];
    const char* cA = (const char*)g.A + (size_t)cur.pm * tstep; const char* cB = (const char*)g.Bt + (size_t)cur.pn * tstep;
    if constexpr (SPLITK) { cA += (size_t)cur.kt0 * kstep; cB += (size_t)cur.kt0 * kstepB; }
    if constexpr (GATHER) {
#pragma unroll
        for (int h = 0; h < 2; ++h)
#pragma unroll
            for (int i = 0; i < 2; ++i) { goC[h][i] = (unsigned)g.gidx[(size_t)cur.pm * BM + h * HALF + gR[i]] * (unsigned)(K * 2) + gC[i]; goN[h][i] = goC[h][i]; } }
    S.a_ready(cur);
    if constexpr (SP2) {
        PG8_STAGE(PG8_SB(0, 0), cB, voffB); PG8_STAGE(PG8_SB(0, 1), cB + hstep, voffB); PG8_STAGE_A(PG8_SA(0, 0), cA, 0, 0, false); PG8_STAGE_A(PG8_SA(0, 1), cA + hstep, 0, 1, false);
        if (wr == 1) PG8_BAR;
        PG8_WAIT_V(2); PG8_BAR;
        PG8_STAGE(PG8_SB(1, 0), cB + kstepB, voffB); PG8_STAGE_A(PG8_SA(1, 0), cA + kstep, kstep, 0, false); PG8_STAGE(PG8_SB(1, 1), cB + hstep + kstepB, voffB);
        PG8_WAIT_V(6); PG8_BAR;
    } else {
        PG8_STAGE(PG8_SB(0, 0), cB, voffB); PG8_STAGE(PG8_SA(0, 0), cA, voffA); PG8_STAGE(PG8_SB(0, 1), cB + hstep, voffB); PG8_STAGE(PG8_SA(0, 1), cA + hstep, voffA);
        if (wr == 1) PG8_BAR;
        PG8_WAIT_V(4); PG8_BAR;
        PG8_STAGE(PG8_SB(1, 0), cB + kstepB, voffB); PG8_STAGE(PG8_SA(1, 0), cA + kstep, voffA); PG8_STAGE(PG8_SB(1, 1), cB + hstep + kstepB, voffB);
        PG8_WAIT_V(6); PG8_BAR;
    }
    for (;;) {
        const bool has_next = S.next(ui + 1, nxt);
        nxt.par = (ui + 1) & 1;
        const char* nA = has_next ? (const char*)g.A + (size_t)nxt.pm * tstep + (SPLITK ? (size_t)nxt.kt0 * kstep : (size_t)0) : cA; const char* nB = has_next ? (const char*)g.Bt + (size_t)nxt.pn * tstep + (SPLITK ? (size_t)nxt.kt0 * kstepB : (size_t)0) : cB;
        const int ntc = SPLITK ? cur.nkt : nt;
        const bool thin = THIN && cur.pm >= 256;
        if constexpr (Epi::PRE) E.pre(cur, wid, lane);
        if constexpr (GATHER) { if (has_next && wid < 4) __builtin_amdgcn_global_load_lds((const unsigned*)(g.gidx + (size_t)nxt.pm * BM + wid * 64 + lane), (PG8_LAS unsigned*)(gix + ((ui + 1) & 1) * 256 + wid * 64), 4, 0, 0); }
        for (int t = 0; t < ntc; t += 2) {
            const bool last = (t == ntc - 2);
            const char* a1 = cA + (size_t)(t + 1) * kstep;
            const char* a2 = last ? nA : cA + (size_t)(t + 2) * kstep; const char* b2 = last ? nB : cB + (size_t)(t + 2) * kstepB;
            const char* a3 = a2 + kstep; const char* b3 = b2 + kstepB;
            if (last && has_next) S.a_ready(nxt);
            const size_t kb2 = last ? (size_t)0 : (size_t)(t + 2) * kstep;
            if constexpr (GATHER) { if (last && has_next) {
#pragma unroll
                for (int h = 0; h < 2; ++h)
#pragma unroll
                    for (int i = 0; i < 2; ++i) goN[h][i] = (unsigned)gix[((ui + 1) & 1) * 256 + h * HALF + gR[i]] * (unsigned)(K * 2) + gC[i]; } }
            if constexpr (SP2) {
            PG8_LDB(B0, 0, 0); PG8_LDB(B1, 0, 1); PG8_SCHED; PG8_LDA(At, 0, 0); PG8_STAGE_A(PG8_SA(1, 1), a1 + hstep, (size_t)(t + 1) * kstep, 1, false);
            PG8_WAIT_V(8); PG8_WAIT_L(0); PG8_BAR; PG8_MMA(0, 0, At, B0); PG8_MMA(0, 1, At, B1); PG8_BAR; PG8_SCHED;
            PG8_LDA(At, 0, 1); PG8_STAGE(PG8_SB(0, 0), b2, voffB); PG8_STAGE(PG8_SB(0, 1), b2 + hstep, voffB); PG8_STAGE_A(PG8_SA(0, 0), a2, kb2, 0, last);
            PG8_WAIT_V(8); PG8_WAIT_L(0); PG8_BAR; if (!thin) { PG8_MMA(1, 0, At, B0); PG8_MMA(1, 1, At, B1); } PG8_BAR; PG8_SCHED;
            PG8_LDB(B0, 1, 0); PG8_LDB(B1, 1, 1); PG8_SCHED; PG8_LDA(At, 1, 0); PG8_STAGE_A(PG8_SA(0, 1), a2 + hstep, kb2, 1, last);
            PG8_WAIT_V(8); PG8_WAIT_L(0); PG8_BAR; PG8_MMA(0, 0, At, B0); PG8_MMA(0, 1, At, B1); PG8_BAR; PG8_SCHED;
            PG8_LDA(At, 1, 1); PG8_STAGE(PG8_SB(1, 0), b3, voffB); PG8_STAGE(PG8_SB(1, 1), b3 + hstep, voffB); PG8_STAGE_A(PG8_SA(1, 0), a3, kb2 + kstep, 0, last);
            PG8_WAIT_V(8); PG8_WAIT_L(0); PG8_BAR; if (!thin) { PG8_MMA(1, 0, At, B0); PG8_MMA(1, 1, At, B1); } PG8_BAR; PG8_SCHED;
            } else {
            PG8_LDB(B0, 0, 0); PG8_SCHED; PG8_LDA(At, 0, 0); PG8_STAGE(PG8_SA(1, 1), a1 + hstep, voffA);
            PG8_WAIT_L(8); PG8_BAR; PG8_WAIT_L(0); PG8_MMA(0, 0, At, B0); PG8_BAR; PG8_SCHED;
            PG8_LDB(B1, 0, 1); PG8_STAGE(PG8_SB(0, 0), b2, voffB);
            PG8_BAR; PG8_WAIT_L(0); PG8_MMA(0, 1, At, B1); PG8_BAR;
            PG8_LDA(At, 0, 1); PG8_STAGE(PG8_SA(0, 0), a2, voffA);
            PG8_BAR; PG8_WAIT_L(0); PG8_MMA(1, 0, At, B0); PG8_BAR; PG8_SCHED;
            PG8_STAGE(PG8_SB(0, 1), b2 + hstep, voffB);
            PG8_WAIT_V(6); PG8_BAR; PG8_MMA(1, 1, At, B1); PG8_BAR;
            PG8_LDB(B0, 1, 0); PG8_SCHED; PG8_LDA(At, 1, 0); PG8_STAGE(PG8_SA(0, 1), a2 + hstep, voffA);
            PG8_WAIT_L(8); PG8_BAR; PG8_WAIT_L(0); PG8_MMA(0, 0, At, B0); PG8_BAR; PG8_SCHED;
            PG8_LDB(B1, 1, 1); PG8_STAGE(PG8_SB(1, 0), b3, voffB);
            PG8_BAR; PG8_WAIT_L(0); PG8_MMA(0, 1, At, B1); PG8_BAR;
            PG8_LDA(At, 1, 1); PG8_STAGE(PG8_SA(1, 0), a3, voffA);
            PG8_BAR; PG8_WAIT_L(0); PG8_MMA(1, 0, At, B0); PG8_BAR; PG8_SCHED;
            PG8_STAGE(PG8_SB(1, 1), b3 + hstep, voffB);
            PG8_WAIT_V(6); PG8_BAR; PG8_MMA(1, 1, At, B1); PG8_BAR;
            }
        }
        if constexpr (ALIGN_EPI) { if (wr == 0) PG8_BAR; }
        if constexpr (!Epi::AFTER_DRAIN) { E(acc, cur, wr, wc, fr, fq); S.done(cur); }
        if (!has_next) break;
#pragma unroll
        for (int a = 0; a < 2; ++a)
#pragma unroll
            for (int b = 0; b < 2; ++b)
#pragma unroll
                for (int m = 0; m < 4; ++m)
#pragma unroll
                    for (int n = 0; n < 2; ++n) acc[a][b][m][n] = (f32x4){0.f, 0.f, 0.f, 0.f};
        cur = nxt; cA = nA; cB = nB; ++ui;
        if constexpr (GATHER) {
#pragma unroll
            for (int h = 0; h < 2; ++h)
#pragma unroll
                for (int i = 0; i < 2; ++i) goC[h][i] = goN[h][i]; }
        if constexpr (ALIGN_EPI) { if (wr == 1) PG8_BAR; }
    }
    PG8_WAIT_V(0);
    if constexpr (!ALIGN_EPI) { if (wr == 0) PG8_BAR; }
    PG8_BAR;
    if constexpr (Epi::AFTER_DRAIN) { E.fused(acc, cur, wr, wc, fr, fq, lds, wid, lane); S.done(cur); }
#undef PG8_SA
#undef PG8_SB
#undef PG8_STAGE
#undef PG8_STAGE_A
#undef PG8_LDA
#undef PG8_LDB
#undef PG8_MMA
#undef PG8_WAIT_V
#undef PG8_WAIT_L
#undef PG8_BAR
#undef PG8_SCHED
}
}


__device__ __forceinline__ void phase_qkv(const Params& P, int layer, LAS unsigned char* lds) {
    unsigned char* const ws = ows(P);
    pg8::Gemm g{(const bf16_t*)(ws + WS_H), (const bf16_t*)(ws + WS_WQKV) + (size_t)layer * QKVW * D, R, QKVW, D};
    pg8::DenseOrder S; S.init(R, QKVW, (int)gridDim.x, (int)blockIdx.x);
    LAS float* ropel = (LAS float*)(lds + pg8::STAGE_BYTES + 4608);
    { const int tid = otid(); ((LAS f32x4*)ropel)[tid] = ((const f32x4*)(ws + WS_ROPE))[tid]; __syncthreads(); }
    pg8::EpiQKV E{ws, (const float*)(ws + WS_ROPE), P.q_norm_g + (layer >> 1) * 64, P.k_norm_g + (layer >> 1) * 64, (layer & 1) == 0 ? 1 : 0, ropel};
    pg8::gemm_phase<pg8::EpiQKV, pg8::DenseOrder, true, true>(lds, g, S, E);
}
__device__ __forceinline__ void phase_oproj(const Params& P, int layer, LAS unsigned char* lds) {
    unsigned char* const ws = ows(P);
    pg8::Gemm g{(const bf16_t*)(ws + WS_O), (const bf16_t*)(ws + WS_WO) + (size_t)layer * D * D, R, D, D};
    pg8::EpiResid E{(bf16_t*)(ws + WS_XR), (const float*)(ws + WS_MOD) + (size_t)layer * 3 * 6144, P.x, P.ctx, layer == 0 ? 1 : 0, (float*)(ws + WS_XSEL)};
    if (layer == DEPTH - 1) { pg8::DenseOrder S; S.init(NB * SEQ, D, (int)gridDim.x, (int)blockIdx.x, 1); pg8::gemm_phase<pg8::EpiResid, pg8::DenseOrder, true, true>(lds, g, S, E); }
    else { pg8::DenseSplitOrder S; S.init((int)gridDim.x, (int)blockIdx.x); pg8::gemm_phase<pg8::EpiResid, pg8::DenseSplitOrder, true, true, false, true, true>(lds, g, S, E); }
}
__device__ __forceinline__ void phase_gateup(const Params& P, int layer, LAS unsigned char* lds) {
    unsigned char* const ws = ows(P);
    pg8::Gemm g{(const bf16_t*)(ws + WS_H), (const bf16_t*)(ws + WS_WGU) + (size_t)layer * NE * (2 * DE) * D, NSLOT, 2 * DE, D, (const int*)(ws + WS_SELI)};
    pg8::EpiSwiGLU E{(bf16_t*)(ws + WS_ACT), 16};
    if (layer == DEPTH - 1) { pg8::MoeOrder S; S.init(16, 16, (int)gridDim.x, (int)blockIdx.x); pg8::gemm_phase<pg8::EpiSwiGLU, pg8::MoeOrder, true, true, true>(lds, g, S, E); }
    else { pg8::MoeCtxLastOrder S; S.init((int)gridDim.x, (int)blockIdx.x); pg8::gemm_phase<pg8::EpiSwiGLU, pg8::MoeCtxLastOrder, true, true, true, true, false, true>(lds, g, S, E); }
}
__device__ __forceinline__ void phase_down(const Params& P, int layer, LAS unsigned char* lds) {
    unsigned char* const ws = ows(P);
    pg8::Gemm g{(const bf16_t*)(ws + WS_ACT), (const bf16_t*)(ws + WS_WD) + (size_t)layer * NE * D * DE, NSLOT, D, DE};
    pg8::EpiDown E{(bf16_t*)(ws + WS_Y), (const float*)(ws + WS_SELG), 4, (LAS float*)(lds + pg8::STAGE_BYTES + 2112)};
    if (layer == DEPTH - 1) { pg8::MoeOrder S; S.init(16, 4, (int)gridDim.x, (int)blockIdx.x); pg8::gemm_phase<pg8::EpiDown, pg8::MoeOrder, true, true>(lds, g, S, E); }
    else { pg8::MoeSplitOrder S; S.init((int)gridDim.x, (int)blockIdx.x); pg8::gemm_phase<pg8::EpiDown, pg8::MoeSplitOrder, true, true, false, true, true, true>(lds, g, S, E); }
}
namespace attn_body {
using bf16=__hip_bfloat16;
using bf16x8=__attribute__((ext_vector_type(8)))short;
using s16x4=__attribute__((ext_vector_type(4)))short;
using f32x16=__attribute__((ext_vector_type(16)))float;
using u32x4=__attribute__((ext_vector_type(4)))unsigned;
constexpr int D=64,DM=1024,KP=256;
constexpr int NW=8,QBLK=32,QB=QBLK*NW,KVBLK=64;
__device__ __forceinline__ int crow(int r,int hi){return (r&3)+8*(r>>2)+4*hi;}
#define SBAR() __builtin_amdgcn_sched_barrier(0)
__device__ __forceinline__ void wmask(f32x16&p0,f32x16&p1,int dk0,int hi){
  const float NEG=-INFINITY; const int kb=dk0+4*hi;
  #pragma unroll
  for(int r=0;r<16;++r){const int dk=kb+(r&3)+8*(r>>2); if(dk<-128||dk>128)p0[r]=NEG; if(dk+32<-128||dk+32>128)p1[r]=NEG;}
}

constexpr int NSLOT=3, SLOTB=8192;
constexpr int LDS_K=0, LDS_V=NSLOT*SLOTB, LDS_WS=2*NSLOT*SLOTB, LDS_OST=LDS_WS+NW*64*4, LDS_BYTES=LDS_OST+NW*4096;
constexpr float C2=0.125f*1.4426950408889634f;
__device__ __forceinline__ void glds16(const void*gsrc,unsigned lds_dst){unsigned keep;
  asm volatile("s_mov_b32 %0, m0\n\ts_mov_b32 m0, %2\n\ts_nop 0\n\tglobal_load_lds_dwordx4 %1, off\n\ts_mov_b32 m0, %0":"=&s"(keep):"v"(gsrc),"s"(lds_dst):"memory");}
__device__ __forceinline__ float max3f(float a,float b,float c){float r;asm("v_max3_f32 %0, %1, %2, %3":"=v"(r):"v"(a),"v"(b),"v"(c));return r;}
__device__ __forceinline__ float max2f(float a,float b){float r;asm("v_max_f32_e32 %0, %1, %2":"=v"(r):"v"(a),"v"(b));return r;}
__device__ __forceinline__ float fadd_s(float a,float b){float r;asm("v_add_f32_e32 %0, %1, %2":"=v"(r):"v"(a),"v"(b));return r;}
__device__ __forceinline__ float fsub_s(float a,float b){float r;asm("v_sub_f32_e32 %0, %1, %2":"=v"(r):"v"(a),"v"(b));return r;}
typedef float f32x2_t __attribute__((ext_vector_type(2))); typedef __bf16 bf16x2_t __attribute__((ext_vector_type(2)));
__device__ __forceinline__ unsigned cvtpk_s(float lo,float hi){f32x2_t v={lo,hi};bf16x2_t b=__builtin_convertvector(v,bf16x2_t);return __builtin_bit_cast(unsigned,b);}
#define WAIT_BAR(N) asm volatile("s_waitcnt vmcnt(" #N ") lgkmcnt(0)\n\ts_barrier":::"memory")

__device__ __forceinline__ void qkt(f32x16&p0,f32x16&p1,const char*Kslot,const bf16x8*qr,const f32x16&negm,int r32,int hi){
  const char*kb=Kslot+hi*1024+r32*16;
  #pragma unroll
  for(int d0=0;d0<4;++d0){
    const bf16x8 b0=*reinterpret_cast<const bf16x8*>(kb+d0*2048);
    const bf16x8 b1=*reinterpret_cast<const bf16x8*>(kb+d0*2048+512);
    if(d0==0){p0=__builtin_amdgcn_mfma_f32_32x32x16_bf16(b0,qr[0],negm,0,0,0);p1=__builtin_amdgcn_mfma_f32_32x32x16_bf16(b1,qr[0],negm,0,0,0);}
    else{p0=__builtin_amdgcn_mfma_f32_32x32x16_bf16(b0,qr[d0],p0,0,0,0);p1=__builtin_amdgcn_mfma_f32_32x32x16_bf16(b1,qr[d0],p1,0,0,0);}}
}
typedef __attribute__((address_space(3))) const char* lds_cptr;
typedef short v4i16_t __attribute__((ext_vector_type(4)));
__device__ __forceinline__ void kload8(bf16x8*kf,lds_cptr kp){
  kf[0]=*(const __attribute__((address_space(3))) bf16x8*)(kp);      kf[1]=*(const __attribute__((address_space(3))) bf16x8*)(kp+512);
  kf[2]=*(const __attribute__((address_space(3))) bf16x8*)(kp+2048); kf[3]=*(const __attribute__((address_space(3))) bf16x8*)(kp+2560);
  kf[4]=*(const __attribute__((address_space(3))) bf16x8*)(kp+4096); kf[5]=*(const __attribute__((address_space(3))) bf16x8*)(kp+4608);
  kf[6]=*(const __attribute__((address_space(3))) bf16x8*)(kp+6144); kf[7]=*(const __attribute__((address_space(3))) bf16x8*)(kp+6656);
}
__device__ __forceinline__ void kload2(bf16x8*kf,lds_cptr kp,int j){ kf[2*j]=*(const __attribute__((address_space(3))) bf16x8*)(kp+j*2048); kf[2*j+1]=*(const __attribute__((address_space(3))) bf16x8*)(kp+j*2048+512); }
__device__ __forceinline__ s16x4 vtr(lds_cptr p){ return __builtin_bit_cast(s16x4,__builtin_amdgcn_ds_read_tr16_b64_v4i16((__attribute__((address_space(3))) v4i16_t*)p)); }
__device__ __forceinline__ float rowmax(const f32x16&p0,const f32x16&p1){
  float a=max3f(p0[0],p0[1],p1[0]),b=max3f(p0[2],p0[3],p1[1]);a=max3f(a,p1[2],p1[3]);
  #pragma unroll
  for(int r=4;r<16;r+=4){a=max3f(a,p0[r],p0[r+1]);b=max3f(b,p0[r+2],p0[r+3]);a=max3f(a,p1[r],p1[r+1]);b=max3f(b,p1[r+2],p1[r+3]);}
  const float m=max2f(a,b);
  auto rr=__builtin_amdgcn_permlane32_swap(__float_as_uint(m),__float_as_uint(m),false,false);
  return max2f(__uint_as_float(rr[0]),__uint_as_float(rr[1]));
}
__device__ __forceinline__ void pv(f32x16*o,int vb,bf16x8 pa0,bf16x8 pa1,bf16x8 pa2,bf16x8 pa3){
  #pragma unroll
  for(int d0=0;d0<2;++d0){s16x4 lo[4],hi[4];
    #pragma unroll
    for(int ks=0;ks<4;++ks){
      asm volatile("ds_read_b64_tr_b16 %0,%1 offset:%c2":"=&v"(lo[ks]):"v"(vb),"i"(d0*4096+ks*1024):"memory");
      asm volatile("ds_read_b64_tr_b16 %0,%1 offset:%c2":"=&v"(hi[ks]):"v"(vb),"i"(d0*4096+ks*1024+512):"memory");}
    asm volatile("s_waitcnt lgkmcnt(0)":::"memory");SBAR();
    #define PK(k) (bf16x8){lo[k][0],lo[k][1],lo[k][2],lo[k][3],hi[k][0],hi[k][1],hi[k][2],hi[k][3]}
    o[d0]=__builtin_amdgcn_mfma_f32_32x32x16_bf16(pa0,PK(0),o[d0],0,0,0);
    o[d0]=__builtin_amdgcn_mfma_f32_32x32x16_bf16(pa1,PK(1),o[d0],0,0,0);
    o[d0]=__builtin_amdgcn_mfma_f32_32x32x16_bf16(pa2,PK(2),o[d0],0,0,0);
    o[d0]=__builtin_amdgcn_mfma_f32_32x32x16_bf16(pa3,PK(3),o[d0],0,0,0);
    #undef PK
  }
}

#ifndef ATTN_STORE16
#define ATTN_STORE16(p,v) (*(u32x4*)(p)=(v))
#endif
struct AttnUnit { int qrow0, kvrow0, h, nt, lo, t0, kt0; };
template<int THRL,bool WINDOW,bool FIXREF> __device__ __forceinline__ void attn_unit(const AttnUnit u,const bf16*Q,const bf16*__restrict__ K,const bf16*__restrict__ V,bf16*O,char*shm,float sinkl2,float mfix){
  const int tid=otid(),lane=tid&63,r32=lane&31,hi=lane>>5; const int wid=__builtin_amdgcn_readfirstlane(tid>>6);
  const bf16*Qw=Q+((long)u.qrow0+wid*QBLK)*DM+u.h*D;
  const bf16*Kh=K+(long)u.kt0*4096,*Vh=V+(long)u.kt0*4096;
  const unsigned lds0=(unsigned)(uintptr_t)shm;
  float*wsf=(float*)(shm+LDS_WS)+wid*64;
  const bf16*ksrc=Kh+wid*512+lane*8;
  const bf16*vsrc=Vh+(wid>>2)*2048+(16*(wid&3)+(lane>>2))*32+(lane&3)*8;
  const unsigned kdst=lds0+LDS_K+wid*1024, vdst=lds0+LDS_V+wid*1024;
  #define TROW(t) (KVBLK*(t)+((WINDOW&&(t)>=4)?u.lo:0))
  #define DMA_K(t,slot) glds16(ksrc+(long)(TROW(t)>>6)*4096,(unsigned)__builtin_amdgcn_readfirstlane(kdst+(slot)))
  #define DMA_V(t,slot) glds16(vsrc+(long)(TROW(t)>>6)*4096,(unsigned)__builtin_amdgcn_readfirstlane(vdst+(slot)))
  const int vb0=(int)(lds0+LDS_V)+((lane>>4)&1)*32+(lane&3)*8+(4*hi+((lane&15)>>2))*64;
  const char*Kbase=shm+LDS_K; bf16x8 kf[8];
  const lds_cptr shm3=(lds_cptr)shm; const lds_cptr kp0=shm3+LDS_K+hi*1024+r32*16; const lds_cptr vp0=shm3+LDS_V+((lane>>4)&1)*32+(lane&3)*8+(4*hi+((lane&15)>>2))*64;
  const int NT=u.nt;
  DMA_K(0,0);DMA_V(0,0);DMA_K(1,SLOTB);
  bf16x8 qr[4];
  #pragma unroll
  for(int d0=0;d0<4;++d0)qr[d0]=*reinterpret_cast<const bf16x8*>(&Qw[(long)r32*DM+d0*16+hi*8]);
  float mhat=FIXREF?mfix:0.f,l_reg=0.f;f32x16 o[2];o[0]=f32x16{};o[1]=f32x16{};f32x16 negm=f32x16{};
  if(FIXREF){_Pragma("unroll") for(int r=0;r<16;++r)negm[r]=-mfix;} asm volatile("":"+v"(negm));
  const int qrel=wid*QBLK+r32;
  #define CMASK(P0,P1,t) do{ if(WINDOW){ if((t)>=4){ const int kq_=u.lo+KVBLK*((t)-4)-u.t0-wid*QBLK;     \
      if(kq_<31-128||kq_+63>128) wmask(P0,P1,kq_-r32,hi); } } }while(0)
  bool resc=false;
  #define START(P0,P1) do{ resc=false; \
    if constexpr(!FIXREF){ const float rm=rowmax(P0,P1); const float dl=rm; mhat=fadd_s(mhat,dl); \
      _Pragma("unroll") for(int r=0;r<16;++r){P0[r]=fsub_s(P0[r],dl);P1[r]=fsub_s(P1[r],dl);} \
      _Pragma("unroll") for(int r=0;r<16;++r)negm[r]=-mhat; asm volatile("":"+v"(negm)); } \
    _Pragma("unroll") for(int r=0;r<16;++r)P0[r]=__builtin_amdgcn_exp2f(P0[r]); }while(0)
  #define RESC() do{ if(!FIXREF&&resc){ asm volatile("s_waitcnt lgkmcnt(0)":::"memory"); \
      _Pragma("unroll") for(int d_=0;d_<2;++d_) _Pragma("unroll") for(int r=0;r<16;++r)o[d_][r]*=wsf[crow(r,hi)]; } }while(0)
  f32x16 pA0,pA1,pB0,pB1;
  int sl_prev=0,sl_cur=0,sl_next=SLOTB;
  #define ROT() do{sl_prev=sl_cur;sl_cur=sl_next;sl_next=(sl_next==(NSLOT-1)*SLOTB)?0:sl_next+SLOTB;}while(0)
  DMA_K(2,2*SLOTB);
  WAIT_BAR(3);
  qkt(pA0,pA1,Kbase,qr,negm,r32,hi);asm volatile("s_nop 15\n\ts_nop 7":"+v"(pA0),"+v"(pA1));CMASK(pA0,pA1,0);
  START(pA0,pA1);
  _Pragma("unroll") for(int r=0;r<16;++r)pA1[r]=__builtin_amdgcn_exp2f(pA1[r]);
  WAIT_BAR(0);
  DMA_K(3,0);DMA_V(1,SLOTB);
  ROT();
  kload8(kf,kp0+sl_cur);
  WAIT_BAR(2);
  s16x4 vlo[8],vhi[8]; u32x4 pw0,pw1,pw2,pw3;
  #define PKW(P,B) cvtpk_s(P[B],P[B+1])
  #define PAF(k) __builtin_bit_cast(bf16x8,pw##k)
  #define VFR(i) (bf16x8){vlo[i][0],vlo[i][1],vlo[i][2],vlo[i][3],vhi[i][0],vhi[i][1],vhi[i][2],vhi[i][3]}
  #define PIN(x) asm volatile("":"+v"(x))
  #define MX3(a,b,c) __builtin_fmaxf(__builtin_fmaxf((a),(b)),(c))
  #define GAPA(MF,A0,A1,A2,A3,W0,W1,PW) do{ MF; sacc+=A0; sacc+=A1; sacc+=A2; sacc+=A3; PIN(sacc); W0; W1; PIN(PW); SBAR(); }while(0)
  #define EX(v) __builtin_amdgcn_exp2f(v)
  #define GAPB(MF,X,B) do{ MF; X[B]=EX(X[B]); X[B+1]=EX(X[B+1]); X[B+2]=EX(X[B+2]); X[B+3]=EX(X[B+3]); PIN(X); SBAR(); }while(0)
  #define VRD(i) do{ vlo[i]=vtr(vp_+(((i)>>2)*4096+((i)&3)*1024)); vhi[i]=vtr(vp_+(((i)>>2)*4096+((i)&3)*1024+512)); }while(0)
  #define KRD(G,j) do{ if(G){ kload2(kf,kp0+sl_next,j); SBAR(); } }while(0)
  #define STEP(C0,C1,P0,P1,t,GK,GV,GL) do{ SBAR(); \
    const lds_cptr vp_=vp0+sl_prev; \
    VRD(0); SBAR(); float sacc=(P0[0]+P0[1]); \
    GAPA(C0=__builtin_amdgcn_mfma_f32_32x32x16_bf16(kf[0],qr[0],negm,0,0,0), P0[2],P0[3],P0[4],P0[5],     pw0[0]=PKW(P0,0), pw0[1]=PKW(P0,2), pw0); \
    VRD(4); SBAR(); GAPA(C1=__builtin_amdgcn_mfma_f32_32x32x16_bf16(kf[1],qr[0],negm,0,0,0), P0[6],P0[7],P0[8],P0[9],     pw0[2]=PKW(P0,4), pw0[3]=PKW(P0,6), pw0); \
    VRD(1); SBAR(); GAPA(C0=__builtin_amdgcn_mfma_f32_32x32x16_bf16(kf[2],qr[1],C0,0,0,0),   P0[10],P0[11],P0[12],P0[13], pw1[0]=PKW(P0,8), pw1[1]=PKW(P0,10), pw1); \
    VRD(5); SBAR(); GAPA(C1=__builtin_amdgcn_mfma_f32_32x32x16_bf16(kf[3],qr[1],C1,0,0,0),   P0[14],P0[15],P1[0],P1[1],   pw1[2]=PKW(P0,12),pw1[3]=PKW(P0,14), pw1); \
    VRD(2); SBAR(); GAPA(C0=__builtin_amdgcn_mfma_f32_32x32x16_bf16(kf[4],qr[2],C0,0,0,0),   P1[2],P1[3],P1[4],P1[5],     pw2[0]=PKW(P1,0), pw2[1]=PKW(P1,2), pw2); \
    VRD(6); SBAR(); GAPA(C1=__builtin_amdgcn_mfma_f32_32x32x16_bf16(kf[5],qr[2],C1,0,0,0),   P1[6],P1[7],P1[8],P1[9],     pw2[2]=PKW(P1,4), pw2[3]=PKW(P1,6), pw2); \
    VRD(3); SBAR(); GAPA(C0=__builtin_amdgcn_mfma_f32_32x32x16_bf16(kf[6],qr[3],C0,0,0,0),   P1[10],P1[11],P1[12],P1[13], pw3[0]=PKW(P1,8), pw3[1]=PKW(P1,10), pw3); \
    VRD(7); SBAR(); GAPA(C1=__builtin_amdgcn_mfma_f32_32x32x16_bf16(kf[7],qr[3],C1,0,0,0),   P1[14],P1[15],0.f,0.f,       pw3[2]=PKW(P1,12),pw3[3]=PKW(P1,14), pw3); \
    l_reg+=sacc; \
    if(GK){DMA_K((t)+3,sl_cur);} if(GV){DMA_V((t)+1,sl_next);} \
    CMASK(C0,C1,t); \
    if constexpr(!FIXREF){ float a=MX3(C0[0],C0[1],C1[0]),b=MX3(C0[2],C0[3],C1[1]); a=MX3(a,C1[2],C1[3]); \
      _Pragma("unroll") for(int r=4;r<16;r+=4){a=MX3(a,C0[r],C0[r+1]);b=MX3(b,C0[r+2],C0[r+3]);a=MX3(a,C1[r],C1[r+1]);b=MX3(b,C1[r+2],C1[r+3]);} \
      float rm=__builtin_fmaxf(a,b); { auto rr=__builtin_amdgcn_permlane32_swap(__float_as_uint(rm),__float_as_uint(rm),false,false); rm=__builtin_fmaxf(__uint_as_float(rr[0]),__uint_as_float(rr[1])); } \
      resc=false; \
      if(__builtin_expect(__any(rm>(float)THRL),0)){ const float dl=__builtin_fmaxf(rm,0.f); mhat+=dl; \
        _Pragma("unroll") for(int r=0;r<16;++r){C0[r]-=dl;C1[r]-=dl;} \
        _Pragma("unroll") for(int r=0;r<16;++r)negm[r]=-mhat; asm volatile("":"+v"(negm)); \
        const float f=__builtin_amdgcn_exp2f(-dl); l_reg*=f; if(hi==0)wsf[r32]=f; resc=true; } } \
    SBAR(); \
      \
    KRD(GL,0); o[0]=__builtin_amdgcn_mfma_f32_32x32x16_bf16(PAF(0),VFR(0),o[0],0,0,0); C0[0]=EX(C0[0]); C0[1]=EX(C0[1]); C0[2]=EX(C0[2]); PIN(C0); PIN(C1); SBAR(); \
    KRD(GL,1); o[1]=__builtin_amdgcn_mfma_f32_32x32x16_bf16(PAF(0),VFR(4),o[1],0,0,0); C0[3]=EX(C0[3]); C0[4]=EX(C0[4]); C0[5]=EX(C0[5]); PIN(C0); PIN(C1); SBAR(); \
    KRD(GL,2); o[0]=__builtin_amdgcn_mfma_f32_32x32x16_bf16(PAF(1),VFR(1),o[0],0,0,0); C0[6]=EX(C0[6]); C0[7]=EX(C0[7]); C0[8]=EX(C0[8]); PIN(C0); PIN(C1); SBAR(); \
    KRD(GL,3); o[1]=__builtin_amdgcn_mfma_f32_32x32x16_bf16(PAF(1),VFR(5),o[1],0,0,0); C0[9]=EX(C0[9]); C0[10]=EX(C0[10]); C0[11]=EX(C0[11]); PIN(C0); PIN(C1); SBAR(); \
    o[0]=__builtin_amdgcn_mfma_f32_32x32x16_bf16(PAF(2),VFR(2),o[0],0,0,0); C0[12]=EX(C0[12]); C0[13]=EX(C0[13]); C0[14]=EX(C0[14]); C0[15]=EX(C0[15]); C1[0]=EX(C1[0]); PIN(C0); PIN(C1); SBAR(); \
    o[1]=__builtin_amdgcn_mfma_f32_32x32x16_bf16(PAF(2),VFR(6),o[1],0,0,0); C1[1]=EX(C1[1]); C1[2]=EX(C1[2]); C1[3]=EX(C1[3]); C1[4]=EX(C1[4]); C1[5]=EX(C1[5]); PIN(C0); PIN(C1); SBAR(); \
    o[0]=__builtin_amdgcn_mfma_f32_32x32x16_bf16(PAF(3),VFR(3),o[0],0,0,0); C1[6]=EX(C1[6]); C1[7]=EX(C1[7]); C1[8]=EX(C1[8]); C1[9]=EX(C1[9]); C1[10]=EX(C1[10]); PIN(C0); PIN(C1); SBAR(); \
    o[1]=__builtin_amdgcn_mfma_f32_32x32x16_bf16(PAF(3),VFR(7),o[1],0,0,0); C1[11]=EX(C1[11]); C1[12]=EX(C1[12]); C1[13]=EX(C1[13]); C1[14]=EX(C1[14]); C1[15]=EX(C1[15]); PIN(C0); PIN(C1); SBAR(); \
    }while(0)
  int t=1;
  for(;t+5<NT;t+=2){
    STEP(pB0,pB1,pA0,pA1,t,true,true,true);     WAIT_BAR(2); RESC(); ROT();
    STEP(pA0,pA1,pB0,pB1,t+1,true,true,true);   WAIT_BAR(2); RESC(); ROT();
  }
  #define ENDW(tt) do{ if((tt)+3<NT){WAIT_BAR(2);} else if((tt)+2<NT){WAIT_BAR(1);} else {WAIT_BAR(0);} }while(0)
  for(;t+1<NT;t+=2){
    STEP(pB0,pB1,pA0,pA1,t,(t+3<NT),(t+1<NT),(t+1<NT));       ENDW(t);   RESC(); ROT();
    STEP(pA0,pA1,pB0,pB1,t+1,(t+4<NT),(t+2<NT),(t+2<NT));     ENDW(t+1); RESC(); ROT();
  }
  STEP(pB0,pB1,pA0,pA1,NT-1,false,false,false); RESC();
  { float sacc=pB0[0]+pB0[1]; _Pragma("unroll") for(int r=2;r<16;++r)sacc+=pB0[r]; _Pragma("unroll") for(int r=0;r<16;++r)sacc+=pB1[r]; l_reg+=sacc;
    pw0=(u32x4){PKW(pB0,0),PKW(pB0,2),PKW(pB0,4),PKW(pB0,6)};pw1=(u32x4){PKW(pB0,8),PKW(pB0,10),PKW(pB0,12),PKW(pB0,14)};pw2=(u32x4){PKW(pB1,0),PKW(pB1,2),PKW(pB1,4),PKW(pB1,6)};pw3=(u32x4){PKW(pB1,8),PKW(pB1,10),PKW(pB1,12),PKW(pB1,14)};
    SBAR(); pv(o,vb0+sl_cur,PAF(0),PAF(1),PAF(2),PAF(3)); }
  #undef PKW
  #undef PAF
  #undef VFR
  #undef PIN
  #undef MX3
  #undef GAPA
  #undef GAPB
  #undef EX
  #undef VRD
  #undef KRD
  #undef STEP
  #undef ENDW
  {auto rr=__builtin_amdgcn_permlane32_swap(__float_as_uint(l_reg),__float_as_uint(l_reg),false,false);l_reg=__uint_as_float(rr[0])+__uint_as_float(rr[1]);}
  if(WINDOW)l_reg+=__builtin_amdgcn_exp2f(sinkl2-mhat);
  if(hi==0)wsf[32+r32]=l_reg;asm volatile("s_waitcnt lgkmcnt(0)":::"memory");
  float rli[16];
  #pragma unroll
  for(int r=0;r<16;++r)rli[r]=__builtin_amdgcn_rcpf(wsf[32+crow(r,hi)]);
  bf16*Ow=O+((long)u.qrow0+wid*QBLK)*DM+u.h*D;
  { bf16*stg=(bf16*)(shm+LDS_OST)+wid*2048;
    #pragma unroll
    for(int r=0;r<16;++r){const int orow=crow(r,hi);
      #pragma unroll
      for(int d0=0;d0<2;++d0)stg[orow*64+d0*32+r32]=__float2bfloat16(o[d0][r]*rli[r]);}
    asm volatile("s_waitcnt lgkmcnt(0)":::"memory");
    #pragma unroll
    for(int i=0;i<4;++i){const int row=i*8+(lane>>3),ch=lane&7; const u32x4 v=*(const u32x4*)(stg+row*64+ch*8); ATTN_STORE16(Ow+(long)row*DM+ch*8,v);} }
  asm volatile("s_waitcnt lgkmcnt(0)\n\ts_barrier":::"memory");
  #undef DMA_K
  #undef TROW
  #undef DMA_V
  #undef CMASK
  #undef START
  #undef RESC
  #undef ROT
}
constexpr int ATTN_LDS_BYTES=LDS_BYTES;
#undef SBAR
#undef WAIT_BAR
}

template <bool WINDOW>
__device__ __forceinline__ void phase_attn(const Params& P, int layer, char* lds) {
    unsigned char* const ws = ows(P);
    const attn_body::bf16* Q = (const attn_body::bf16*)(ws + WS_Q); const attn_body::bf16* Kb = (const attn_body::bf16*)(ws + WS_K); const attn_body::bf16* Vb = (const attn_body::bf16*)(ws + WS_V);
    attn_body::bf16* O = (attn_body::bf16*)(ws + WS_O);
    const float* sinkp = P.attn_sink + (layer >> 1) * NQH;
    float mfix = 0.f; bool fix = false;
    if (!WINDOW) { const int lane = otid() & 63; float gq = fabsf(P.q_norm_g[(layer >> 1) * 64 + lane]), gk = fabsf(P.k_norm_g[(layer >> 1) * 64 + lane]);
#pragma unroll
        for (int o = 1; o < 64; o <<= 1) { gq = fmaxf(gq, __shfl_xor(gq, o)); gk = fmaxf(gk, __shfl_xor(gk, o)); }
        mfix = __builtin_amdgcn_readfirstlane(8.f * LOG2E * 1.01f * gq * gk + 0.05f); fix = mfix < 40.f; }
    for (int v = blockIdx.x; v < 256; v += gridDim.x) {
        const int xcd = v & 7, cu = v >> 3; const int b = xcd >> 2, kvh = xcd & 3;
        for (int i = 0; i < 9; ++i) {
            attn_body::AttnUnit u; u.kvrow0 = b * RB; u.lo = 0; u.t0 = 0; u.kt0 = (b * 4 + kvh) * 260;
            if (i < 8) { const int n = i * 32 + cu; u.h = kvh * 4 + (n >> 6); const int qb = n & 63; u.t0 = qb * 256; u.qrow0 = b * RB + CTXL + u.t0;
                if (WINDOW) { int lo = u.t0 - 128; if (lo < 0) lo = 0; int hi = u.t0 + 384; if (hi > SEQ) hi = SEQ; u.lo = lo; u.nt = 4 + (hi - lo) / 64; } else u.nt = RB / 64; }
            else { if (cu >= 4 || layer == DEPTH - 1) break; u.h = kvh * 4 + cu; u.qrow0 = b * RB; u.nt = 4; }
            const float sk = WINDOW ? sinkp[u.h] * LOG2E : 0.f;
            if (WINDOW) attn_body::attn_unit<8, true, false>(u, Q, Kb, Vb, O, lds, sk, 0.f);
            else if (fix) attn_body::attn_unit<8, false, true>(u, Q, Kb, Vb, O, lds, 0.f, mfix);
            else attn_body::attn_unit<8, false, false>(u, Q, Kb, Vb, O, lds, 0.f, 0.f);
        }
    }
}

__device__ __forceinline__ int block_excl_scan(int v, LAS int* sm, int& total) {
    const int tid = otid(), lane = tid & 63, wave = tid >> 6;
    int inc = v;
#pragma unroll
    for (int o = 1; o < 64; o <<= 1) { const int t = __shfl_up(inc, o); if (lane >= o) inc += t; }
    __syncthreads();
    if (lane == 63) sm[wave] = inc;
    __syncthreads();
    int base = 0, tot = 0;
#pragma unroll
    for (int w = 0; w < 8; ++w) { const int s = sm[w]; if (w < wave) base += s; tot += s; }
    total = tot;
    return base + inc - v;
}
__device__ __forceinline__ void phase_select(const Params& P, LAS unsigned char* lds, bool last) {
    unsigned char* const ws = ows(P);
    const int tid = otid();
    LAS int* hist = (LAS int*)lds;
    LAS int* tot = hist + 32 * 257;
    LAS int* sm = tot + 256;
    LAS unsigned* bc = (LAS unsigned*)(sm + 16);
    const float* AFFL = (const float*)(ws + WS_AFF); const float* AFFC = AFFL + (size_t)NB * NE * SEQ;
    int* SELI = (int*)(ws + WS_SELI); float* SELG = (float*)(ws + WS_SELG); int* INVT = (int*)(ws + WS_INVT);
    for (int pid = blockIdx.x; pid < (last ? 32 : 64); pid += gridDim.x) {
        const bool isctx = pid >= 32; const int be = pid & 31, b = be >> 4, e = be & 15;
        const int n = isctx ? CTXL : SEQ, kcap = isctx ? CAP_C : CAP_L;
        const float* aff = isctx ? AFFC + (size_t)be * CTXL : AFFL + (size_t)be * SEQ;
        const int cnt = isctx ? (tid < CTXL ? 1 : 0) : 32; const int i0 = isctx ? tid : tid * 32;
        unsigned key[32];
        if (isctx) { key[0] = cnt ? __builtin_bit_cast(unsigned, aff[i0]) : 0u;
#pragma unroll
            for (int i = 1; i < 32; ++i) key[i] = 0u; }
        else {
#pragma unroll
            for (int i = 0; i < 32; i += 4) { const u32x4 t = *(const u32x4*)(aff + i0 + i); key[i] = t.x; key[i + 1] = t.y; key[i + 2] = t.z; key[i + 3] = t.w; } }
        unsigned prefix = 0u, mask = 0u; int krem = kcap;
        for (int pass = 0; pass < 4; ++pass) {
            const int shift = 24 - 8 * pass;
            __syncthreads();
            for (int i = tid; i < 32 * 257; i += NT) hist[i] = 0;
            __syncthreads();
            LAS int* myh = hist + (tid & 31) * 257;
#pragma unroll
            for (int i = 0; i < 32; ++i) if (i < cnt && (key[i] & mask) == prefix) __hip_atomic_fetch_add(&myh[(key[i] >> shift) & 255u], 1, __ATOMIC_RELAXED, __HIP_MEMORY_SCOPE_WORKGROUP);
            __syncthreads();
            if (tid < 256) { int s = 0;
#pragma unroll 8
                for (int c = 0; c < 32; ++c) s += hist[c * 257 + tid];
                tot[tid] = s; }
            __syncthreads();
            if (tid < 64) {
                int c[4]; int s = 0;
#pragma unroll
                for (int j = 0; j < 4; ++j) { c[j] = tot[255 - (4 * tid + j)]; s += c[j]; }
                int inc = s;
#pragma unroll
                for (int o = 1; o < 64; o <<= 1) { const int t = __shfl_up(inc, o); if (tid >= o) inc += t; }
                int above = inc - s;
                if (above < krem && inc >= krem) { int d = 255 - 4 * tid;
#pragma unroll
                    for (int j = 0; j < 3; ++j) if (above + c[j] < krem) { above += c[j]; --d; } else break;
                    bc[0] = prefix | ((unsigned)d << shift); bc[1] = (unsigned)(krem - above); }
            }
            __syncthreads();
            prefix = bc[0]; krem = (int)bc[1]; mask |= 255u << shift;
        }
        const unsigned T = prefix;
        int ceq = 0;
#pragma unroll
        for (int i = 0; i < 32; ++i) if (i < cnt && key[i] == T) ++ceq;
        int tot; const int eqb = block_excl_scan(ceq, sm, tot);
        unsigned selm = 0u; int csel = 0, er = eqb;
#pragma unroll
        for (int i = 0; i < 32; ++i) if (i < cnt) { bool s = key[i] > T; if (key[i] == T) { s = er < krem; ++er; } if (s) { selm |= 1u << i; ++csel; } }
        int tots; int pos = block_excl_scan(csel, sm, tots);
        const int sbase = isctx ? NSLOT_L + e * 256 + b * CAP_C : (b * NE + e) * CAP_L;
        const int rbase = b * RB + (isctx ? 0 : CTXL);
        int invv[32];
#pragma unroll
        for (int i = 0; i < 32; ++i) { invv[i] = -1; if (i < cnt) { const int r = rbase + i0 + i;
            if ((selm >> i) & 1u) { const int inv = sbase + pos; invv[i] = inv; SELI[inv] = r; SELG[inv] = __builtin_bit_cast(float, key[i]); ++pos; } } }
        if (isctx) { if (cnt) INVT[(size_t)e * R + rbase + i0] = invv[0]; }
        else { typedef int i32x4 __attribute__((ext_vector_type(4))); i32x4* dst = (i32x4*)(INVT + (size_t)e * R + rbase + i0);
#pragma unroll
            for (int i = 0; i < 8; ++i) dst[i] = (i32x4){invv[4 * i], invv[4 * i + 1], invv[4 * i + 2], invv[4 * i + 3]}; }
        if (isctx && b == 0 && tid < 192) { SELI[NSLOT_L + e * 256 + 64 + tid] = 0; SELG[NSLOT_L + e * 256 + 64 + tid] = 0.f; }
    }
}


__device__ __forceinline__ float reduce16(float (&v)[16], int lane) {
#pragma unroll
    for (int i = 0; i < 8; ++i) { const bool up = lane & 1; const float keep = up ? v[i + 8] : v[i], send = up ? v[i] : v[i + 8]; v[i] = keep + __shfl_xor(send, 1); }
#pragma unroll
    for (int i = 0; i < 4; ++i) { const bool up = lane & 2; const float keep = up ? v[i + 4] : v[i], send = up ? v[i] : v[i + 4]; v[i] = keep + __shfl_xor(send, 2); }
#pragma unroll
    for (int i = 0; i < 2; ++i) { const bool up = lane & 4; const float keep = up ? v[i + 2] : v[i], send = up ? v[i] : v[i + 2]; v[i] = keep + __shfl_xor(send, 4); }
    { const bool up = lane & 8; const float keep = up ? v[1] : v[0], send = up ? v[0] : v[1]; v[0] = keep + __shfl_xor(send, 8); }
    v[0] += __shfl_xor(v[0], 16); v[0] += __shfl_xor(v[0], 32);
    return v[0];
}
__device__ __forceinline__ float softmax16(float s) {
    float mx = s;
#pragma unroll
    for (int o = 1; o < 16; o <<= 1) mx = fmaxf(mx, __shfl_xor(mx, o));
    const float ex = expf(s - mx); float den = ex;
#pragma unroll
    for (int o = 1; o < 16; o <<= 1) den += __shfl_xor(den, o);
    return ex / den;
}
__device__ __forceinline__ void phase_norm2_router(const Params& P, int layer, LAS unsigned char* lds) {
    unsigned char* const ws = ows(P);
    const int tid = otid(), lane = tid & 63, wave = tid >> 6;
    const int gw = blockIdx.x * 8 + wave, NGW = gridDim.x * 8;
    LAS float* wT = (LAS float*)lds;
    { const f32x4* wr4 = (const f32x4*)(P.w_router + (size_t)layer * D * NE);
      for (int i = tid; i < D * NE / 4; i += NT) { const f32x4 w = wr4[i]; const int k = i >> 2, e0 = (i & 3) * 4; wT[(e0 + 0) * 1024 + k] = w.x; wT[(e0 + 1) * 1024 + k] = w.y; wT[(e0 + 2) * 1024 + k] = w.z; wT[(e0 + 3) * 1024 + k] = w.w; } }
    __syncthreads();
    bf16_t* XR = (bf16_t*)(ws + WS_XR); bf16_t* H = (bf16_t*)(ws + WS_H);
    const float* MOD = (const float*)(ws + WS_MOD) + (size_t)layer * 3 * 6144;
    const float* gain = P.norm_ffn_g + (size_t)layer * D;
    const float* OPART = (const float*)(ws + WS_XSEL);
    float* AFFL = (float*)(ws + WS_AFF); float* AFFC = AFFL + (size_t)NB * NE * SEQ;
    const int erev = ((lane & 1) << 3) | ((lane & 2) << 1) | ((lane & 4) >> 1) | ((lane & 8) >> 3);
    for (int pr = gw; pr < R / 2; pr += NGW) {
        const int r0 = 2 * pr; const int b = r0 / RB, j = r0 - b * RB; const int mv = j < CTXL ? 2 : b;
        if (layer == DEPTH - 1 && j < CTXL) continue;
        const float* sh = MOD + (size_t)mv * 6144 + 3072; const float* sc = sh + 1024;
        u32x2* xr = (u32x2*)(XR + (size_t)r0 * D) + lane;
        f32x4 v0[4], v1[4]; float ss0 = 0.f, ss1 = 0.f;
#pragma unroll
        for (int q = 0; q < 4; ++q) { const u32x2 a = xr[64 * q], b2 = xr[256 + 64 * q];
            v0[q] = (f32x4){__builtin_bit_cast(float, a.x << 16), __builtin_bit_cast(float, a.x & 0xffff0000u), __builtin_bit_cast(float, a.y << 16), __builtin_bit_cast(float, a.y & 0xffff0000u)};
            v1[q] = (f32x4){__builtin_bit_cast(float, b2.x << 16), __builtin_bit_cast(float, b2.x & 0xffff0000u), __builtin_bit_cast(float, b2.y << 16), __builtin_bit_cast(float, b2.y & 0xffff0000u)}; }
        if (j < CTXL) {
#pragma unroll
            for (int p = 0; p < 3; ++p) { const f32x4* pp = (const f32x4*)(OPART + ((size_t)p * 512 + (size_t)b * CTXL + j) * D) + lane;
#pragma unroll
                for (int q = 0; q < 4; ++q) { v0[q] += pp[64 * q]; v1[q] += pp[256 + 64 * q]; } }
#pragma unroll
            for (int q = 0; q < 4; ++q) { xr[64 * q] = (u32x2){pk2(v0[q].x, v0[q].y), pk2(v0[q].z, v0[q].w)}; xr[256 + 64 * q] = (u32x2){pk2(v1[q].x, v1[q].y), pk2(v1[q].z, v1[q].w)}; } }
#pragma unroll
        for (int q = 0; q < 4; ++q) { ss0 += (v0[q].x * v0[q].x + v0[q].y * v0[q].y) + (v0[q].z * v0[q].z + v0[q].w * v0[q].w); ss1 += (v1[q].x * v1[q].x + v1[q].y * v1[q].y) + (v1[q].z * v1[q].z + v1[q].w * v1[q].w); }
        const float rstd0 = 1.0f / sqrtf(wave_sum(ss0) * (1.f / D) + EPS), rstd1 = 1.0f / sqrtf(wave_sum(ss1) * (1.f / D) + EPS);
        unsigned long long* o8 = (unsigned long long*)(H + (size_t)r0 * D) + lane;
#pragma unroll
        for (int q = 0; q < 4; ++q) {
            const int c0 = 4 * lane + 256 * q;
            const f32x4 g4 = *(const f32x4*)(gain + c0), sc4 = *(const f32x4*)(sc + c0), sh4 = *(const f32x4*)(sh + c0);
            const f32x4 gm = g4 * (sc4 + 1.f);
            v0[q] = v0[q] * rstd0 * gm + sh4; v1[q] = v1[q] * rstd1 * gm + sh4;
            o8[64 * q] = (unsigned long long)pk2(v0[q].x, v0[q].y) | ((unsigned long long)pk2(v0[q].z, v0[q].w) << 32);
            o8[256 + 64 * q] = (unsigned long long)pk2(v1[q].x, v1[q].y) | ((unsigned long long)pk2(v1[q].z, v1[q].w) << 32);
        }
        float a0[16], a1[16];
#pragma unroll
        for (int e = 0; e < 16; ++e) {
            float s0 = 0.f, s1 = 0.f;
#pragma unroll
            for (int q = 0; q < 4; ++q) { const f32x4 w = *(const LAS f32x4*)(wT + e * 1024 + 4 * lane + 256 * q);
                s0 += (v0[q].x * w.x + v0[q].y * w.y) + (v0[q].z * w.z + v0[q].w * w.w); s1 += (v1[q].x * w.x + v1[q].y * w.y) + (v1[q].z * w.z + v1[q].w * w.w); }
            a0[e] = s0; a1[e] = s1;
            if (e & 1) asm volatile("" ::: "memory");
        }
        const float p0 = softmax16(reduce16(a0, lane)), p1 = softmax16(reduce16(a1, lane));
        if (lane < 16) { typedef float f32x2 __attribute__((ext_vector_type(2)));
            float* dst = j < CTXL ? AFFC + ((size_t)b * NE + erev) * CTXL + j : AFFL + ((size_t)b * NE + erev) * SEQ + (j - CTXL);
            *(f32x2*)dst = (f32x2){p0, p1}; }
    }
}

template <bool LAST>
__device__ __forceinline__ void phase_combine_norm(const Params& P, int layer) {
    unsigned char* const ws = ows(P);
    const int tid = otid(), lane = tid & 63, wave = tid >> 6; const int gw = blockIdx.x * 8 + wave, NGW = gridDim.x * 8;
    bf16_t* XR = (bf16_t*)(ws + WS_XR); const bf16_t* Y = (const bf16_t*)(ws + WS_Y); const int* INVT = (const int*)(ws + WS_INVT); bf16_t* H = (bf16_t*)(ws + WS_H);
    const float* MOD = (const float*)(ws + WS_MOD) + (size_t)layer * 3 * 6144;
    const float* gain = LAST ? P.final_norm_g : P.norm_mix_g + (size_t)(layer + 1) * D;
    int sv = (gw < R && lane < 16) ? INVT[(size_t)lane * R + gw] : -1;
    for (int r = gw; r < R; r += NGW) {
        const int b = r / RB, j = r - b * RB; const int mv = j < CTXL ? 2 : b;
        const int svc = sv; sv = (r + NGW < R && lane < 16) ? INVT[(size_t)lane * R + r + NGW] : -1;
        if (LAST && j < CTXL) continue;
        u32x2* xr = (u32x2*)(XR + (size_t)r * D) + lane;
        f32x4 x[4], acc[4];
#pragma unroll
        for (int q = 0; q < 4; ++q) { const u32x2 a = xr[64 * q]; x[q] = (f32x4){__builtin_bit_cast(float, a.x << 16), __builtin_bit_cast(float, a.x & 0xffff0000u), __builtin_bit_cast(float, a.y << 16), __builtin_bit_cast(float, a.y & 0xffff0000u)}; acc[q] = (f32x4){0.f, 0.f, 0.f, 0.f}; }
#pragma unroll
        for (int e = 0; e < NE; ++e) { const int s = __builtin_amdgcn_readlane(svc, e);
            if (s >= 0) {
                if (!LAST && s >= NSLOT_L) {
#pragma unroll
                    for (int p = 0; p < 4; ++p) { const u32x2* y = (const u32x2*)(Y + (size_t)(pg8::YP_ROW0 + 4096 * p + (s - NSLOT_L)) * D) + lane;
#pragma unroll
                        for (int q = 0; q < 4; ++q) { const u32x2 w = y[64 * q]; acc[q] += (f32x4){__builtin_bit_cast(float, w.x << 16), __builtin_bit_cast(float, w.x & 0xffff0000u), __builtin_bit_cast(float, w.y << 16), __builtin_bit_cast(float, w.y & 0xffff0000u)}; } } }
                else { const u32x2* y = (const u32x2*)(Y + (size_t)s * D) + lane;
#pragma unroll
                    for (int q = 0; q < 4; ++q) { const u32x2 w = y[64 * q]; acc[q] += (f32x4){__builtin_bit_cast(float, w.x << 16), __builtin_bit_cast(float, w.x & 0xffff0000u), __builtin_bit_cast(float, w.y << 16), __builtin_bit_cast(float, w.y & 0xffff0000u)}; } } } }
        const float* g2 = MOD + (size_t)mv * 6144 + 5120;
        float ss = 0.f;
#pragma unroll
        for (int q = 0; q < 4; ++q) { const f32x4 g4 = *(const f32x4*)(g2 + 4 * lane + 256 * q); x[q] = x[q] + g4 * acc[q]; if (!LAST) xr[64 * q] = (u32x2){pk2(x[q].x, x[q].y), pk2(x[q].z, x[q].w)};
            ss += (x[q].x * x[q].x + x[q].y * x[q].y) + (x[q].z * x[q].z + x[q].w * x[q].w); }
        const float rstd = 1.0f / sqrtf(wave_sum(ss) * (1.f / D) + EPS);
        if (LAST) { f32x4* o = (f32x4*)(P.out + ((size_t)b * SEQ + (j - CTXL)) * D) + lane;
#pragma unroll
            for (int q = 0; q < 4; ++q) { const f32x4 g4 = *(const f32x4*)(gain + 4 * lane + 256 * q); o[64 * q] = x[q] * rstd * g4; } }
        else { const float* sh = MOD + 3 * 6144 + (size_t)mv * 6144; const float* sc = sh + 1024;
            unsigned long long* o8 = (unsigned long long*)(H + (size_t)r * D) + lane;
#pragma unroll
            for (int q = 0; q < 4; ++q) { const int c0 = 4 * lane + 256 * q; const f32x4 g4 = *(const f32x4*)(gain + c0), sc4 = *(const f32x4*)(sc + c0), sh4 = *(const f32x4*)(sh + c0);
                const f32x4 h = x[q] * rstd * g4 * (sc4 + 1.f) + sh4;
                o8[64 * q] = (unsigned long long)pk2(h.x, h.y) | ((unsigned long long)pk2(h.z, h.w) << 32); } }
    }
}

#define XB_TMO      128
#define XB_XCNT(j)  (256  + 64 * (j))
#define XB_XSUB(j)  (1280 + 64 * (j))
#define XB_XGEN(j)  (2304 + 64 * (j))
#define XB_TOP      3328
#define XB_TOPGEN   3392
#define XCD_BAR_WORDS 3456
#define XB_SPIN_CAP (1u << 18)

__device__ __forceinline__ unsigned xb_ld(unsigned* p)              { return __hip_atomic_load(p, __ATOMIC_RELAXED, __HIP_MEMORY_SCOPE_AGENT); }
__device__ __forceinline__ unsigned xb_add(unsigned* p, unsigned v) { return __hip_atomic_fetch_add(p, v, __ATOMIC_RELAXED, __HIP_MEMORY_SCOPE_AGENT); }
__device__ __forceinline__ unsigned xb_xcc_id() { return (unsigned)__builtin_amdgcn_s_getreg((3 << 11) | 20) & 0xFu; }
#define XB_SPIN(cond, bar) do { unsigned _sp = 0; while (cond) { __builtin_amdgcn_s_sleep(1); \
    if ((++_sp & 255u) == 0u) { if (xb_ld(&(bar)[XB_TMO])) break; if (_sp > XB_SPIN_CAP) { atomicAdd(&(bar)[XB_TMO], 1u); break; } } } } while (0)

struct XcdBarrier {
    unsigned* bar; unsigned x;
    volatile LAS unsigned* st;
};

__device__ __forceinline__ XcdBarrier xcd_barrier_post(unsigned* bar, volatile LAS unsigned* st) {
    XcdBarrier b; b.bar = bar; b.x = xb_xcc_id(); b.st = st;
    if (threadIdx.x == 0) (void)xb_add(&bar[XB_XCNT(b.x)], 1u);
    return b;
}
__device__ __forceinline__ void xcd_barrier_complete(unsigned* bar, unsigned x, unsigned& nloc, unsigned& nx) {
    const unsigned G = gridDim.x * gridDim.y * gridDim.z;
    unsigned sum, cnt, mine, sp = 0u;
    for (;;) {
        sum = 0u; cnt = 0u; mine = 0u;
#pragma unroll
        for (unsigned j = 0; j < 16; ++j) { const unsigned c = xb_ld(&bar[XB_XCNT(j)]); sum += c; cnt += (c > 0u) ? 1u : 0u; mine = (j == x) ? c : mine; }
        if (sum == G) break;
        __builtin_amdgcn_s_sleep(1);
        if ((++sp & 255u) == 0u) { if (xb_ld(&bar[XB_TMO])) break; if (sp > XB_SPIN_CAP) { atomicAdd(&bar[XB_TMO], 1u); break; } }
    }
    nloc = mine > 0u ? mine : 1u; nx = cnt > 0u ? cnt : 1u;
}

__device__ __forceinline__ void xcd_barrier(const XcdBarrier& b) {
    asm volatile("s_waitcnt vmcnt(0)" ::: "memory");
    __syncthreads();
    if (threadIdx.x == 0) {
        unsigned* bar = b.bar; unsigned bx_ = b.x;
        asm volatile("" : "+s"(bar), "+s"(bx_));
        __builtin_amdgcn_s_waitcnt(0);
        unsigned nloc = b.st[0], nx = b.st[1];
        if (nloc == 0u) { xcd_barrier_complete(bar, bx_, nloc, nx); b.st[0] = nloc; b.st[1] = nx; }
        const unsigned old = xb_add(&bar[XB_XSUB(bx_)], 1u);
        const unsigned gen = old / nloc;
        if (old + 1u == (gen + 1u) * nloc) {
            __builtin_amdgcn_fence(__ATOMIC_RELEASE, "agent");
            asm volatile("s_waitcnt vmcnt(0)" ::: "memory");
            const unsigned og = xb_add(&bar[XB_TOP], 1u);
            const unsigned tg = og / nx;
            if (og + 1u == (tg + 1u) * nx) xb_add(&bar[XB_TOPGEN], 1u);
            else XB_SPIN(xb_ld(&bar[XB_TOPGEN]) == tg, bar);
            __builtin_amdgcn_fence(__ATOMIC_ACQUIRE, "agent");
            xb_add(&bar[XB_XGEN(bx_)], 1u);
            asm volatile("s_waitcnt vmcnt(0)" ::: "memory");
        } else {
            XB_SPIN(xb_ld(&bar[XB_XGEN(bx_)]) == gen, bar);
            __builtin_amdgcn_fence(__ATOMIC_ACQUIRE, "agent");
            asm volatile("s_waitcnt vmcnt(0)" ::: "memory");
        }
    }
    __syncthreads();
}


constexpr int LDS_RING = 131072;
constexpr int LDS_CTL_OFF = LDS_RING;
constexpr int LDS_BYTES = LDS_RING + 16384;
constexpr int CW_BAR = 4096;
constexpr size_t CTL_ZERO_BYTES = 64 * 1024;

template <int l>
__device__ __forceinline__ void layer_phases(const Params& P, LAS unsigned char* lds, char* lds_raw, const XcdBarrier& bar) {
    constexpr bool last = l == DEPTH - 1;
    phase_qkv(P, l, lds);
    xcd_barrier(bar);
    if (l & 1) phase_attn<true>(P, l, lds_raw); else phase_attn<false>(P, l, lds_raw);
    xcd_barrier(bar);
    phase_oproj(P, l, lds);
    xcd_barrier(bar);
    phase_norm2_router(P, l, lds);
    xcd_barrier(bar);
    phase_select(P, lds, last);
    xcd_barrier(bar);
    phase_gateup(P, l, lds);
    xcd_barrier(bar);
    phase_down(P, l, lds);
    xcd_barrier(bar);
    phase_combine_norm<last>(P, l);
    if (!last) xcd_barrier(bar);
}

__global__ void __launch_bounds__(512, 2) fwd_kernel(Params P) {
    extern __shared__ __attribute__((aligned(16))) unsigned char lds_raw[];
    LAS unsigned char* lds = (LAS unsigned char*)lds_raw;
    volatile LAS unsigned* xbw = (volatile LAS unsigned*)(lds + LDS_CTL_OFF);
    if (threadIdx.x < 4) xbw[threadIdx.x] = 0u;
    __syncthreads();
    XcdBarrier bar = xcd_barrier_post((unsigned*)(P.ws + WS_CTL) + CW_BAR, xbw);

    phase_weights(P, lds);
    __syncthreads();
    phase_mod(P, lds);
    phase_rope_init(P);
    xcd_barrier(bar);
    phase_norm1_l0(P);
    xcd_barrier(bar);
    layer_phases<0>(P, lds, (char*)lds_raw, bar);
    layer_phases<1>(P, lds, (char*)lds_raw, bar);
    layer_phases<2>(P, lds, (char*)lds_raw, bar);
    layer_phases<3>(P, lds, (char*)lds_raw, bar);
}

extern "C" void kernel_launch(void* const* d_in, const int* in_sizes, int n_in, void* d_out, int out_size, void* d_ws, size_t ws_size, hipStream_t stream) {
    static int grid = 0;
    if (grid == 0) {
        if (n_in != 18 || ws_size < WS_END || out_size != NB * SEQ * D) { fprintf(stderr, "kernel_launch: unexpected problem: n_in %d ws %zu (need %zu) out %d; nothing launched\n", n_in, ws_size, (size_t)WS_END, out_size); grid = -1; return; }
        int dev = 0, cus = 0, per_cu = 0;
        if (hipGetDevice(&dev) != hipSuccess || hipDeviceGetAttribute(&cus, hipDeviceAttributeMultiprocessorCount, dev) != hipSuccess) { fprintf(stderr, "kernel_launch: device query failed\n"); grid = -1; return; }
        if (hipFuncSetAttribute((const void*)fwd_kernel, hipFuncAttributeMaxDynamicSharedMemorySize, LDS_BYTES) != hipSuccess) { fprintf(stderr, "kernel_launch: hipFuncSetAttribute failed\n"); grid = -1; return; }
        if (hipOccupancyMaxActiveBlocksPerMultiprocessor(&per_cu, (const void*)fwd_kernel, 512, LDS_BYTES) != hipSuccess || per_cu < 1) { fprintf(stderr, "kernel_launch: occupancy query reports %d workgroups per CU\n", per_cu); }
        (void)hipGetLastError();
        grid = cus;
    }
    if (grid < 0) return;
    Params P{};
    P.x = (const float*)d_in[0]; P.c = (const float*)d_in[1]; P.ctx = (const float*)d_in[2]; P.c_ctx = (const float*)d_in[3]; P.w_mod = (const float*)d_in[4]; P.b_mod = (const float*)d_in[5];
    P.norm_mix_g = (const float*)d_in[6]; P.norm_ffn_g = (const float*)d_in[7]; P.w_qkv = (const float*)d_in[8]; P.w_o = (const float*)d_in[9]; P.q_norm_g = (const float*)d_in[10]; P.k_norm_g = (const float*)d_in[11];
    P.attn_sink = (const float*)d_in[12]; P.w_router = (const float*)d_in[13]; P.w_gate = (const float*)d_in[14]; P.w_up = (const float*)d_in[15]; P.w_down = (const float*)d_in[16]; P.final_norm_g = (const float*)d_in[17];
    P.out = (float*)d_out; P.ws = (unsigned char*)d_ws;
    if (hipMemsetAsync((char*)d_ws + WS_CTL, 0, CTL_ZERO_BYTES, stream) != hipSuccess) { fprintf(stderr, "kernel_launch: memset failed\n"); return; }
    hipLaunchKernelGGL(fwd_kernel, dim3(grid), dim3(512), LDS_BYTES, stream, P);
    const hipError_t le = hipPeekAtLastError();
    if (le != hipSuccess) fprintf(stderr, "kernel_launch: launch failed: %s (grid %d)\n", hipGetErrorName(le), grid);
}
```
